# Optimizing an MI355X kernel written in HIP

```python
import math
import jax, jax.numpy as jnp
from jax import lax
import numpy as np

D_MODEL = 1024
BATCH = 16
SEQ = 2048
DEPTH = 1

D_SSM = D_MODEL // 2
SSM_GROUP = 16
N_SSM_GROUPS = D_SSM // SSM_GROUP
SSM_STATE = 64
D_ATTN = D_MODEL - D_SSM
HEAD_DIM = 64
N_HEADS = D_ATTN // HEAD_DIM
N_KV_HEADS = 2
D_KV = N_KV_HEADS * HEAD_DIM
IDX_HEADS = 8
IDX_DIM = 64
TOPK_MAX = 256
Q_BLOCK = 128
D_FF = 4 * D_MODEL
EPS = 1e-6
DT_MIN = 1e-3
DT_MAX = 1e-1
IDX_SCALE = (IDX_DIM ** -0.5) * (IDX_HEADS ** -0.5)
D_IN = D_SSM + D_ATTN + 2 * D_KV + IDX_HEADS * IDX_DIM + IDX_DIM + IDX_HEADS

kernel_name = "hymba_s5_dsa_hybrid_layer"


def rms_norm(x, g):
    xf = x.astype(jnp.float32)
    y = xf * lax.rsqrt(jnp.mean(xf * xf, axis=-1, keepdims=True) + EPS)
    return (y * g.astype(jnp.float32)).astype(x.dtype)


def s5_mixer(u, lam_re, lam_im, log_dt, b_re, b_im, c_re, c_im, d_skip, w_glu, b_glu):
    bsz, seq, _ = u.shape
    uf = u.astype(jnp.float32)
    ug = uf.reshape(bsz, seq, N_SSM_GROUPS, SSM_GROUP)
    lam = lax.complex(lam_re.astype(jnp.float32), lam_im.astype(jnp.float32))
    dt = jnp.exp(log_dt.astype(jnp.float32))[:, None]
    lam_bar = jnp.exp(lam * dt)
    b_c = lax.complex(b_re.astype(jnp.float32), b_im.astype(jnp.float32))
    b_bar = ((lam_bar - 1.0) / lam)[..., None] * b_c
    bu = jnp.einsum('gpc,blgc->blgp', b_bar, ug.astype(jnp.complex64))
    a = jnp.broadcast_to(lam_bar[None, None], (1, seq, N_SSM_GROUPS, SSM_STATE))

    def combine(e1, e2):
        a1, s1 = e1
        a2, s2 = e2
        return a1 * a2, a2 * s1 + s2

    _, states = lax.associative_scan(combine, (a, bu), axis=1)
    c_c = lax.complex(c_re.astype(jnp.float32), c_im.astype(jnp.float32))
    y = jnp.real(jnp.einsum('gcp,blgp->blgc', c_c, states)).reshape(bsz, seq, D_SSM)
    y = y + d_skip.astype(jnp.float32) * uf
    z = jax.nn.gelu(y)
    out = z * jax.nn.sigmoid(z @ w_glu.astype(jnp.float32) + b_glu.astype(jnp.float32))
    return out.astype(u.dtype)


def dsa_attention(q, k, v, q_idx, k_idx, w_idx, q_gain, k_gain):
    bsz, seq = q.shape[0], q.shape[1]
    q = rms_norm(q, q_gain)
    k = rms_norm(k, k_gain)
    topk = min(TOPK_MAX, seq // 4)
    n_blocks = seq // Q_BLOCK
    key_pos = jnp.arange(seq)
    bidx = jnp.arange(bsz)[:, None, None]
    k_idx_f = k_idx.astype(jnp.float32)

    def block(start):
        qb = lax.dynamic_slice_in_dim(q, start, Q_BLOCK, axis=1)
        qib = lax.dynamic_slice_in_dim(q_idx, start, Q_BLOCK, axis=1).astype(jnp.float32)
        wb = lax.dynamic_slice_in_dim(w_idx, start, Q_BLOCK, axis=1).astype(jnp.float32)
        q_pos = start + jnp.arange(Q_BLOCK)
        causal = key_pos[None, :] <= q_pos[:, None]
        logits = jax.nn.relu(jnp.einsum('bthd,bsd->bths', qib, k_idx_f))
        score = jnp.einsum('bth,bths->bts', wb, logits) * IDX_SCALE
        score = jnp.where(causal[None], score, -jnp.inf)
        _, sel = lax.top_k(score, topk)
        sel_ok = sel <= q_pos[None, :, None]
        k_sel = k[bidx, sel].astype(jnp.float32)
        v_sel = v[bidx, sel].astype(jnp.float32)
        qg = qb.astype(jnp.float32).reshape(bsz, Q_BLOCK, N_KV_HEADS, N_HEADS // N_KV_HEADS, HEAD_DIM)
        s = jnp.einsum('btkgd,btnkd->btkgn', qg, k_sel) * (HEAD_DIM ** -0.5)
        s = jnp.where(sel_ok[:, :, None, None, :], s, -jnp.inf)
        p = jax.nn.softmax(s, axis=-1)
        o = jnp.einsum('btkgn,btnkd->btkgd', p, v_sel).reshape(bsz, Q_BLOCK, N_HEADS * HEAD_DIM)
        return o.astype(q.dtype)

    outs = lax.map(block, jnp.arange(n_blocks) * Q_BLOCK)
    return outs.transpose(1, 0, 2, 3).reshape(bsz, seq, N_HEADS * HEAD_DIM)


def setup_inputs(seed: int = 0) -> dict:
    key = jax.random.key(seed)
    ks = jax.random.split(key, 26)
    f32 = jnp.float32
    G, P, C = N_SSM_GROUPS, SSM_STATE, SSM_GROUP

    def nrm(k, shape, scale):
        return jax.random.normal(k, shape, f32) * scale

    x = jax.random.normal(ks[0], (BATCH, SEQ, D_MODEL), f32)
    c = jax.random.normal(ks[1], (BATCH, D_MODEL), f32)
    norm1_g = 1.0 + nrm(ks[2], (DEPTH, D_MODEL), 0.02)
    norm2_g = 1.0 + nrm(ks[3], (DEPTH, D_MODEL), 0.02)
    w_ada = nrm(ks[4], (DEPTH, D_MODEL, 6 * D_MODEL), 0.5 * D_MODEL ** -0.5)
    b_ada = nrm(ks[5], (DEPTH, 6 * D_MODEL), 0.02)
    w_in = nrm(ks[6], (DEPTH, D_MODEL, D_IN), D_MODEL ** -0.5)
    lam_re = -0.5 + nrm(ks[7], (DEPTH, G, P), 0.01)
    lam_im = jnp.pi * jnp.arange(P, dtype=f32)[None, None, :] + nrm(ks[8], (DEPTH, G, P), 0.01)
    log_dt = jax.random.uniform(ks[9], (DEPTH, G), f32, math.log(DT_MIN), math.log(DT_MAX))
    ssm_b_re = nrm(ks[10], (DEPTH, G, P, C), (2.0 * C) ** -0.5)
    ssm_b_im = nrm(ks[11], (DEPTH, G, P, C), (2.0 * C) ** -0.5)
    ssm_c_re = nrm(ks[12], (DEPTH, G, C, P), (2.0 * P) ** -0.5)
    ssm_c_im = nrm(ks[13], (DEPTH, G, C, P), (2.0 * P) ** -0.5)
    d_skip = nrm(ks[14], (DEPTH, D_SSM), 1.0)
    w_glu = nrm(ks[15], (DEPTH, D_SSM, D_SSM), D_SSM ** -0.5)
    b_glu = nrm(ks[16], (DEPTH, D_SSM), 0.02)
    q_gain = 1.0 + nrm(ks[17], (DEPTH, HEAD_DIM), 0.02)
    k_gain = 1.0 + nrm(ks[18], (DEPTH, HEAD_DIM), 0.02)
    gn_ssm = 1.0 + nrm(ks[19], (DEPTH, D_SSM), 0.02)
    gn_attn = 1.0 + nrm(ks[20], (DEPTH, D_ATTN), 0.02)
    w_out = nrm(ks[21], (DEPTH, D_SSM + D_ATTN, D_MODEL), (D_SSM + D_ATTN) ** -0.5)
    w_ff1 = nrm(ks[22], (DEPTH, D_MODEL, D_FF), D_MODEL ** -0.5)
    w_ff2 = nrm(ks[23], (DEPTH, D_FF, D_MODEL), D_FF ** -0.5)
    return {"x": x, "c": c, "norm1_g": norm1_g, "norm2_g": norm2_g, "w_ada": w_ada, "b_ada": b_ada,
            "w_in": w_in, "lam_re": lam_re, "lam_im": lam_im, "log_dt": log_dt,
            "ssm_b_re": ssm_b_re, "ssm_b_im": ssm_b_im, "ssm_c_re": ssm_c_re, "ssm_c_im": ssm_c_im,
            "d_skip": d_skip, "w_glu": w_glu, "b_glu": b_glu, "q_gain": q_gain, "k_gain": k_gain,
            "gn_ssm": gn_ssm, "gn_attn": gn_attn, "w_out": w_out, "w_ff1": w_ff1, "w_ff2": w_ff2}


def reference(x, c, norm1_g, norm2_g, w_ada, b_ada, w_in, lam_re, lam_im, log_dt,
              ssm_b_re, ssm_b_im, ssm_c_re, ssm_c_im, d_skip, w_glu, b_glu, q_gain, k_gain,
              gn_ssm, gn_attn, w_out, w_ff1, w_ff2):
    bsz, seq, _ = x.shape
    split_points = list(np.cumsum([D_SSM, D_ATTN, D_KV, D_KV, IDX_HEADS * IDX_DIM, IDX_DIM]))
    silu_c = jax.nn.silu(c)
    for i in range(DEPTH):
        mod = silu_c @ w_ada[i] + b_ada[i]
        sh1, sc1, g1, sh2, sc2, g2 = [m[:, None, :] for m in jnp.split(mod, 6, axis=-1)]

        h = rms_norm(x, norm1_g[i]) * (1.0 + sc1) + sh1
        proj = h @ w_in[i]
        u_ssm, q, k, v, q_idx, k_idx, w_idx = jnp.split(proj, split_points, axis=-1)
        y_ssm = s5_mixer(u_ssm, lam_re[i], lam_im[i], log_dt[i], ssm_b_re[i], ssm_b_im[i],
                         ssm_c_re[i], ssm_c_im[i], d_skip[i], w_glu[i], b_glu[i])
        y_att = dsa_attention(q.reshape(bsz, seq, N_HEADS, HEAD_DIM),
                              k.reshape(bsz, seq, N_KV_HEADS, HEAD_DIM),
                              v.reshape(bsz, seq, N_KV_HEADS, HEAD_DIM),
                              q_idx.reshape(bsz, seq, IDX_HEADS, IDX_DIM),
                              k_idx, w_idx, q_gain[i], k_gain[i])
        mixed = jnp.concatenate([rms_norm(y_ssm, gn_ssm[i]), rms_norm(y_att, gn_attn[i])], axis=-1)
        x = x + g1 * (mixed @ w_out[i])

        h2 = rms_norm(x, norm2_g[i]) * (1.0 + sc2) + sh2
        ff = jnp.square(jax.nn.relu(h2 @ w_ff1[i])) @ w_ff2[i]
        x = x + g2 * ff
    return x
```

```cpp
#include <hip/hip_runtime.h>
#include <cstdio>
#include <cstdint>

#ifndef MK_N_LAUNCHES
#define MK_N_LAUNCHES 8
#endif

namespace pg8 {
#define PG8_LAS __attribute__((address_space(3)))
typedef unsigned short bf16_t;
typedef short bf16x8 __attribute__((ext_vector_type(8)));
typedef float f32x4 __attribute__((ext_vector_type(4)));
typedef unsigned u32x4 __attribute__((ext_vector_type(4)));
typedef unsigned u32x2 __attribute__((ext_vector_type(2)));
constexpr int BM = 256, BK = 64, HALF = 128, HTB = HALF * BK * 2, STAGE_BYTES = 8 * HTB, NXCD = 8, WGM = 8;

__host__ __device__ __forceinline__ int lds_byte(int r, int c) { const int st = (r >> 4) * 2 + (c >> 5), rr = r & 15, cc = c & 31, ob = rr * 64 + cc * 2; return st * 1024 + (ob ^ (((ob >> 9) & 1) << 5)); }
__host__ __device__ __forceinline__ void stage_rc(int b, int& R, int& C) { const int st = b / 1024, sb = b % 1024, swz = sb ^ (((sb >> 9) & 1) << 5); R = (st >> 1) * 16 + swz / 64; C = (st & 1) * 32 + (swz % 64) / 2; }
__host__ __device__ __forceinline__ int perm32(int rho) { const int n = rho >> 4, i = rho & 15; return 8 * (i >> 2) + 4 * n + (i & 3); }

struct Unit { int pm, pn; };
struct Gemm { const bf16_t* A; const bf16_t* Bt; int M, N, K, lda, wrapA; };

struct StaticOrder {
    int nM, nN, nwg, G, c;
    __host__ __device__ void init(int M, int N, int G_, int c_) { nM = M / BM; nN = N / BM; nwg = nM * nN; G = G_; c = c_; }
    __host__ __device__ bool next(int i, Unit& u) const {
        const long L = (long)i * G + c; if (L >= nwg) return false;
        int wgid = (int)L; { const int q = nwg / NXCD, r = nwg % NXCD, xcd = wgid % NXCD, off = wgid / NXCD; wgid = (xcd < r ? xcd * (q + 1) : r * (q + 1) + (xcd - r) * q) + off; }
        const int nig = WGM * nN, gid = wgid / nig, fm = gid * WGM, gsz = (nM - fm) < WGM ? (nM - fm) : WGM;
        u.pm = fm + ((wgid % nig) % gsz); u.pn = (wgid % nig) / gsz; return true;
    }
};

__device__ __forceinline__ unsigned cvt_pk_bf16(float lo, float hi) { unsigned r; asm volatile("v_cvt_pk_bf16_f32 %0, %1, %2" : "=v"(r) : "v"(lo), "v"(hi)); return r; }

template <class Epi, class Sched, bool ALIGN_EPI>
__device__ __forceinline__ void gemm_phase(PG8_LAS unsigned char* lds, const Gemm g, const Sched& S, const Epi& E) {
    const int tid = threadIdx.x, wid = __builtin_amdgcn_readfirstlane(tid >> 6), lane = tid & 63, wr = wid >> 2, wc = wid & 3, fr = lane & 15, fq = lane >> 4;
    const int K = g.K, nt = K / BK, lda = g.lda, wrapA = g.wrapA;
    unsigned voffA[2], voffB[2];
#pragma unroll
    for (int i = 0; i < 2; ++i) { int R, C; stage_rc(tid * 16 + i * 8192, R, C); const int Rb = Epi::PERM ? ((R & ~31) + perm32(R & 31)) : R;
        voffA[i] = (unsigned)(R * lda + C) * 2u; voffB[i] = (unsigned)(Rb * K + C) * 2u; }
    const size_t kstep = (size_t)(BK * 2);
    const size_t hsA = (size_t)HALF * lda * 2, hsB = (size_t)HALF * K * 2;
    const size_t tsA = 2 * hsA, tsB = 2 * hsB;
    const unsigned ldsw = (unsigned)wid * 1024u;
    const int aoff = lds_byte(wr * 64 + fr, fq * 8), boff = lds_byte(wc * 32 + fr, fq * 8);
#define PG8_SA(b, h) (((b) * 2 + (h)) * HTB)
#define PG8_SB(b, h) ((4 + (b) * 2 + (h)) * HTB)
#define PG8_STAGE(bufoff, gbase, voff) do { _Pragma("unroll") for (int _i = 0; _i < 2; ++_i) \
        __builtin_amdgcn_global_load_lds((const unsigned*)((const char*)(gbase) + (voff)[_i]), (PG8_LAS unsigned*)(lds + (bufoff) + ldsw + _i * 8192), 16, 0, 0); } while (0)
#define PG8_LDA(dst, b, h) do { _Pragma("unroll") for (int m = 0; m < 4; ++m) _Pragma("unroll") for (int k = 0; k < 2; ++k) dst[m][k] = *(const PG8_LAS bf16x8*)(lds + PG8_SA(b, h) + aoff + m * 2048 + k * 1024); } while (0)
#define PG8_LDB(dst, b, h) do { _Pragma("unroll") for (int n = 0; n < 2; ++n) _Pragma("unroll") for (int k = 0; k < 2; ++k) dst[n][k] = *(const PG8_LAS bf16x8*)(lds + PG8_SB(b, h) + boff + n * 2048 + k * 1024); } while (0)
#define PG8_MMA(ai, bj, At, Bt) do { __builtin_amdgcn_s_setprio(1); _Pragma("unroll") for (int m = 0; m < 4; ++m) _Pragma("unroll") for (int n = 0; n < 2; ++n) _Pragma("unroll") for (int k = 0; k < 2; ++k) \
        acc[ai][bj][m][n] = __builtin_amdgcn_mfma_f32_16x16x32_bf16(Bt[n][k], At[m][k], acc[ai][bj][m][n], 0, 0, 0); __builtin_amdgcn_s_setprio(0); } while (0)
#define PG8_WAIT_V(n) asm volatile("s_waitcnt vmcnt(" #n ")" ::: "memory")
#define PG8_WAIT_L(n) asm volatile("s_waitcnt lgkmcnt(" #n ")" ::: "memory")
#define PG8_BAR __builtin_amdgcn_s_barrier()
#define PG8_SCHED __builtin_amdgcn_sched_barrier(0)
#define PG8_AT(t) ((t) >= wrapA ? (t) - wrapA : (t))
    Unit cur, nxt; int ui = 0;
    if (!S.next(0, cur)) return;
    f32x4 acc[2][2][4][2];
#pragma unroll
    for (int a = 0; a < 2; ++a)
#pragma unroll
        for (int b = 0; b < 2; ++b)
#pragma unroll
            for (int m = 0; m < 4; ++m)
#pragma unroll
                for (int n = 0; n < 2; ++n) acc[a][b][m][n] = (f32x4){0.f, 0.f, 0.f, 0.f};
    bf16x8 At[4][2], B0[2][2], B1[2][2];
    const char* cA = (const char*)g.A + (size_t)cur.pm * tsA; const char* cB = (const char*)g.Bt + (size_t)cur.pn * tsB;
    PG8_STAGE(PG8_SB(0, 0), cB, voffB); PG8_STAGE(PG8_SB(0, 1), cB + hsB, voffB); PG8_STAGE(PG8_SA(0, 0), cA, voffA); PG8_STAGE(PG8_SA(0, 1), cA + hsA, voffA);
    if (wr == 1) PG8_BAR;
    PG8_WAIT_V(2); PG8_BAR;
    PG8_STAGE(PG8_SB(1, 0), cB + kstep, voffB); PG8_STAGE(PG8_SA(1, 0), cA + kstep, voffA); PG8_STAGE(PG8_SB(1, 1), cB + hsB + kstep, voffB);
    PG8_WAIT_V(6); PG8_BAR;
    for (;;) {
        const bool has_next = S.next(ui + 1, nxt);
        const char* nA = has_next ? (const char*)g.A + (size_t)nxt.pm * tsA : cA; const char* nB = has_next ? (const char*)g.Bt + (size_t)nxt.pn * tsB : cB;
        for (int t = 0; t < nt; t += 2) {
            const bool last = (t == nt - 2);
            const char* a1 = cA + (size_t)PG8_AT(t + 1) * kstep;
            const char* a2 = last ? nA : cA + (size_t)PG8_AT(t + 2) * kstep; const char* b2 = last ? nB : cB + (size_t)(t + 2) * kstep;
            const char* a3 = a2 + kstep; const char* b3 = b2 + kstep;
            if constexpr (Epi::MID) { if (t == E.tmid) E.mid(acc, cur, wr, wc, fr, fq); }
            PG8_LDB(B0, 0, 0); PG8_LDB(B1, 0, 1); PG8_SCHED; PG8_LDA(At, 0, 0); PG8_STAGE(PG8_SA(1, 1), a1 + hsA, voffA);
            PG8_WAIT_V(8); PG8_WAIT_L(0); PG8_BAR; PG8_MMA(0, 0, At, B0); PG8_MMA(0, 1, At, B1); PG8_BAR; PG8_SCHED;
            PG8_LDA(At, 0, 1); PG8_STAGE(PG8_SB(0, 0), b2, voffB); PG8_STAGE(PG8_SB(0, 1), b2 + hsB, voffB); PG8_STAGE(PG8_SA(0, 0), a2, voffA);
            PG8_WAIT_V(8); PG8_WAIT_L(0); PG8_BAR; PG8_MMA(1, 0, At, B0); PG8_MMA(1, 1, At, B1); PG8_BAR; PG8_SCHED;
            PG8_LDB(B0, 1, 0); PG8_LDB(B1, 1, 1); PG8_SCHED; PG8_LDA(At, 1, 0); PG8_STAGE(PG8_SA(0, 1), a2 + hsA, voffA);
            PG8_WAIT_V(8); PG8_WAIT_L(0); PG8_BAR; PG8_MMA(0, 0, At, B0); PG8_MMA(0, 1, At, B1); PG8_BAR; PG8_SCHED;
            PG8_LDA(At, 1, 1); PG8_STAGE(PG8_SB(1, 0), b3, voffB); PG8_STAGE(PG8_SB(1, 1), b3 + hsB, voffB); PG8_STAGE(PG8_SA(1, 0), a3, voffA);
            PG8_WAIT_V(8); PG8_WAIT_L(0); PG8_BAR; PG8_MMA(1, 0, At, B0); PG8_MMA(1, 1, At, B1); PG8_BAR; PG8_SCHED;
        }
        if constexpr (ALIGN_EPI) { if (wr == 0) PG8_BAR; }
        E(acc, cur, wr, wc, fr, fq);
        if (!has_next) break;
#pragma unroll
        for (int a = 0; a < 2; ++a)
#pragma unroll
            for (int b = 0; b < 2; ++b)
#pragma unroll
                for (int m = 0; m < 4; ++m)
#pragma unroll
                    for (int n = 0; n < 2; ++n) acc[a][b][m][n] = (f32x4){0.f, 0.f, 0.f, 0.f};
        cur = nxt; cA = nA; cB = nB; ++ui;
        if constexpr (ALIGN_EPI) { if (wr == 1) PG8_BAR; }
    }
    PG8_WAIT_V(0);
    if constexpr (!ALIGN_EPI) { if (wr == 0) PG8_BAR; }
    PG8_BAR;
#undef PG8_SA
#undef PG8_SB
#undef PG8_STAGE
#undef PG8_LDA
#undef PG8_LDB
#undef PG8_MMA
#undef PG8_WAIT_V
#undef PG8_WAIT_L
#undef PG8_BAR
#undef PG8_SCHED
#undef PG8_AT
}
}

constexpr int NWAVES = 8;
constexpr int NPHASE = 8;
constexpr int N_LAUNCHES = MK_N_LAUNCHES;
constexpr int BATCH = 16, SEQ = 2048, DM = 1024, M = BATCH * SEQ;
constexpr int D_SSM = 512, NG = 32, GC = 16, NP = 64, D_ATT = 512, HD = 64, NH = 8, IH = 8, ID = 64, TOPK = 256, DFF = 4096, D_IN = 1864;
constexpr int N_PLAIN = 1280, N_IDX_PAD = 768, K3 = 3072;
constexpr float EPS = 1e-6f;
constexpr float IDX_SCALE = 0.125f * 0.35355339059327373f;

constexpr size_t MiB = 1u << 20;
constexpr size_t WS_CTL = 0, CTL_ZERO_BYTES = 1 * MiB;
constexpr size_t WS_MODP = 1 * MiB;
constexpr size_t WS_MOD = 4 * MiB;
constexpr size_t WS_BIAS2 = 4 * MiB + 512 * 1024;
constexpr size_t WS_SSQS = 5 * MiB;
constexpr size_t WS_SSQ2 = 6 * MiB;
constexpr size_t WS_WINP = 8 * MiB;
constexpr size_t WS_WINI = 11 * MiB;
constexpr size_t WS_WGLU = 16 * MiB;
constexpr size_t WS_WOUT = 17 * MiB;
constexpr size_t WS_W1 = 19 * MiB;
constexpr size_t WS_W2 = 27 * MiB;
constexpr size_t WS_SSMP = 35 * MiB;
constexpr size_t WS_U = 36 * MiB;
constexpr size_t WS_Q = 68 * MiB;
constexpr size_t WS_A2 = 36 * MiB;
constexpr size_t WS_XN = 100 * MiB;
constexpr size_t WS_KV = 228 * MiB;
constexpr size_t WS_KI = 244 * MiB;
constexpr size_t WS_WI = 252 * MiB;
constexpr size_t WS_QI = 256 * MiB;
constexpr size_t WS_Z = 320 * MiB;
constexpr size_t WS_MIX = 352 * MiB;
constexpr size_t WS_H = 256 * MiB;
constexpr size_t WS_END = 512 * MiB;
constexpr int CW_BAR = 4096;

constexpr int RING_OFF = 0;
constexpr int WAVE_LDS = 17920;
constexpr int LDSCTL_OFF = 143360, MISC_OFF = LDSCTL_OFF + 320;
constexpr int LDS_BYTES = 147456;

#define GAS __attribute__((address_space(1)))
#define LAS __attribute__((address_space(3)))
typedef unsigned short bf16;
typedef unsigned v4u __attribute__((ext_vector_type(4)));
typedef unsigned v2u __attribute__((ext_vector_type(2)));
typedef float f32x4 __attribute__((ext_vector_type(4)));
typedef float f32x2 __attribute__((ext_vector_type(2)));
typedef GAS unsigned gu32;
#define RLX_AGENT __ATOMIC_RELAXED, __HIP_MEMORY_SCOPE_AGENT
#define LDS_WAIT() asm volatile("s_waitcnt lgkmcnt(0)" ::: "memory")
#define VM_WAIT() asm volatile("s_waitcnt vmcnt(0)" ::: "memory")
__device__ __forceinline__ unsigned f2bf(float f) { unsigned u = __builtin_bit_cast(unsigned, f); return (u + 0x7fffu + ((u >> 16) & 1u)) >> 16; }
__device__ __forceinline__ unsigned pk2(float lo, float hi) { return f2bf(lo) | (f2bf(hi) << 16); }
__device__ __forceinline__ float bf2f(unsigned h) { return __builtin_bit_cast(float, h << 16); }
__device__ __forceinline__ float bflo(unsigned w) { return __builtin_bit_cast(float, w << 16); }
__device__ __forceinline__ float bfhi(unsigned w) { return __builtin_bit_cast(float, w & 0xffff0000u); }

#define XB_TMO      128
#define XB_XCNT(j)  (256  + 64 * (j))
#define XB_XSUB(j)  (1280 + 64 * (j))
#define XB_XGEN(j)  (2304 + 64 * (j))
#define XB_TOP      3328
#define XB_TOPGEN   3392
#define XCD_BAR_WORDS 3456
#define XB_SPIN_CAP (1u << 18)
__device__ __forceinline__ unsigned xb_ld(unsigned* p)              { return __hip_atomic_load(p, __ATOMIC_RELAXED, __HIP_MEMORY_SCOPE_AGENT); }
__device__ __forceinline__ unsigned xb_add(unsigned* p, unsigned v) { return __hip_atomic_fetch_add(p, v, __ATOMIC_RELAXED, __HIP_MEMORY_SCOPE_AGENT); }
__device__ __forceinline__ unsigned xb_xcc_id() { return (unsigned)__builtin_amdgcn_s_getreg((3 << 11) | 20) & 0xFu; }
#define XB_SPIN(cond, bar) do { unsigned _sp = 0; while (cond) { __builtin_amdgcn_s_sleep(1); \
    if ((++_sp & 255u) == 0u) { if (xb_ld(&(bar)[XB_TMO])) break; if (_sp > XB_SPIN_CAP) { atomicAdd(&(bar)[XB_TMO], 1u); break; } } } } while (0)
struct XcdBarrier { unsigned* bar; unsigned x; volatile LAS unsigned* st; };
__device__ __forceinline__ XcdBarrier xcd_barrier_post(unsigned* bar, volatile LAS unsigned* st) {
    XcdBarrier b; b.bar = bar; b.x = xb_xcc_id(); b.st = st;
    if (threadIdx.x == 0) (void)xb_add(&bar[XB_XCNT(b.x)], 1u);
    return b;
}
__device__ __forceinline__ void xcd_barrier_complete(unsigned* bar, unsigned x, unsigned& nloc, unsigned& nx) {
    const unsigned G = gridDim.x * gridDim.y * gridDim.z;
    unsigned sum, cnt, mine, sp = 0u;
    for (;;) {
        sum = 0u; cnt = 0u; mine = 0u;
#pragma unroll
        for (unsigned j = 0; j < 16; ++j) { const unsigned c = xb_ld(&bar[XB_XCNT(j)]); sum += c; cnt += (c > 0u) ? 1u : 0u; mine = (j == x) ? c : mine; }
        if (sum == G) break;
        __builtin_amdgcn_s_sleep(1);
        if ((++sp & 255u) == 0u) { if (xb_ld(&bar[XB_TMO])) break; if (sp > XB_SPIN_CAP) { atomicAdd(&bar[XB_TMO], 1u); break; } }
    }
    nloc = mine > 0u ? mine : 1u; nx = cnt > 0u ? cnt : 1u;
}
__device__ __forceinline__ void xcd_barrier(const XcdBarrier& b) {
    asm volatile("s_waitcnt vmcnt(0)" ::: "memory");
    __syncthreads();
    if (threadIdx.x == 0) {
        unsigned* bar = b.bar;
        __builtin_amdgcn_s_waitcnt(0);
        unsigned nloc = b.st[0], nx = b.st[1];
        if (nloc == 0u) { xcd_barrier_complete(bar, b.x, nloc, nx); b.st[0] = nloc; b.st[1] = nx; }
        const unsigned old = xb_add(&bar[XB_XSUB(b.x)], 1u);
        const unsigned gen = old / nloc;
        if (old + 1u == (gen + 1u) * nloc) {
            __builtin_amdgcn_fence(__ATOMIC_RELEASE, "agent");
            asm volatile("s_waitcnt vmcnt(0)" ::: "memory");
            const unsigned og = xb_add(&bar[XB_TOP], 1u);
            const unsigned tg = og / nx;
            if (og + 1u == (tg + 1u) * nx) xb_add(&bar[XB_TOPGEN], 1u);
            else XB_SPIN(xb_ld(&bar[XB_TOPGEN]) == tg, bar);
            __builtin_amdgcn_fence(__ATOMIC_ACQUIRE, "agent");
            xb_add(&bar[XB_XGEN(b.x)], 1u);
            asm volatile("s_waitcnt vmcnt(0)" ::: "memory");
        } else {
            XB_SPIN(xb_ld(&bar[XB_XGEN(b.x)]) == gen, bar);
            __builtin_amdgcn_fence(__ATOMIC_ACQUIRE, "agent");
            asm volatile("s_waitcnt vmcnt(0)" ::: "memory");
        }
    }
    __syncthreads();
}

struct Frame {
    LAS unsigned char* lds;
    volatile LAS unsigned* MISC;
    gu32* ctl;
    int tid, lane, wave;
    int vcu, G;
    const float *x, *c, *norm1_g, *norm2_g, *w_ada, *b_ada, *w_in, *lam_re, *lam_im, *log_dt, *b_re, *b_im, *c_re, *c_im, *d_skip, *w_glu, *b_glu, *q_gain, *k_gain, *gn_ssm, *gn_attn, *w_out, *w_ff1, *w_ff2;
    float* out;
    float *MODP, *MOD, *BIAS2, *SSQS, *SSQ2, *KI, *WI, *QI;
    f32x2 *LAMB, *BBAR;
    bf16 *WINP, *WINI, *WGLU, *WOUT, *W1, *W2, *U, *Q, *A2, *XN, *KV, *Z, *MIX, *H;
};

__device__ __forceinline__ float wave_sum(float v) {
#pragma unroll
    for (int o = 1; o < 64; o <<= 1) v += __shfl_xor(v, o);
    return v;
}
__device__ __forceinline__ float wave_max(float v) {
#pragma unroll
    for (int o = 1; o < 64; o <<= 1) v = fmaxf(v, __shfl_xor(v, o));
    return v;
}
__device__ __forceinline__ int wave_sum_i(int v) {
#pragma unroll
    for (int o = 1; o < 64; o <<= 1) v += __shfl_xor(v, o);
    return v;
}

__device__ __forceinline__ double exp_d(double x) {
    const double n = __builtin_rint(x * 1.4426950408889634);
    const double r = (x - n * 0.693147180369123816490e+00) - n * 1.90821492927058770002e-10;
    double p = 1.0 / 87178291200.0;
    p = p * r + 1.0 / 6227020800.0; p = p * r + 1.0 / 479001600.0; p = p * r + 1.0 / 39916800.0; p = p * r + 1.0 / 3628800.0; p = p * r + 1.0 / 362880.0;
    p = p * r + 1.0 / 40320.0; p = p * r + 1.0 / 5040.0; p = p * r + 1.0 / 720.0; p = p * r + 1.0 / 120.0; p = p * r + 1.0 / 24.0; p = p * r + 1.0 / 6.0; p = p * r + 0.5; p = p * r + 1.0; p = p * r + 1.0;
    const long long e = (long long)n + 1023;
    return p * __builtin_bit_cast(double, (unsigned long long)e << 52);
}
__device__ __forceinline__ void sincos_d(double x, double& s, double& c) {
    const double n = __builtin_rint(x * 0.63661977236758134308);
    double r = (x - n * 1.57079632673412561417e+00) - n * 6.07710050650619224932e-11;
    r = r - n * 2.02226624879595063154e-21;
    const double r2 = r * r;
    double sp = -1.0 / 1307674368000.0;
    sp = sp * r2 + 1.0 / 6227020800.0; sp = sp * r2 - 1.0 / 39916800.0; sp = sp * r2 + 1.0 / 362880.0; sp = sp * r2 - 1.0 / 5040.0; sp = sp * r2 + 1.0 / 120.0; sp = sp * r2 - 1.0 / 6.0; sp = sp * r2 + 1.0;
    const double sr = sp * r;
    double cp = 1.0 / 20922789888000.0;
    cp = cp * r2 - 1.0 / 87178291200.0; cp = cp * r2 + 1.0 / 479001600.0; cp = cp * r2 - 1.0 / 3628800.0; cp = cp * r2 + 1.0 / 40320.0; cp = cp * r2 - 1.0 / 720.0; cp = cp * r2 + 1.0 / 24.0; cp = cp * r2 - 0.5; cp = cp * r2 + 1.0;
    const long long q = (long long)n & 3;
    s = (q == 0) ? sr : (q == 1) ? cp : (q == 2) ? -sr : -cp;
    c = (q == 0) ? cp : (q == 1) ? -sr : (q == 2) ? -cp : sr;
}

template <int MODE>
__device__ __forceinline__ void p0_transpose_item(Frame& F, const float* W, int K, int N, bf16* WT, LAS float* scr, int item, int lane) {
    const int nblk = (N + 31) / 32, kb = item / nblk, nb = item % nblk, k0 = 64 * kb, n0 = 32 * nb;
#pragma unroll 8
    for (int i = 0; i < 32; ++i) { const int kk = 2 * i + (lane >> 5); const int n = n0 + (lane & 31);
        float v = (MODE != 1 || n < N) ? W[(size_t)(k0 + kk) * N + n] : 0.f;
        if (MODE == 2) { const int k = k0 + kk; v *= (k < D_SSM) ? F.gn_ssm[k] : F.gn_attn[k - D_SSM]; }
        scr[kk * 33 + (lane & 31)] = v; }
    LDS_WAIT(); asm volatile("" ::: "memory");
    const int c = lane & 7;
#pragma unroll
    for (int j = 0; j < 4; ++j) { const int n = (lane >> 3) + 8 * j; const LAS float* s = scr + (8 * c) * 33 + n;
        float v[8];
#pragma unroll
        for (int e = 0; e < 8; ++e) v[e] = s[e * 33];
        v4u o; o.x = pk2(v[0], v[1]); o.y = pk2(v[2], v[3]); o.z = pk2(v[4], v[5]); o.w = pk2(v[6], v[7]);
        if (MODE != 1) { *(GAS v4u*)(WT + (size_t)(n0 + n) * K + k0 + 8 * c) = o; }
        else {
            const int ng = n0 + n;
            if (ng < N_PLAIN) { *(GAS v4u*)(F.WINP + (size_t)ng * 1024 + k0 + 8 * c) = o; }
            else {
                float l[8];
#pragma unroll
                for (int e = 0; e < 8; ++e) l[e] = v[e] - bf2f(f2bf(v[e]));
                v4u ol; ol.x = pk2(l[0], l[1]); ol.y = pk2(l[2], l[3]); ol.z = pk2(l[4], l[5]); ol.w = pk2(l[6], l[7]);
                bf16* d = F.WINI + (size_t)(ng - N_PLAIN) * K3 + k0 + 8 * c;
                *(GAS v4u*)(d) = o; *(GAS v4u*)(d + 1024) = o; *(GAS v4u*)(d + 2048) = ol;
            }
        } }
    LDS_WAIT(); asm volatile("" ::: "memory");
}

__device__ __forceinline__ void p0_mod_item(Frame& F, int item, LAS float* scr) {
    const int cg = item >> 3, ks = item & 7, j = cg * 64 + F.lane, k0 = ks * 128;
    for (int e = F.lane; e < 2048; e += 64) { const int b = e >> 7, i = e & 127; const float cv = F.c[b * 1024 + k0 + i]; scr[e] = cv / (1.f + __expf(-cv)); }
    LDS_WAIT(); asm volatile("" ::: "memory");
    float acc[16];
#pragma unroll
    for (int b = 0; b < 16; ++b) acc[b] = 0.f;
    for (int i4 = 0; i4 < 32; ++i4) {
        const float* wp = F.w_ada + (size_t)(k0 + 4 * i4) * 6144 + j;
        const float w0 = wp[0], w1 = wp[6144], w2 = wp[2 * 6144], w3 = wp[3 * 6144];
#pragma unroll
        for (int b = 0; b < 16; ++b) { const f32x4 s = *(const LAS f32x4*)(scr + b * 128 + 4 * i4); acc[b] += s.x * w0 + s.y * w1 + s.z * w2 + s.w * w3; }
    }
#pragma unroll
    for (int b = 0; b < 16; ++b) F.MODP[(size_t)(ks * 16 + b) * 6144 + j] = acc[b];
    LDS_WAIT(); asm volatile("" ::: "memory");
}

__device__ __forceinline__ void p0_ssm_item(Frame& F, int g) {
    const int p = F.lane, gp = g * 64 + p;
    const double lre = (double)F.lam_re[gp], lim = (double)F.lam_im[gp], dt = exp_d((double)F.log_dt[g]);
    double s, c; sincos_d(lim * dt, s, c);
    const double mag = exp_d(lre * dt), lbr = mag * c, lbi = mag * s;
    const double a = lbr - 1.0, b = lbi, den = lre * lre + lim * lim;
    const double cr = (a * lre + b * lim) / den, ci = (b * lre - a * lim) / den;
    F.LAMB[gp] = (f32x2){(float)lbr, (float)lbi};
#pragma unroll
    for (int cc = 0; cc < 16; ++cc) { const double br = (double)F.b_re[gp * 16 + cc], bi = (double)F.b_im[gp * 16 + cc];
        F.BBAR[gp * 16 + cc] = (f32x2){(float)(cr * br - ci * bi), (float)(cr * bi + ci * br)}; }
}

__device__ __forceinline__ void p0a_phase(Frame& F) {
    LAS float* scr = (LAS float*)(F.lds + RING_OFF + F.wave * WAVE_LDS);
    const int gw = F.vcu * NWAVES + F.wave, NGW = F.G * NWAVES;
    constexpr int I_MOD = 96 * 8, I_SSM = 32;
    constexpr int I_IN = 16 * 59, I_GLU = 8 * 16, I_OUT = 16 * 32, I_1 = 16 * 128, I_2 = 64 * 32;
    constexpr int NITEMS = I_MOD + I_SSM + I_IN + I_GLU + I_OUT + I_1 + I_2;
    for (int it = gw; it < NITEMS; it += NGW) {
        int r = it;
        if (r < I_MOD) { p0_mod_item(F, r, scr); continue; } r -= I_MOD;
        if (r < I_SSM) { p0_ssm_item(F, r); continue; } r -= I_SSM;
        if (r < I_IN) { p0_transpose_item<1>(F, F.w_in, 1024, D_IN, nullptr, scr, r, F.lane); continue; } r -= I_IN;
        if (r < I_GLU) { p0_transpose_item<0>(F, F.w_glu, 512, 512, F.WGLU, scr, r, F.lane); continue; } r -= I_GLU;
        if (r < I_OUT) { p0_transpose_item<2>(F, F.w_out, 1024, 1024, F.WOUT, scr, r, F.lane); continue; } r -= I_OUT;
        if (r < I_1) { p0_transpose_item<0>(F, F.w_ff1, 1024, DFF, F.W1, scr, r, F.lane); continue; } r -= I_1;
        p0_transpose_item<0>(F, F.w_ff2, DFF, 1024, F.W2, scr, r, F.lane);
    }
    { const int gt = (F.vcu * NWAVES + F.wave) * 64 + F.lane, NT = F.G * NWAVES * 64; GAS v4u* z = (GAS v4u*)(F.WINI + (size_t)608 * K3);
      for (int i = gt; i < 160 * K3 / 8; i += NT) z[i] = (v4u){0u, 0u, 0u, 0u}; }
}

__device__ __forceinline__ void p0b_phase(Frame& F) {
    const int w = F.vcu;
    { const int idx = w * 384 + F.tid;
      if (F.tid < 384 && idx < 16 * 6144) { const int j = idx % 6144; float s = F.b_ada[j];
#pragma unroll
          for (int ks = 0; ks < 8; ++ks) s += F.MODP[(size_t)ks * 16 * 6144 + idx];
          F.MOD[idx] = s; } }
    LAS float* sh = (LAS float*)(F.lds + RING_OFF);
    for (int rb = w; rb < M / 128; rb += F.G) {
        const int b = rb / 16;
        __syncthreads();
        for (int e = F.tid; e < 2048; e += NWAVES * 64) { float s = F.b_ada[e];
#pragma unroll
            for (int ks = 0; ks < 8; ++ks) s += F.MODP[(size_t)(ks * 16 + b) * 6144 + e];
            sh[e] = s; }
        __syncthreads();
        for (int r = 0; r < 16; ++r) {
            const size_t m = (size_t)rb * 128 + F.wave * 16 + r;
            const GAS f32x4* xr = (const GAS f32x4*)(F.x + m * DM) + F.lane;
            f32x4 v[4]; float ss = 0.f;
#pragma unroll
            for (int j = 0; j < 4; ++j) { v[j] = xr[64 * j]; ss += (v[j].x * v[j].x + v[j].y * v[j].y) + (v[j].z * v[j].z + v[j].w * v[j].w); }
            const float rstd = 1.0f / sqrtf(wave_sum(ss) * (1.f / DM) + EPS);
            GAS v2u* oh = (GAS v2u*)(F.XN + m * 2048) + F.lane;
#pragma unroll
            for (int j = 0; j < 4; ++j) { const int col = 4 * F.lane + 256 * j;
                const f32x4 g = *(const f32x4*)(F.norm1_g + col); const f32x4 s1 = *(const LAS f32x4*)(sh + col); const f32x4 c1 = *(const LAS f32x4*)(sh + 1024 + col);
                f32x4 h = v[j] * rstd * g * (c1 + 1.0f) + s1;
                float hh[4] = {h.x, h.y, h.z, h.w}, hl[4];
#pragma unroll
                for (int e = 0; e < 4; ++e) hl[e] = hh[e] - bf2f(f2bf(hh[e]));
                oh[64 * j] = (v2u){pk2(hh[0], hh[1]), pk2(hh[2], hh[3])};
                oh[256 + 64 * j] = (v2u){pk2(hl[0], hl[1]), pk2(hl[2], hl[3])}; }
        }
    }
}

using pg8::Unit; using pg8::cvt_pk_bf16;
struct EpiInPlain {
    static constexpr bool PERM = true, MID = false; int tmid;
    bf16 *U, *Q, *KV;
    __device__ __forceinline__ void mid(f32x4 (&)[2][2][4][2], const Unit&, int, int, int, int) const {}
    __device__ __forceinline__ void operator()(const f32x4 (&acc)[2][2][4][2], const Unit& u, int wr, int wc, int fr, int fq) const {
        bf16* base; int ldc, colt;
        if (u.pn < 2) { base = U; ldc = 512; colt = u.pn * 256; } else if (u.pn < 4) { base = Q; ldc = 512; colt = (u.pn - 2) * 256; } else { base = KV; ldc = 256; colt = 0; }
        const int row0 = u.pm * 256 + wr * 64 + fr, col0 = colt + wc * 32 + 8 * fq;
#pragma unroll
        for (int ai = 0; ai < 2; ++ai)
#pragma unroll
            for (int m = 0; m < 4; ++m) { bf16* rowp = base + (size_t)(row0 + ai * 128 + m * 16) * ldc + col0;
#pragma unroll
                for (int bj = 0; bj < 2; ++bj) { const f32x4 v0 = acc[ai][bj][m][0], v1 = acc[ai][bj][m][1];
                    v4u wv; wv.x = cvt_pk_bf16(v0[0], v0[1]); wv.y = cvt_pk_bf16(v0[2], v0[3]); wv.z = cvt_pk_bf16(v1[0], v1[1]); wv.w = cvt_pk_bf16(v1[2], v1[3]);
                    *(v4u*)(rowp + bj * 128) = wv; } }
    }
};
struct EpiInIdx {
    static constexpr bool PERM = false, MID = false; int tmid;
    float *QI, *KI, *WI;
    __device__ __forceinline__ void mid(f32x4 (&)[2][2][4][2], const Unit&, int, int, int, int) const {}
    __device__ __forceinline__ void operator()(const f32x4 (&acc)[2][2][4][2], const Unit& u, int wr, int wc, int fr, int fq) const {
        const int row0 = u.pm * 256 + wr * 64 + fr;
        if (u.pn < 2) {
            const int col0 = u.pn * 256 + wc * 32 + 4 * fq;
#pragma unroll
            for (int ai = 0; ai < 2; ++ai)
#pragma unroll
                for (int m = 0; m < 4; ++m) { float* rowp = QI + (size_t)(row0 + ai * 128 + m * 16) * 512 + col0;
#pragma unroll
                    for (int bj = 0; bj < 2; ++bj)
#pragma unroll
                        for (int n = 0; n < 2; ++n) *(f32x4*)(rowp + bj * 128 + n * 16) = acc[ai][bj][m][n]; }
        } else {
#pragma unroll
            for (int ai = 0; ai < 2; ++ai)
#pragma unroll
                for (int m = 0; m < 4; ++m) { const size_t row = (size_t)(row0 + ai * 128 + m * 16);
#pragma unroll
                    for (int n = 0; n < 2; ++n) { const int col = wc * 32 + 16 * n + 4 * fq;
                        if (col < 64) *(f32x4*)(KI + row * 64 + col) = acc[ai][0][m][n];
                        else if (col < 72) *(f32x4*)(WI + row * 8 + (col - 64)) = acc[ai][0][m][n]; } }
        }
    }
};
struct EpiGlu {
    static constexpr bool PERM = true, MID = false; int tmid;
    const bf16* Z; bf16* MIX; const float* bglu; float* SSQS;
    __device__ __forceinline__ void mid(f32x4 (&)[2][2][4][2], const Unit&, int, int, int, int) const {}
    __device__ __forceinline__ void operator()(const f32x4 (&acc)[2][2][4][2], const Unit& u, int wr, int wc, int fr, int fq) const {
        const int row0 = u.pm * 256 + wr * 64 + fr, col0 = u.pn * 256 + wc * 32 + 8 * fq;
#pragma unroll
        for (int ai = 0; ai < 2; ++ai)
#pragma unroll
            for (int m = 0; m < 4; ++m) { const size_t row = (size_t)(row0 + ai * 128 + m * 16); float ss = 0.f;
#pragma unroll
                for (int bj = 0; bj < 2; ++bj) { const int col = col0 + bj * 128;
                    const v4u zz = *(const v4u*)(Z + row * 512 + col);
                    const f32x4 b0 = *(const f32x4*)(bglu + col), b1 = *(const f32x4*)(bglu + col + 4);
                    const f32x4 a0 = acc[ai][bj][m][0] + b0, a1 = acc[ai][bj][m][1] + b1;
                    float zf[8] = {bflo(zz.x), bfhi(zz.x), bflo(zz.y), bfhi(zz.y), bflo(zz.z), bfhi(zz.z), bflo(zz.w), bfhi(zz.w)};
                    float av[8] = {a0[0], a0[1], a0[2], a0[3], a1[0], a1[1], a1[2], a1[3]}, y[8];
#pragma unroll
                    for (int e = 0; e < 8; ++e) { y[e] = zf[e] / (1.f + __expf(-av[e])); ss += y[e] * y[e]; }
                    v4u wv; wv.x = cvt_pk_bf16(y[0], y[1]); wv.y = cvt_pk_bf16(y[2], y[3]); wv.z = cvt_pk_bf16(y[4], y[5]); wv.w = cvt_pk_bf16(y[6], y[7]);
                    *(v4u*)(MIX + row * 1024 + col) = wv; }
                ss += __shfl_xor(ss, 16); ss += __shfl_xor(ss, 32);
                if (fq == 0) SSQS[row * 8 + u.pn * 4 + wc] = ss; }
    }
};
struct EpiOut {
    static constexpr bool PERM = true, MID = true; int tmid;
    const float* x; float* x1; bf16* A2; const float* MOD; const float* g2n; const float* SSQS; float* SSQ2;
    __device__ __forceinline__ void mid(f32x4 (&acc)[2][2][4][2], const Unit& u, int wr, int wc, int fr, int fq) const {
#pragma unroll
        for (int ai = 0; ai < 2; ++ai)
#pragma unroll
            for (int m = 0; m < 4; ++m) { const size_t row = (size_t)(u.pm * 256 + ai * 128 + wr * 64 + m * 16 + fr);
                const f32x4 p = *(const f32x4*)(SSQS + row * 8 + 4 * (fq & 1)); float s = (p.x + p.y) + (p.z + p.w); s += __shfl_xor(s, 16);
                const float rstd = 1.0f / sqrtf(s * (1.f / 512.f) + EPS);
#pragma unroll
                for (int bj = 0; bj < 2; ++bj)
#pragma unroll
                    for (int n = 0; n < 2; ++n) acc[ai][bj][m][n] *= rstd; }
    }
    __device__ __forceinline__ void operator()(const f32x4 (&acc)[2][2][4][2], const Unit& u, int wr, int wc, int fr, int fq) const {
        const int b = u.pm >> 3; const float* mod = MOD + (size_t)b * 6144;
        const int row0 = u.pm * 256 + wr * 64 + fr, col0 = u.pn * 256 + wc * 32 + 8 * fq;
#pragma unroll
        for (int ai = 0; ai < 2; ++ai)
#pragma unroll
            for (int m = 0; m < 4; ++m) { const size_t row = (size_t)(row0 + ai * 128 + m * 16); float ss = 0.f;
#pragma unroll
                for (int bj = 0; bj < 2; ++bj) { const int col = col0 + bj * 128; float a2[8];
#pragma unroll
                    for (int n = 0; n < 2; ++n) { const int c4 = col + 4 * n;
                        const f32x4 xv = *(const f32x4*)(x + row * 1024 + c4); const f32x4 g1 = *(const f32x4*)(mod + 2048 + c4);
                        const f32x4 v = xv + g1 * acc[ai][bj][m][n];
                        *(f32x4*)(x1 + row * 1024 + c4) = v; ss += (v.x * v.x + v.y * v.y) + (v.z * v.z + v.w * v.w);
                        const f32x4 sc2 = *(const f32x4*)(mod + 4096 + c4); const f32x4 gg = *(const f32x4*)(g2n + c4);
                        const f32x4 a = v * gg * (sc2 + 1.0f); a2[4 * n] = a.x; a2[4 * n + 1] = a.y; a2[4 * n + 2] = a.z; a2[4 * n + 3] = a.w; }
                    v4u wv; wv.x = cvt_pk_bf16(a2[0], a2[1]); wv.y = cvt_pk_bf16(a2[2], a2[3]); wv.z = cvt_pk_bf16(a2[4], a2[5]); wv.w = cvt_pk_bf16(a2[6], a2[7]);
                    *(v4u*)(A2 + row * 1024 + col) = wv; }
                ss += __shfl_xor(ss, 16); ss += __shfl_xor(ss, 32);
                if (fq == 0) SSQ2[row * 16 + u.pn * 4 + wc] = ss; }
    }
};
struct EpiUp {
    static constexpr bool PERM = true, MID = false; int tmid;
    const float* SSQ2; const float* BIAS2; bf16* H;
    __device__ __forceinline__ void mid(f32x4 (&)[2][2][4][2], const Unit&, int, int, int, int) const {}
    __device__ __forceinline__ void operator()(const f32x4 (&acc)[2][2][4][2], const Unit& u, int wr, int wc, int fr, int fq) const {
        const int b = u.pm >> 3; const float* bias = BIAS2 + (size_t)b * DFF;
        const int row0 = u.pm * 256 + wr * 64 + fr, col0 = u.pn * 256 + wc * 32 + 8 * fq;
        f32x4 bv[2][2];
#pragma unroll
        for (int bj = 0; bj < 2; ++bj)
#pragma unroll
            for (int n = 0; n < 2; ++n) bv[bj][n] = *(const f32x4*)(bias + col0 + bj * 128 + 4 * n);
#pragma unroll
        for (int ai = 0; ai < 2; ++ai)
#pragma unroll
            for (int m = 0; m < 4; ++m) { const size_t row = (size_t)(row0 + ai * 128 + m * 16);
                const f32x4 p = *(const f32x4*)(SSQ2 + row * 16 + 4 * fq); float s = (p.x + p.y) + (p.z + p.w); s += __shfl_xor(s, 16); s += __shfl_xor(s, 32);
                const float rstd = 1.0f / sqrtf(s * (1.f / 1024.f) + EPS);
#pragma unroll
                for (int bj = 0; bj < 2; ++bj) { f32x4 v0 = acc[ai][bj][m][0] * rstd + bv[bj][0], v1 = acc[ai][bj][m][1] * rstd + bv[bj][1];
                    float h[8] = {v0[0], v0[1], v0[2], v0[3], v1[0], v1[1], v1[2], v1[3]};
#pragma unroll
                    for (int e = 0; e < 8; ++e) { const float r = fmaxf(h[e], 0.f); h[e] = r * r; }
                    v4u wv; wv.x = cvt_pk_bf16(h[0], h[1]); wv.y = cvt_pk_bf16(h[2], h[3]); wv.z = cvt_pk_bf16(h[4], h[5]); wv.w = cvt_pk_bf16(h[6], h[7]);
                    *(v4u*)(H + row * DFF + col0 + bj * 128) = wv; } }
    }
};
struct EpiDown {
    static constexpr bool PERM = false, MID = false; int tmid;
    float* out; const float* MOD;
    __device__ __forceinline__ void mid(f32x4 (&)[2][2][4][2], const Unit&, int, int, int, int) const {}
    __device__ __forceinline__ void operator()(const f32x4 (&acc)[2][2][4][2], const Unit& u, int wr, int wc, int fr, int fq) const {
        const int b = u.pm >> 3; const float* g2 = MOD + (size_t)b * 6144 + 5120;
        const int row0 = u.pm * 256 + wr * 64 + fr, col0 = u.pn * 256 + wc * 32 + 4 * fq;
        f32x4 gv[2][2];
#pragma unroll
        for (int bj = 0; bj < 2; ++bj)
#pragma unroll
            for (int n = 0; n < 2; ++n) gv[bj][n] = *(const f32x4*)(g2 + col0 + bj * 128 + n * 16);
#pragma unroll
        for (int ai = 0; ai < 2; ++ai)
#pragma unroll
            for (int m = 0; m < 4; ++m) { float* rowp = out + (size_t)(row0 + ai * 128 + m * 16) * 1024 + col0;
#pragma unroll
                for (int bj = 0; bj < 2; ++bj)
#pragma unroll
                    for (int n = 0; n < 2; ++n) { const f32x4 x1 = *(const f32x4*)(rowp + bj * 128 + n * 16); *(f32x4*)(rowp + bj * 128 + n * 16) = x1 + gv[bj][n] * acc[ai][bj][m][n]; } }
    }
};

__device__ __forceinline__ float gelu_tanh(float v) {
    const float a = 0.7978845608028654f * (v + 0.044715f * v * v * v);
    const float th = 1.f - 2.f / (__expf(2.f * a) + 1.f);
    return 0.5f * v * (1.f + th);
}
__device__ __forceinline__ void bias2_item(Frame& F, int item, LAS float* scr) {
    const int b = item >> 6, n = (item & 63) * 64 + F.lane;
    for (int e = F.lane; e < 1024; e += 64) scr[e] = F.MOD[(size_t)b * 6144 + 3072 + e];
    LDS_WAIT(); asm volatile("" ::: "memory");
    float acc = 0.f;
#pragma unroll 8
    for (int k = 0; k < 1024; ++k) acc += scr[k] * F.w_ff1[(size_t)k * DFF + n];
    F.BIAS2[(size_t)b * DFF + n] = acc;
    LDS_WAIT(); asm volatile("" ::: "memory");
}
__device__ __forceinline__ void ssm_naive_unit(Frame& F, int b, int g, LAS unsigned char* wl) {
    const int lane = F.lane;
    LAS f32x2* Cl = (LAS f32x2*)wl;
    LAS f32x2* xs = Cl + 16 * 65;
#pragma unroll
    for (int c = 0; c < 16; ++c) Cl[c * 65 + lane] = (f32x2){F.c_re[(g * 16 + c) * 64 + lane], F.c_im[(g * 16 + c) * 64 + lane]};
    const f32x2 lam = F.LAMB[g * 64 + lane];
    f32x2 Bb[16];
#pragma unroll
    for (int c = 0; c < 16; ++c) Bb[c] = F.BBAR[(g * 64 + lane) * 16 + c];
    float dsk[4];
#pragma unroll
    for (int k = 0; k < 4; ++k) dsk[k] = F.d_skip[g * 16 + (lane >> 4) * 4 + k];
    LDS_WAIT(); asm volatile("" ::: "memory");
    float xr = 0.f, xi = 0.f;
    for (int ch = 0; ch < SEQ / 16; ++ch) {
        const int t0 = ch * 16;
#pragma unroll 4
        for (int tt = 0; tt < 16; ++tt) {
            const bf16* up = F.U + ((size_t)b * SEQ + t0 + tt) * 512 + g * 16;
            const v4u ua = *(const v4u*)up, ub = *(const v4u*)(up + 8);
            const float u[16] = {bflo(ua.x), bfhi(ua.x), bflo(ua.y), bfhi(ua.y), bflo(ua.z), bfhi(ua.z), bflo(ua.w), bfhi(ua.w),
                                 bflo(ub.x), bfhi(ub.x), bflo(ub.y), bfhi(ub.y), bflo(ub.z), bfhi(ub.z), bflo(ub.w), bfhi(ub.w)};
            float br = 0.f, bi = 0.f;
#pragma unroll
            for (int c = 0; c < 16; ++c) { br += Bb[c].x * u[c]; bi += Bb[c].y * u[c]; }
            const float nr = lam.x * xr - lam.y * xi + br, ni = lam.x * xi + lam.y * xr + bi; xr = nr; xi = ni;
            xs[tt * 65 + lane] = (f32x2){xr, xi};
        }
        LDS_WAIT(); asm volatile("" ::: "memory");
        const int tt = lane & 15, cq = lane >> 4;
        float y[4] = {0.f, 0.f, 0.f, 0.f};
#pragma unroll 4
        for (int p = 0; p < 64; ++p) { const f32x2 xv = xs[tt * 65 + p];
#pragma unroll
            for (int k = 0; k < 4; ++k) { const f32x2 cv = Cl[(cq * 4 + k) * 65 + p]; y[k] += cv.x * xv.x - cv.y * xv.y; } }
        const size_t off = ((size_t)b * SEQ + t0 + tt) * 512 + g * 16 + cq * 4;
        const v2u uu = *(const v2u*)(F.U + off);
        const float uf[4] = {bflo(uu.x), bfhi(uu.x), bflo(uu.y), bfhi(uu.y)};
        float z[4];
#pragma unroll
        for (int k = 0; k < 4; ++k) z[k] = gelu_tanh(y[k] + dsk[k] * uf[k]);
        *(v2u*)(F.Z + off) = (v2u){pk2(z[0], z[1]), pk2(z[2], z[3])};
        LDS_WAIT(); asm volatile("" ::: "memory");
    }
}

__device__ __forceinline__ unsigned fkey(float f) { const unsigned u = __float_as_uint(f); return (u & 0x80000000u) ? ~u : (u | 0x80000000u); }

__device__ __forceinline__ void attn_naive_query(Frame& F, int b, int t, LAS unsigned char* wl) {
    const int lane = F.lane; const size_t m = (size_t)b * SEQ + t;
    LAS float* qi = (LAS float*)wl;
    LAS float* qn = qi + 512;
    LAS unsigned* keys = (LAS unsigned*)(qn + 512);
    LAS unsigned* sel = keys + 2048;
    LAS float* pl = (LAS float*)keys;
    { const f32x4 a = *(const f32x4*)(F.QI + m * 512 + lane * 8), bq = *(const f32x4*)(F.QI + m * 512 + lane * 8 + 4);
      *(LAS f32x4*)(qi + lane * 8) = a; *(LAS f32x4*)(qi + lane * 8 + 4) = bq; }
    LAS float* wi = (LAS float*)(sel + 256);
    if (lane < 8) wi[lane] = F.WI[m * 8 + lane];
    { const v4u qv = *(const v4u*)(F.Q + m * 512 + lane * 8);
      float q[8] = {bflo(qv.x), bfhi(qv.x), bflo(qv.y), bfhi(qv.y), bflo(qv.z), bfhi(qv.z), bflo(qv.w), bfhi(qv.w)};
      float ss = 0.f;
#pragma unroll
      for (int j = 0; j < 8; ++j) ss += q[j] * q[j];
      ss += __shfl_xor(ss, 1); ss += __shfl_xor(ss, 2); ss += __shfl_xor(ss, 4);
      const float rstd = 1.0f / sqrtf(ss * (1.f / 64.f) + EPS); const int d0 = (lane & 7) * 8;
#pragma unroll
      for (int j = 0; j < 8; ++j) qn[lane * 8 + j] = q[j] * rstd * F.q_gain[d0 + j] * 0.125f; }
    LDS_WAIT(); asm volatile("" ::: "memory");
#pragma unroll 1
    for (int j = 0; j < 32; ++j) {
        const int s = lane + 64 * j; unsigned key = 0u;
        if (s <= t) {
            const float* kp = F.KI + ((size_t)b * SEQ + s) * 64;
            f32x4 kk[16];
#pragma unroll
            for (int i = 0; i < 16; ++i) kk[i] = *(const f32x4*)(kp + 4 * i);
            float sc = 0.f;
#pragma unroll 1
            for (int h = 0; h < 8; ++h) { float d = 0.f;
#pragma unroll
                for (int i = 0; i < 16; ++i) { const f32x4 qv = *(const LAS f32x4*)(qi + h * 64 + 4 * i); d += (qv.x * kk[i].x + qv.y * kk[i].y) + (qv.z * kk[i].z + qv.w * kk[i].w); }
                sc += wi[h] * fmaxf(d, 0.f); }
            key = fkey(sc * IDX_SCALE + 0.0f);
        }
        keys[s] = key;
    }
    LDS_WAIT(); asm volatile("" ::: "memory");
    unsigned kreg[32];
#pragma unroll
    for (int j = 0; j < 32; ++j) kreg[j] = keys[lane + 64 * j];
    LDS_WAIT(); asm volatile("" ::: "memory");
    const int n = t + 1; unsigned tau = 0u; int need = 0;
    if (n > TOPK) {
#pragma unroll 1
        for (int bit = 31; bit >= 0; --bit) { const unsigned cand = tau | (1u << bit); int c = 0;
#pragma unroll
            for (int j = 0; j < 32; ++j) c += (kreg[j] >= cand) ? 1 : 0;
            c = wave_sum_i(c); if (c >= TOPK) tau = cand; }
        int cg = 0;
#pragma unroll
        for (int j = 0; j < 32; ++j) cg += (kreg[j] > tau) ? 1 : 0;
        cg = wave_sum_i(cg); need = TOPK - cg;
    }
    const unsigned long long lt = (1ull << lane) - 1ull;
    int base = 0, eqb = 0;
#pragma unroll
    for (int j = 0; j < 32; ++j) {
        const int s = lane + 64 * j; bool sf;
        if (n > TOPK) { const bool gt = kreg[j] > tau, eq = kreg[j] == tau; const unsigned long long em = __ballot(eq);
            const int rank = eqb + __popcll(em & lt); sf = gt || (eq && rank < need); eqb += __popcll(em); }
        else sf = (s <= t);
        const unsigned long long sm = __ballot(sf);
        if (sf) sel[base + __popcll(sm & lt)] = (unsigned)s;
        base += __popcll(sm);
    }
    const int nsel = base;
#pragma unroll
    for (int i = 0; i < 4; ++i) { const int idx = lane + 64 * i; if (idx >= nsel) sel[idx] = 0u; }
    LDS_WAIT(); asm volatile("" ::: "memory");
#pragma unroll 1
    for (int i = 0; i < 4; ++i) {
        const int idx = lane + 64 * i; const bool act = idx < nsel; const unsigned s = sel[idx];
        const bf16* kp = F.KV + ((size_t)b * SEQ + s) * 256;
#pragma unroll 1
        for (int kvh = 0; kvh < 2; ++kvh) {
            float k[64]; float ss = 0.f;
#pragma unroll
            for (int c8 = 0; c8 < 8; ++c8) { const v4u kv = *(const v4u*)(kp + kvh * 64 + c8 * 8);
                k[c8 * 8 + 0] = bflo(kv.x); k[c8 * 8 + 1] = bfhi(kv.x); k[c8 * 8 + 2] = bflo(kv.y); k[c8 * 8 + 3] = bfhi(kv.y);
                k[c8 * 8 + 4] = bflo(kv.z); k[c8 * 8 + 5] = bfhi(kv.z); k[c8 * 8 + 6] = bflo(kv.w); k[c8 * 8 + 7] = bfhi(kv.w); }
#pragma unroll
            for (int d = 0; d < 64; ++d) ss += k[d] * k[d];
            const float rstd = 1.0f / sqrtf(ss * (1.f / 64.f) + EPS);
#pragma unroll
            for (int d = 0; d < 64; ++d) k[d] *= rstd * F.k_gain[d];
#pragma unroll 1
            for (int gq = 0; gq < 4; ++gq) { const int h = kvh * 4 + gq; float d = 0.f;
#pragma unroll
                for (int i4 = 0; i4 < 16; ++i4) { const f32x4 qv = *(const LAS f32x4*)(qn + h * 64 + 4 * i4); d += (qv.x * k[4 * i4] + qv.y * k[4 * i4 + 1]) + (qv.z * k[4 * i4 + 2] + qv.w * k[4 * i4 + 3]); }
                pl[idx * 8 + h] = act ? d : -INFINITY; }
        }
    }
    LDS_WAIT(); asm volatile("" ::: "memory");
    {
        float l[4][8];
#pragma unroll
        for (int i = 0; i < 4; ++i) { const f32x4 a = *(const LAS f32x4*)(pl + (lane + 64 * i) * 8), c = *(const LAS f32x4*)(pl + (lane + 64 * i) * 8 + 4);
            l[i][0] = a.x; l[i][1] = a.y; l[i][2] = a.z; l[i][3] = a.w; l[i][4] = c.x; l[i][5] = c.y; l[i][6] = c.z; l[i][7] = c.w; }
#pragma unroll
        for (int h = 0; h < 8; ++h) {
            float mx = fmaxf(fmaxf(l[0][h], l[1][h]), fmaxf(l[2][h], l[3][h])); mx = wave_max(mx);
            float sum = 0.f;
#pragma unroll
            for (int i = 0; i < 4; ++i) { l[i][h] = __expf(l[i][h] - mx); sum += l[i][h]; }
            sum = wave_sum(sum); const float inv = 1.0f / sum;
#pragma unroll
            for (int i = 0; i < 4; ++i) l[i][h] *= inv;
        }
        LDS_WAIT(); asm volatile("" ::: "memory");
#pragma unroll
        for (int i = 0; i < 4; ++i) { *(LAS f32x4*)(pl + (lane + 64 * i) * 8) = (f32x4){l[i][0], l[i][1], l[i][2], l[i][3]}; *(LAS f32x4*)(pl + (lane + 64 * i) * 8 + 4) = (f32x4){l[i][4], l[i][5], l[i][6], l[i][7]}; }
    }
    LDS_WAIT(); asm volatile("" ::: "memory");
    float o[8];
#pragma unroll
    for (int h = 0; h < 8; ++h) o[h] = 0.f;
    const int nsel4 = (nsel + 3) & ~3;
    for (int n0 = 0; n0 < nsel4; n0 += 4) {
#pragma unroll
        for (int u = 0; u < 4; ++u) {
            const unsigned s = sel[n0 + u]; const bf16* vp = F.KV + ((size_t)b * SEQ + s) * 256 + 128;
            const float v0 = bf2f(vp[lane]), v1 = bf2f(vp[64 + lane]);
            const f32x4 pa = *(const LAS f32x4*)(pl + (n0 + u) * 8), pb = *(const LAS f32x4*)(pl + (n0 + u) * 8 + 4);
            o[0] += pa.x * v0; o[1] += pa.y * v0; o[2] += pa.z * v0; o[3] += pa.w * v0;
            o[4] += pb.x * v1; o[5] += pb.y * v1; o[6] += pb.z * v1; o[7] += pb.w * v1;
        }
    }
    float ss = 0.f;
#pragma unroll
    for (int h = 0; h < 8; ++h) ss += o[h] * o[h];
    ss = wave_sum(ss); const float rstd = 1.0f / sqrtf(ss * (1.f / 512.f) + EPS);
#pragma unroll
    for (int h = 0; h < 8; ++h) F.MIX[m * 1024 + 512 + h * 64 + lane] = (bf16)f2bf(o[h] * rstd);
    LDS_WAIT(); asm volatile("" ::: "memory");
}

__device__ __forceinline__ void p3_phase(Frame& F) {
    LAS unsigned char* wl = F.lds + RING_OFF + F.wave * WAVE_LDS;
    const int gw = F.vcu * NWAVES + F.wave, NGW = F.G * NWAVES;
    for (int it = gw; it < 1024; it += NGW) bias2_item(F, it, (LAS float*)wl);
    for (int it = gw; it < BATCH * NG; it += NGW) ssm_naive_unit(F, it >> 5, it & 31, wl);
    for (int wv = gw; wv < BATCH * 128; wv += NGW) {
        const int b = wv >> 7, r = wv & 127;
        for (int j = 0; j < 16; ++j) { const int t = (j & 1) ? 128 * j + (127 - r) : 128 * j + r; attn_naive_query(F, b, t, wl); }
    }
}

struct Args { const float* in[24]; float* out; unsigned char* ws; int ph_lo, ph_hi, li, pad; };
__global__ void __launch_bounds__(NWAVES * 64, 2) fwd_kernel(Args args) {
    extern __shared__ __attribute__((aligned(16))) unsigned char lds[];
    Frame F;
    F.lds = (LAS unsigned char*)lds;
    F.MISC = (volatile LAS unsigned*)(F.lds + MISC_OFF);
    F.tid = threadIdx.x; F.lane = F.tid & 63; F.wave = __builtin_amdgcn_readfirstlane(F.tid >> 6);
    F.G = gridDim.x; { const int bx = blockIdx.x; F.vcu = (F.G % 8 == 0) ? (bx % 8) * (F.G / 8) + bx / 8 : bx; }
    unsigned char* ws = args.ws;
    F.ctl = (gu32*)(ws + WS_CTL);
    F.x = args.in[0]; F.c = args.in[1]; F.norm1_g = args.in[2]; F.norm2_g = args.in[3]; F.w_ada = args.in[4]; F.b_ada = args.in[5]; F.w_in = args.in[6];
    F.lam_re = args.in[7]; F.lam_im = args.in[8]; F.log_dt = args.in[9]; F.b_re = args.in[10]; F.b_im = args.in[11]; F.c_re = args.in[12]; F.c_im = args.in[13];
    F.d_skip = args.in[14]; F.w_glu = args.in[15]; F.b_glu = args.in[16]; F.q_gain = args.in[17]; F.k_gain = args.in[18]; F.gn_ssm = args.in[19]; F.gn_attn = args.in[20];
    F.w_out = args.in[21]; F.w_ff1 = args.in[22]; F.w_ff2 = args.in[23]; F.out = args.out;
    F.MODP = (float*)(ws + WS_MODP); F.MOD = (float*)(ws + WS_MOD); F.BIAS2 = (float*)(ws + WS_BIAS2); F.SSQS = (float*)(ws + WS_SSQS); F.SSQ2 = (float*)(ws + WS_SSQ2);
    F.KI = (float*)(ws + WS_KI); F.WI = (float*)(ws + WS_WI); F.QI = (float*)(ws + WS_QI);
    F.LAMB = (f32x2*)(ws + WS_SSMP); F.BBAR = (f32x2*)(ws + WS_SSMP + 16384);
    F.WINP = (bf16*)(ws + WS_WINP); F.WINI = (bf16*)(ws + WS_WINI); F.WGLU = (bf16*)(ws + WS_WGLU); F.WOUT = (bf16*)(ws + WS_WOUT); F.W1 = (bf16*)(ws + WS_W1); F.W2 = (bf16*)(ws + WS_W2);
    F.U = (bf16*)(ws + WS_U); F.Q = (bf16*)(ws + WS_Q); F.A2 = (bf16*)(ws + WS_A2); F.XN = (bf16*)(ws + WS_XN); F.KV = (bf16*)(ws + WS_KV); F.Z = (bf16*)(ws + WS_Z); F.MIX = (bf16*)(ws + WS_MIX); F.H = (bf16*)(ws + WS_H);
    for (int u = F.tid; u < (LDS_BYTES - LDSCTL_OFF) / 4; u += NWAVES * 64) ((LAS unsigned*)(F.lds + LDSCTL_OFF))[u] = 0u;
    __syncthreads();
    XcdBarrier bar; bar.bar = (unsigned*)(F.ctl + CW_BAR); bar.x = 0; bar.st = nullptr;
    if (N_LAUNCHES == 1) bar = xcd_barrier_post((unsigned*)(F.ctl + CW_BAR), F.MISC + 8);
#define GRID_BAR() do { if (N_LAUNCHES == 1) xcd_barrier(bar); } while (0)
    const int lo = args.ph_lo, hi = args.ph_hi;
#ifndef PHASE_MASK
#define PHASE_MASK 0xFF
#endif
#define IN(k) (((PHASE_MASK >> (k)) & 1) && lo <= (k) && (k) < hi)
#define BOTH(k) (IN(k) && IN((k) + 1))

    if (IN(0)) { p0a_phase(F); if (BOTH(0)) GRID_BAR(); }
    if (IN(1)) { p0b_phase(F); if (BOTH(1)) GRID_BAR(); }
    if (IN(2)) {
        { pg8::Gemm g{F.XN, F.WINP, M, N_PLAIN, 1024, 2048, 1 << 30}; pg8::StaticOrder S; S.init(M, N_PLAIN, F.G, (int)blockIdx.x);
          EpiInPlain E{0, F.U, F.Q, F.KV};
          pg8::gemm_phase<EpiInPlain, pg8::StaticOrder, true>(F.lds + RING_OFF, g, S, E); }
        { pg8::Gemm g{F.XN, F.WINI, M, N_IDX_PAD, K3, 2048, 32}; pg8::StaticOrder S; S.init(M, N_IDX_PAD, F.G, F.G - 1 - (int)blockIdx.x);
          EpiInIdx E{0, F.QI, F.KI, F.WI};
          pg8::gemm_phase<EpiInIdx, pg8::StaticOrder, true>(F.lds + RING_OFF, g, S, E); }
        if (BOTH(2)) GRID_BAR();
    }
    if (IN(3)) { p3_phase(F); if (BOTH(3)) GRID_BAR(); }
    if (IN(4)) {
        pg8::Gemm g{F.Z, F.WGLU, M, 512, 512, 512, 1 << 30}; pg8::StaticOrder S; S.init(M, 512, F.G, (int)blockIdx.x);
        EpiGlu E{0, F.Z, F.MIX, F.b_glu, F.SSQS};
        pg8::gemm_phase<EpiGlu, pg8::StaticOrder, true>(F.lds + RING_OFF, g, S, E);
        if (BOTH(4)) GRID_BAR();
    }
    if (IN(5)) {
        pg8::Gemm g{F.MIX, F.WOUT, M, 1024, 1024, 1024, 1 << 30}; pg8::StaticOrder S; S.init(M, 1024, F.G, (int)blockIdx.x);
        EpiOut E{8, F.x, F.out, F.A2, F.MOD, F.norm2_g, F.SSQS, F.SSQ2};
        pg8::gemm_phase<EpiOut, pg8::StaticOrder, true>(F.lds + RING_OFF, g, S, E);
        if (BOTH(5)) GRID_BAR();
    }
    if (IN(6)) {
        pg8::Gemm g{F.A2, F.W1, M, DFF, 1024, 1024, 1 << 30}; pg8::StaticOrder S; S.init(M, DFF, F.G, (int)blockIdx.x);
        EpiUp E{0, F.SSQ2, F.BIAS2, F.H};
        pg8::gemm_phase<EpiUp, pg8::StaticOrder, true>(F.lds + RING_OFF, g, S, E);
        if (BOTH(6)) GRID_BAR();
    }
    if (IN(7)) {
        pg8::Gemm g{F.H, F.W2, M, 1024, DFF, DFF, 1 << 30}; pg8::StaticOrder S; S.init(M, 1024, F.G, (int)blockIdx.x);
        EpiDown E{0, F.out, F.MOD};
        pg8::gemm_phase<EpiDown, pg8::StaticOrder, true>(F.lds + RING_OFF, g, S, E);
    }
#undef IN
#undef BOTH
}

extern "C" void kernel_launch(void* const* d_in, const int* in_sizes, int n_in, void* d_out, int out_size, void* d_ws, size_t ws_size, hipStream_t stream) {
    static int grid = 0;
    if (grid == 0) {
        if (n_in != 24 || in_sizes[0] != M * DM || out_size != M * DM || ws_size < WS_END) { fprintf(stderr, "kernel_launch: unexpected shapes (n_in %d, in0 %d, out %d, ws %zu); nothing launched\n", n_in, n_in > 0 ? in_sizes[0] : -1, out_size, ws_size); grid = -1; return; }
        int dev = 0, cus = 0, per_cu = 0;
        if (hipGetDevice(&dev) != hipSuccess || hipDeviceGetAttribute(&cus, hipDeviceAttributeMultiprocessorCount, dev) != hipSuccess) { fprintf(stderr, "kernel_launch: device query failed\n"); grid = -1; return; }
        if (hipFuncSetAttribute((const void*)fwd_kernel, hipFuncAttributeMaxDynamicSharedMemorySize, LDS_BYTES) != hipSuccess) { fprintf(stderr, "kernel_launch: hipFuncSetAttribute failed\n"); grid = -1; return; }
        if (hipOccupancyMaxActiveBlocksPerMultiprocessor(&per_cu, (const void*)fwd_kernel, NWAVES * 64, LDS_BYTES) != hipSuccess || per_cu < 1)
            fprintf(stderr, "kernel_launch: note: occupancy query reports %d workgroups per CU\n", per_cu);
        (void)hipGetLastError();
        grid = cus;
    }
    if (grid < 0) return;
    if (hipMemsetAsync((char*)d_ws + WS_CTL, 0, CTL_ZERO_BYTES, stream) != hipSuccess) { fprintf(stderr, "kernel_launch: memset failed\n"); return; }
    Args a{};
    for (int i = 0; i < 24; ++i) a.in[i] = (const float*)d_in[i];
    a.out = (float*)d_out; a.ws = (unsigned char*)d_ws;
    for (int li = 0; li < N_LAUNCHES; ++li) {
        a.ph_lo = (N_LAUNCHES == 1) ? 0 : li; a.ph_hi = (N_LAUNCHES == 1) ? NPHASE : li + 1; a.li = li;
        hipLaunchKernelGGL(fwd_kernel, dim3(grid), dim3(NWAVES * 64), LDS_BYTES, stream, a);
        const hipError_t le = hipPeekAtLastError();
        if (le != hipSuccess) { fprintf(stderr, "kernel_launch: launch %d failed: %s\n", li, hipGetErrorName(le)); break; }
    }
}
```

```cpp
#include <hip/hip_runtime.h>
#include <cstdio>
#include <cstdint>

#ifndef MK_N_LAUNCHES
#define MK_N_LAUNCHES 1
#endif

namespace pg8 {
#define PG8_LAS __attribute__((address_space(3)))
typedef unsigned short bf16_t;
typedef short bf16x8 __attribute__((ext_vector_type(8)));
typedef float f32x4 __attribute__((ext_vector_type(4)));
typedef unsigned u32x4 __attribute__((ext_vector_type(4)));
typedef unsigned u32x2 __attribute__((ext_vector_type(2)));
constexpr int BM = 256, BK = 64, HALF = 128, HTB = HALF * BK * 2, STAGE_BYTES = 8 * HTB, NXCD = 8, WGM = 8;

__host__ __device__ __forceinline__ int lds_byte(int r, int c) { const int st = (r >> 4) * 2 + (c >> 5), rr = r & 15, cc = c & 31, ob = rr * 64 + cc * 2; return st * 1024 + (ob ^ (((ob >> 9) & 1) << 5)); }
__host__ __device__ __forceinline__ void stage_rc(int b, int& R, int& C) { const int st = b / 1024, sb = b % 1024, swz = sb ^ (((sb >> 9) & 1) << 5); R = (st >> 1) * 16 + swz / 64; C = (st & 1) * 32 + (swz % 64) / 2; }
__host__ __device__ __forceinline__ int perm32(int rho) { const int n = rho >> 4, i = rho & 15; return 8 * (i >> 2) + 4 * n + (i & 3); }

struct Unit { int pm, pn; };
struct Gemm { const bf16_t* A; const bf16_t* Bt; int M, N, K, lda, wrapA; };

struct StaticOrder {
    int nM, nN, nwg, G, c;
    __host__ __device__ void init(int M, int N, int G_, int c_) { nM = M / BM; nN = N / BM; nwg = nM * nN; G = G_; c = c_; }
    __host__ __device__ bool next(int i, Unit& u) const {
        const long L = (long)i * G + c; if (L >= nwg) return false;
        int wgid = (int)L; { const int q = nwg / NXCD, r = nwg % NXCD, xcd = wgid % NXCD, off = wgid / NXCD; wgid = (xcd < r ? xcd * (q + 1) : r * (q + 1) + (xcd - r) * q) + off; }
        const int nig = WGM * nN, gid = wgid / nig, fm = gid * WGM, gsz = (nM - fm) < WGM ? (nM - fm) : WGM;
        u.pm = fm + ((wgid % nig) % gsz); u.pn = (wgid % nig) / gsz; return true;
    }
};

__device__ __forceinline__ unsigned cvt_pk_bf16(float lo, float hi) { unsigned r; asm volatile("v_cvt_pk_bf16_f32 %0, %1, %2" : "=v"(r) : "v"(lo), "v"(hi)); return r; }

template <class Epi, class Sched, bool ALIGN_EPI>
__device__ __forceinline__ void gemm_phase(PG8_LAS unsigned char* lds, const Gemm g, const Sched& S, const Epi& E) {
    const int tid = threadIdx.x, wid = __builtin_amdgcn_readfirstlane(tid >> 6), lane = tid & 63, wr = wid >> 2, wc = wid & 3, fr = lane & 15, fq = lane >> 4;
    const int K = g.K, nt = K / BK, lda = g.lda, wrapA = g.wrapA;
    unsigned voffA[2], voffB[2];
#pragma unroll
    for (int i = 0; i < 2; ++i) { int R, C; stage_rc(tid * 16 + i * 8192, R, C); const int Rb = Epi::PERM ? ((R & ~31) + perm32(R & 31)) : R;
        voffA[i] = (unsigned)(R * lda + C) * 2u; voffB[i] = (unsigned)(Rb * K + C) * 2u; }
    const size_t kstep = (size_t)(BK * 2);
    const size_t hsA = (size_t)HALF * lda * 2, hsB = (size_t)HALF * K * 2;
    const size_t tsA = 2 * hsA, tsB = 2 * hsB;
    const unsigned ldsw = (unsigned)wid * 1024u;
    const int aoff = lds_byte(wr * 64 + fr, fq * 8), boff = lds_byte(wc * 32 + fr, fq * 8);
#define PG8_SA(b, h) (((b) * 2 + (h)) * HTB)
#define PG8_SB(b, h) ((4 + (b) * 2 + (h)) * HTB)
#define PG8_STAGE(bufoff, gbase, voff) do { _Pragma("unroll") for (int _i = 0; _i < 2; ++_i) \
        __builtin_amdgcn_global_load_lds((const unsigned*)((const char*)(gbase) + (voff)[_i]), (PG8_LAS unsigned*)(lds + (bufoff) + ldsw + _i * 8192), 16, 0, 0); } while (0)
#define PG8_LDA(dst, b, h) do { _Pragma("unroll") for (int m = 0; m < 4; ++m) _Pragma("unroll") for (int k = 0; k < 2; ++k) dst[m][k] = *(const PG8_LAS bf16x8*)(lds + PG8_SA(b, h) + aoff + m * 2048 + k * 1024); } while (0)
#define PG8_LDB(dst, b, h) do { _Pragma("unroll") for (int n = 0; n < 2; ++n) _Pragma("unroll") for (int k = 0; k < 2; ++k) dst[n][k] = *(const PG8_LAS bf16x8*)(lds + PG8_SB(b, h) + boff + n * 2048 + k * 1024); } while (0)
#define PG8_MMA(ai, bj, At, Bt) do { __builtin_amdgcn_s_setprio(1); _Pragma("unroll") for (int m = 0; m < 4; ++m) _Pragma("unroll") for (int n = 0; n < 2; ++n) _Pragma("unroll") for (int k = 0; k < 2; ++k) \
        acc[ai][bj][m][n] = __builtin_amdgcn_mfma_f32_16x16x32_bf16(Bt[n][k], At[m][k], acc[ai][bj][m][n], 0, 0, 0); __builtin_amdgcn_s_setprio(0); } while (0)
#define PG8_WAIT_V(n) asm volatile("s_waitcnt vmcnt(" #n ")" ::: "memory")
#define PG8_WAIT_L(n) asm volatile("s_waitcnt lgkmcnt(" #n ")" ::: "memory")
#define PG8_BAR __builtin_amdgcn_s_barrier()
#define PG8_SCHED __builtin_amdgcn_sched_barrier(0)
#define PG8_AT(t) ((t) >= wrapA ? (t) - wrapA : (t))
    Unit cur, nxt; int ui = 0;
    if (!S.next(0, cur)) return;
    f32x4 acc[2][2][4][2];
#pragma unroll
    for (int a = 0; a < 2; ++a)
#pragma unroll
        for (int b = 0; b < 2; ++b)
#pragma unroll
            for (int m = 0; m < 4; ++m)
#pragma unroll
                for (int n = 0; n < 2; ++n) acc[a][b][m][n] = (f32x4){0.f, 0.f, 0.f, 0.f};
    bf16x8 At[4][2], B0[2][2], B1[2][2];
    const char* cA = (const char*)g.A + (size_t)cur.pm * tsA; const char* cB = (const char*)g.Bt + (size_t)cur.pn * tsB;
    PG8_STAGE(PG8_SB(0, 0), cB, voffB); PG8_STAGE(PG8_SB(0, 1), cB + hsB, voffB); PG8_STAGE(PG8_SA(0, 0), cA, voffA); PG8_STAGE(PG8_SA(0, 1), cA + hsA, voffA);
    if (wr == 1) PG8_BAR;
    PG8_WAIT_V(2); PG8_BAR;
    PG8_STAGE(PG8_SB(1, 0), cB + kstep, voffB); PG8_STAGE(PG8_SA(1, 0), cA + kstep, voffA); PG8_STAGE(PG8_SB(1, 1), cB + hsB + kstep, voffB);
    PG8_WAIT_V(6); PG8_BAR;
    for (;;) {
        const bool has_next = S.next(ui + 1, nxt);
        const char* nA = has_next ? (const char*)g.A + (size_t)nxt.pm * tsA : cA; const char* nB = has_next ? (const char*)g.Bt + (size_t)nxt.pn * tsB : cB;
        for (int t = 0; t < nt; t += 2) {
            const bool last = (t == nt - 2);
            const char* a1 = cA + (size_t)PG8_AT(t + 1) * kstep;
            const char* a2 = last ? nA : cA + (size_t)PG8_AT(t + 2) * kstep; const char* b2 = last ? nB : cB + (size_t)(t + 2) * kstep;
            const char* a3 = a2 + kstep; const char* b3 = b2 + kstep;
            if constexpr (Epi::MID) { if (t == E.tmid) E.mid(acc, cur, wr, wc, fr, fq); }
            PG8_LDB(B0, 0, 0); PG8_LDB(B1, 0, 1); PG8_SCHED; PG8_LDA(At, 0, 0); PG8_STAGE(PG8_SA(1, 1), a1 + hsA, voffA);
            PG8_WAIT_V(8); PG8_WAIT_L(0); PG8_BAR; PG8_MMA(0, 0, At, B0); PG8_MMA(0, 1, At, B1); PG8_BAR; PG8_SCHED;
            PG8_LDA(At, 0, 1); PG8_STAGE(PG8_SB(0, 0), b2, voffB); PG8_STAGE(PG8_SB(0, 1), b2 + hsB, voffB); PG8_STAGE(PG8_SA(0, 0), a2, voffA);
            PG8_WAIT_V(8); PG8_WAIT_L(0); PG8_BAR; PG8_MMA(1, 0, At, B0); PG8_MMA(1, 1, At, B1); PG8_BAR; PG8_SCHED;
            PG8_LDB(B0, 1, 0); PG8_LDB(B1, 1, 1); PG8_SCHED; PG8_LDA(At, 1, 0); PG8_STAGE(PG8_SA(0, 1), a2 + hsA, voffA);
            PG8_WAIT_V(8); PG8_WAIT_L(0); PG8_BAR; PG8_MMA(0, 0, At, B0); PG8_MMA(0, 1, At, B1); PG8_BAR; PG8_SCHED;
            PG8_LDA(At, 1, 1); PG8_STAGE(PG8_SB(1, 0), b3, voffB); PG8_STAGE(PG8_SB(1, 1), b3 + hsB, voffB); PG8_STAGE(PG8_SA(1, 0), a3, voffA);
            PG8_WAIT_V(8); PG8_WAIT_L(0); PG8_BAR; PG8_MMA(1, 0, At, B0); PG8_MMA(1, 1, At, B1); PG8_BAR; PG8_SCHED;
        }
        if constexpr (ALIGN_EPI) { if (wr == 0) PG8_BAR; }
        E(acc, cur, wr, wc, fr, fq);
        if (!has_next) break;
#pragma unroll
        for (int a = 0; a < 2; ++a)
#pragma unroll
            for (int b = 0; b < 2; ++b)
#pragma unroll
                for (int m = 0; m < 4; ++m)
#pragma unroll
                    for (int n = 0; n < 2; ++n) acc[a][b][m][n] = (f32x4){0.f, 0.f, 0.f, 0.f};
        cur = nxt; cA = nA; cB = nB; ++ui;
        if constexpr (ALIGN_EPI) { if (wr == 1) PG8_BAR; }
    }
    PG8_WAIT_V(0);
    if constexpr (!ALIGN_EPI) { if (wr == 0) PG8_BAR; }
    PG8_BAR;
#undef PG8_SA
#undef PG8_SB
#undef PG8_STAGE
#undef PG8_LDA
#undef PG8_LDB
#undef PG8_MMA
#undef PG8_WAIT_V
#undef PG8_WAIT_L
#undef PG8_BAR
#undef PG8_SCHED
#undef PG8_AT
}
}

constexpr int NWAVES = 8;
constexpr int NPHASE = 8;
constexpr int N_LAUNCHES = MK_N_LAUNCHES;
constexpr int BATCH = 16, SEQ = 2048, DM = 1024, M = BATCH * SEQ;
constexpr int D_SSM = 512, NG = 32, GC = 16, NP = 64, D_ATT = 512, HD = 64, NH = 8, IH = 8, ID = 64, TOPK = 256, DFF = 4096, D_IN = 1864;
constexpr int N_PLAIN = 1280, N_IDX_PAD = 768, K3 = 3072;
constexpr float EPS = 1e-6f;
constexpr float IDX_SCALE = 0.125f * 0.35355339059327373f;

constexpr size_t MiB = 1u << 20;
constexpr size_t WS_CTL = 0, CTL_ZERO_BYTES = 1 * MiB;
constexpr size_t WS_MODP = 1 * MiB;
constexpr size_t WS_MOD = 4 * MiB;
constexpr size_t WS_BIAS2 = 4 * MiB + 512 * 1024;
constexpr size_t WS_SSQS = 5 * MiB;
constexpr size_t WS_SSQ2 = 6 * MiB;
constexpr size_t WS_WINP = 8 * MiB;
constexpr size_t WS_WINI = 11 * MiB;
constexpr size_t WS_WGLU = 16 * MiB;
constexpr size_t WS_WOUT = 17 * MiB;
constexpr size_t WS_W1 = 19 * MiB;
constexpr size_t WS_W2 = 27 * MiB;
constexpr size_t WS_SSMP = 35 * MiB;
constexpr size_t WS_U = 36 * MiB;
constexpr size_t WS_Q = 68 * MiB;
constexpr size_t WS_A2 = 36 * MiB;
constexpr size_t WS_XN = 100 * MiB;
constexpr size_t WS_KV = 228 * MiB;
constexpr size_t WS_KI = 244 * MiB;
constexpr size_t WS_WI = 252 * MiB;
constexpr size_t WS_QI = 256 * MiB;
constexpr size_t WS_Z = 320 * MiB;
constexpr size_t WS_MIX = 352 * MiB;
constexpr size_t WS_H = 256 * MiB;
constexpr size_t WS_END = 512 * MiB;
constexpr int CW_BAR = 4096;

constexpr int RING_OFF = 0;
constexpr int WAVE_LDS = 17920;
constexpr int LDSCTL_OFF = 143360, MISC_OFF = LDSCTL_OFF + 320;
constexpr int LDS_BYTES = 147456;

#define GAS __attribute__((address_space(1)))
#define LAS __attribute__((address_space(3)))
typedef unsigned short bf16;
typedef unsigned v4u __attribute__((ext_vector_type(4)));
typedef unsigned v2u __attribute__((ext_vector_type(2)));
typedef float f32x4 __attribute__((ext_vector_type(4)));
typedef float f32x2 __attribute__((ext_vector_type(2)));
typedef GAS unsigned gu32;
#define RLX_AGENT __ATOMIC_RELAXED, __HIP_MEMORY_SCOPE_AGENT
#define LDS_WAIT() asm volatile("s_waitcnt lgkmcnt(0)" ::: "memory")
#define VM_WAIT() asm volatile("s_waitcnt vmcnt(0)" ::: "memory")
__device__ __forceinline__ unsigned f2bf(float f) { unsigned u = __builtin_bit_cast(unsigned, f); return (u + 0x7fffu + ((u >> 16) & 1u)) >> 16; }
__device__ __forceinline__ unsigned pk2(float lo, float hi) { return f2bf(lo) | (f2bf(hi) << 16); }
__device__ __forceinline__ float bf2f(unsigned h) { return __builtin_bit_cast(float, h << 16); }
__device__ __forceinline__ float bflo(unsigned w) { return __builtin_bit_cast(float, w << 16); }
__device__ __forceinline__ float bfhi(unsigned w) { return __builtin_bit_cast(float, w & 0xffff0000u); }

#define XB_TMO      128
#define XB_XCNT(j)  (256  + 64 * (j))
#define XB_XSUB(j)  (1280 + 64 * (j))
#define XB_XGEN(j)  (2304 + 64 * (j))
#define XB_TOP      3328
#define XB_TOPGEN   3392
#define XCD_BAR_WORDS 3456
#define XB_SPIN_CAP (1u << 18)
__device__ __forceinline__ unsigned xb_ld(unsigned* p)              { return __hip_atomic_load(p, __ATOMIC_RELAXED, __HIP_MEMORY_SCOPE_AGENT); }
__device__ __forceinline__ unsigned xb_add(unsigned* p, unsigned v) { return __hip_atomic_fetch_add(p, v, __ATOMIC_RELAXED, __HIP_MEMORY_SCOPE_AGENT); }
__device__ __forceinline__ unsigned xb_xcc_id() { return (unsigned)__builtin_amdgcn_s_getreg((3 << 11) | 20) & 0xFu; }
#define XB_SPIN(cond, bar) do { unsigned _sp = 0; while (cond) { __builtin_amdgcn_s_sleep(1); \
    if ((++_sp & 255u) == 0u) { if (xb_ld(&(bar)[XB_TMO])) break; if (_sp > XB_SPIN_CAP) { atomicAdd(&(bar)[XB_TMO], 1u); break; } } } } while (0)
struct XcdBarrier { unsigned* bar; unsigned x; volatile LAS unsigned* st; };
__device__ __forceinline__ XcdBarrier xcd_barrier_post(unsigned* bar, volatile LAS unsigned* st) {
    XcdBarrier b; b.bar = bar; b.x = xb_xcc_id(); b.st = st;
    if (threadIdx.x == 0) (void)xb_add(&bar[XB_XCNT(b.x)], 1u);
    return b;
}
__device__ __forceinline__ void xcd_barrier_complete(unsigned* bar, unsigned x, unsigned& nloc, unsigned& nx) {
    const unsigned G = gridDim.x * gridDim.y * gridDim.z;
    unsigned sum, cnt, mine, sp = 0u;
    for (;;) {
        sum = 0u; cnt = 0u; mine = 0u;
#pragma unroll
        for (unsigned j = 0; j < 16; ++j) { const unsigned c = xb_ld(&bar[XB_XCNT(j)]); sum += c; cnt += (c > 0u) ? 1u : 0u; mine = (j == x) ? c : mine; }
        if (sum == G) break;
        __builtin_amdgcn_s_sleep(1);
        if ((++sp & 255u) == 0u) { if (xb_ld(&bar[XB_TMO])) break; if (sp > XB_SPIN_CAP) { atomicAdd(&bar[XB_TMO], 1u); break; } }
    }
    nloc = mine > 0u ? mine : 1u; nx = cnt > 0u ? cnt : 1u;
}
__device__ __forceinline__ void xcd_barrier(const XcdBarrier& b) {
    asm volatile("s_waitcnt vmcnt(0)" ::: "memory");
    __syncthreads();
    if (threadIdx.x == 0) {
        unsigned* bar = b.bar;
        __builtin_amdgcn_s_waitcnt(0);
        unsigned nloc = b.st[0], nx = b.st[1];
        if (nloc == 0u) { xcd_barrier_complete(bar, b.x, nloc, nx); b.st[0] = nloc; b.st[1] = nx; }
        const unsigned old = xb_add(&bar[XB_XSUB(b.x)], 1u);
        const unsigned gen = old / nloc;
        if (old + 1u == (gen + 1u) * nloc) {
            __builtin_amdgcn_fence(__ATOMIC_RELEASE, "agent");
            asm volatile("s_waitcnt vmcnt(0)" ::: "memory");
            const unsigned og = xb_add(&bar[XB_TOP], 1u);
            const unsigned tg = og / nx;
            if (og + 1u == (tg + 1u) * nx) xb_add(&bar[XB_TOPGEN], 1u);
            else XB_SPIN(xb_ld(&bar[XB_TOPGEN]) == tg, bar);
            __builtin_amdgcn_fence(__ATOMIC_ACQUIRE, "agent");
            xb_add(&bar[XB_XGEN(b.x)], 1u);
            asm volatile("s_waitcnt vmcnt(0)" ::: "memory");
        } else {
            XB_SPIN(xb_ld(&bar[XB_XGEN(b.x)]) == gen, bar);
            __builtin_amdgcn_fence(__ATOMIC_ACQUIRE, "agent");
            asm volatile("s_waitcnt vmcnt(0)" ::: "memory");
        }
    }
    __syncthreads();
}

struct Frame {
    LAS unsigned char* lds;
    volatile LAS unsigned* MISC;
    gu32* ctl;
    int tid, lane, wave;
    int vcu, G;
    const float *x, *c, *norm1_g, *norm2_g, *w_ada, *b_ada, *w_in, *lam_re, *lam_im, *log_dt, *b_re, *b_im, *c_re, *c_im, *d_skip, *w_glu, *b_glu, *q_gain, *k_gain, *gn_ssm, *gn_attn, *w_out, *w_ff1, *w_ff2;
    float* out;
    float *MODP, *MOD, *BIAS2, *SSQS, *SSQ2, *KI, *WI, *QI;
    f32x2 *LAMB, *BBAR;
    bf16 *WINP, *WINI, *WGLU, *WOUT, *W1, *W2, *U, *Q, *A2, *XN, *KV, *Z, *MIX, *H;
};

__device__ __forceinline__ float wave_sum(float v) {
#pragma unroll
    for (int o = 1; o < 64; o <<= 1) v += __shfl_xor(v, o);
    return v;
}
__device__ __forceinline__ float wave_max(float v) {
#pragma unroll
    for (int o = 1; o < 64; o <<= 1) v = fmaxf(v, __shfl_xor(v, o));
    return v;
}
__device__ __forceinline__ int wave_sum_i(int v) {
#pragma unroll
    for (int o = 1; o < 64; o <<= 1) v += __shfl_xor(v, o);
    return v;
}

__device__ __forceinline__ double exp_d(double x) {
    const double n = __builtin_rint(x * 1.4426950408889634);
    const double r = (x - n * 0.693147180369123816490e+00) - n * 1.90821492927058770002e-10;
    double p = 1.0 / 87178291200.0;
    p = p * r + 1.0 / 6227020800.0; p = p * r + 1.0 / 479001600.0; p = p * r + 1.0 / 39916800.0; p = p * r + 1.0 / 3628800.0; p = p * r + 1.0 / 362880.0;
    p = p * r + 1.0 / 40320.0; p = p * r + 1.0 / 5040.0; p = p * r + 1.0 / 720.0; p = p * r + 1.0 / 120.0; p = p * r + 1.0 / 24.0; p = p * r + 1.0 / 6.0; p = p * r + 0.5; p = p * r + 1.0; p = p * r + 1.0;
    const long long e = (long long)n + 1023;
    return p * __builtin_bit_cast(double, (unsigned long long)e << 52);
}
__device__ __forceinline__ void sincos_d(double x, double& s, double& c) {
    const double n = __builtin_rint(x * 0.63661977236758134308);
    double r = (x - n * 1.57079632673412561417e+00) - n * 6.07710050650619224932e-11;
    r = r - n * 2.02226624879595063154e-21;
    const double r2 = r * r;
    double sp = -1.0 / 1307674368000.0;
    sp = sp * r2 + 1.0 / 6227020800.0; sp = sp * r2 - 1.0 / 39916800.0; sp = sp * r2 + 1.0 / 362880.0; sp = sp * r2 - 1.0 / 5040.0; sp = sp * r2 + 1.0 / 120.0; sp = sp * r2 - 1.0 / 6.0; sp = sp * r2 + 1.0;
    const double sr = sp * r;
    double cp = 1.0 / 20922789888000.0;
    cp = cp * r2 - 1.0 / 87178291200.0; cp = cp * r2 + 1.0 / 479001600.0; cp = cp * r2 - 1.0 / 3628800.0; cp = cp * r2 + 1.0 / 40320.0; cp = cp * r2 - 1.0 / 720.0; cp = cp * r2 + 1.0 / 24.0; cp = cp * r2 - 0.5; cp = cp * r2 + 1.0;
    const long long q = (long long)n & 3;
    s = (q == 0) ? sr : (q == 1) ? cp : (q == 2) ? -sr : -cp;
    c = (q == 0) ? cp : (q == 1) ? -sr : (q == 2) ? -cp : sr;
}

template <int MODE>
__device__ __forceinline__ void p0_transpose_item(Frame& F, const float* W, int K, int N, bf16* WT, LAS float* scr, int item, int lane) {
    const int nblk = (N + 31) / 32, kb = item / nblk, nb = item % nblk, k0 = 64 * kb, n0 = 32 * nb;
#pragma unroll 8
    for (int i = 0; i < 32; ++i) { const int kk = 2 * i + (lane >> 5); const int n = n0 + (lane & 31);
        float v = (MODE != 1 || n < N) ? W[(size_t)(k0 + kk) * N + n] : 0.f;
        if (MODE == 2) { const int k = k0 + kk; v *= (k < D_SSM) ? F.gn_ssm[k] : F.gn_attn[k - D_SSM]; }
        scr[kk * 33 + (lane & 31)] = v; }
    LDS_WAIT(); asm volatile("" ::: "memory");
    const int c = lane & 7;
#pragma unroll
    for (int j = 0; j < 4; ++j) { const int n = (lane >> 3) + 8 * j; const LAS float* s = scr + (8 * c) * 33 + n;
        float v[8];
#pragma unroll
        for (int e = 0; e < 8; ++e) v[e] = s[e * 33];
        v4u o; o.x = pk2(v[0], v[1]); o.y = pk2(v[2], v[3]); o.z = pk2(v[4], v[5]); o.w = pk2(v[6], v[7]);
        if (MODE != 1) { *(GAS v4u*)(WT + (size_t)(n0 + n) * K + k0 + 8 * c) = o; }
        else {
            const int ng = n0 + n;
            if (ng < N_PLAIN) { *(GAS v4u*)(F.WINP + (size_t)ng * 1024 + k0 + 8 * c) = o; }
            else {
                float l[8];
#pragma unroll
                for (int e = 0; e < 8; ++e) l[e] = v[e] - bf2f(f2bf(v[e]));
                v4u ol; ol.x = pk2(l[0], l[1]); ol.y = pk2(l[2], l[3]); ol.z = pk2(l[4], l[5]); ol.w = pk2(l[6], l[7]);
                bf16* d = F.WINI + (size_t)(ng - N_PLAIN) * K3 + k0 + 8 * c;
                *(GAS v4u*)(d) = o; *(GAS v4u*)(d + 1024) = o; *(GAS v4u*)(d + 2048) = ol;
            }
        } }
    LDS_WAIT(); asm volatile("" ::: "memory");
}

__device__ __forceinline__ void p0_mod_item(Frame& F, int item, LAS float* scr) {
    const int cg = item >> 3, ks = item & 7, j = cg * 64 + F.lane, k0 = ks * 128;
    for (int e = F.lane; e < 2048; e += 64) { const int b = e >> 7, i = e & 127; const float cv = F.c[b * 1024 + k0 + i]; scr[e] = cv / (1.f + __expf(-cv)); }
    LDS_WAIT(); asm volatile("" ::: "memory");
    float acc[16];
#pragma unroll
    for (int b = 0; b < 16; ++b) acc[b] = 0.f;
    for (int i4 = 0; i4 < 32; ++i4) {
        const float* wp = F.w_ada + (size_t)(k0 + 4 * i4) * 6144 + j;
        const float w0 = wp[0], w1 = wp[6144], w2 = wp[2 * 6144], w3 = wp[3 * 6144];
#pragma unroll
        for (int b = 0; b < 16; ++b) { const f32x4 s = *(const LAS f32x4*)(scr + b * 128 + 4 * i4); acc[b] += s.x * w0 + s.y * w1 + s.z * w2 + s.w * w3; }
    }
#pragma unroll
    for (int b = 0; b < 16; ++b) F.MODP[(size_t)(ks * 16 + b) * 6144 + j] = acc[b];
    LDS_WAIT(); asm volatile("" ::: "memory");
}

__device__ __forceinline__ void p0_ssm_item(Frame& F, int g) {
    const int p = F.lane, gp = g * 64 + p;
    const double lre = (double)F.lam_re[gp], lim = (double)F.lam_im[gp], dt = exp_d((double)F.log_dt[g]);
    double s, c; sincos_d(lim * dt, s, c);
    const double mag = exp_d(lre * dt), lbr = mag * c, lbi = mag * s;
    const double a = lbr - 1.0, b = lbi, den = lre * lre + lim * lim;
    const double cr = (a * lre + b * lim) / den, ci = (b * lre - a * lim) / den;
    F.LAMB[gp] = (f32x2){(float)lbr, (float)lbi};
#pragma unroll
    for (int cc = 0; cc < 16; ++cc) { const double br = (double)F.b_re[gp * 16 + cc], bi = (double)F.b_im[gp * 16 + cc];
        F.BBAR[gp * 16 + cc] = (f32x2){(float)(cr * br - ci * bi), (float)(cr * bi + ci * br)}; }
}

__device__ __forceinline__ void p0a_phase(Frame& F) {
    LAS float* scr = (LAS float*)(F.lds + RING_OFF + F.wave * WAVE_LDS);
    const int gw = F.vcu * NWAVES + F.wave, NGW = F.G * NWAVES;
    constexpr int I_MOD = 96 * 8, I_SSM = 32;
    constexpr int I_IN = 16 * 59, I_GLU = 8 * 16, I_OUT = 16 * 32, I_1 = 16 * 128, I_2 = 64 * 32;
    constexpr int NITEMS = I_MOD + I_SSM + I_IN + I_GLU + I_OUT + I_1 + I_2;
    for (int it = gw; it < NITEMS; it += NGW) {
        int r = it;
        if (r < I_MOD) { p0_mod_item(F, r, scr); continue; } r -= I_MOD;
        if (r < I_SSM) { p0_ssm_item(F, r); continue; } r -= I_SSM;
        if (r < I_IN) { p0_transpose_item<1>(F, F.w_in, 1024, D_IN, nullptr, scr, r, F.lane); continue; } r -= I_IN;
        if (r < I_GLU) { p0_transpose_item<0>(F, F.w_glu, 512, 512, F.WGLU, scr, r, F.lane); continue; } r -= I_GLU;
        if (r < I_OUT) { p0_transpose_item<2>(F, F.w_out, 1024, 1024, F.WOUT, scr, r, F.lane); continue; } r -= I_OUT;
        if (r < I_1) { p0_transpose_item<0>(F, F.w_ff1, 1024, DFF, F.W1, scr, r, F.lane); continue; } r -= I_1;
        p0_transpose_item<0>(F, F.w_ff2, DFF, 1024, F.W2, scr, r, F.lane);
    }
    { const int gt = (F.vcu * NWAVES + F.wave) * 64 + F.lane, NT = F.G * NWAVES * 64; GAS v4u* z = (GAS v4u*)(F.WINI + (size_t)608 * K3);
      for (int i = gt; i < 160 * K3 / 8; i += NT) z[i] = (v4u){0u, 0u, 0u, 0u}; }
}

__device__ __forceinline__ void p0b_phase(Frame& F) {
    const int w = F.vcu;
    { const int idx = w * 384 + F.tid;
      if (F.tid < 384 && idx < 16 * 6144) { const int j = idx % 6144; float s = F.b_ada[j];
#pragma unroll
          for (int ks = 0; ks < 8; ++ks) s += F.MODP[(size_t)ks * 16 * 6144 + idx];
          F.MOD[idx] = s; } }
    LAS float* sh = (LAS float*)(F.lds + RING_OFF);
    for (int rb = w; rb < M / 128; rb += F.G) {
        const int b = rb / 16;
        __syncthreads();
        for (int e = F.tid; e < 2048; e += NWAVES * 64) { float s = F.b_ada[e];
#pragma unroll
            for (int ks = 0; ks < 8; ++ks) s += F.MODP[(size_t)(ks * 16 + b) * 6144 + e];
            sh[e] = s; }
        __syncthreads();
        for (int r = 0; r < 16; ++r) {
            const size_t m = (size_t)rb * 128 + F.wave * 16 + r;
            const GAS f32x4* xr = (const GAS f32x4*)(F.x + m * DM) + F.lane;
            f32x4 v[4]; float ss = 0.f;
#pragma unroll
            for (int j = 0; j < 4; ++j) { v[j] = xr[64 * j]; ss += (v[j].x * v[j].x + v[j].y * v[j].y) + (v[j].z * v[j].z + v[j].w * v[j].w); }
            const float rstd = 1.0f / sqrtf(wave_sum(ss) * (1.f / DM) + EPS);
            GAS v2u* oh = (GAS v2u*)(F.XN + m * 2048) + F.lane;
#pragma unroll
            for (int j = 0; j < 4; ++j) { const int col = 4 * F.lane + 256 * j;
                const f32x4 g = *(const f32x4*)(F.norm1_g + col); const f32x4 s1 = *(const LAS f32x4*)(sh + col); const f32x4 c1 = *(const LAS f32x4*)(sh + 1024 + col);
                f32x4 h = v[j] * rstd * g * (c1 + 1.0f) + s1;
                float hh[4] = {h.x, h.y, h.z, h.w}, hl[4];
#pragma unroll
                for (int e = 0; e < 4; ++e) hl[e] = hh[e] - bf2f(f2bf(hh[e]));
                oh[64 * j] = (v2u){pk2(hh[0], hh[1]), pk2(hh[2], hh[3])};
                oh[256 + 64 * j] = (v2u){pk2(hl[0], hl[1]), pk2(hl[2], hl[3])}; }
        }
    }
}

using pg8::Unit; using pg8::cvt_pk_bf16;
struct EpiInPlain {
    static constexpr bool PERM = true, MID = false; int tmid;
    bf16 *U, *Q, *KV;
    __device__ __forceinline__ void mid(f32x4 (&)[2][2][4][2], const Unit&, int, int, int, int) const {}
    __device__ __forceinline__ void operator()(const f32x4 (&acc)[2][2][4][2], const Unit& u, int wr, int wc, int fr, int fq) const {
        bf16* base; int ldc, colt;
        if (u.pn < 2) { base = U; ldc = 512; colt = u.pn * 256; } else if (u.pn < 4) { base = Q; ldc = 512; colt = (u.pn - 2) * 256; } else { base = KV; ldc = 256; colt = 0; }
        const int row0 = u.pm * 256 + wr * 64 + fr, col0 = colt + wc * 32 + 8 * fq;
#pragma unroll
        for (int ai = 0; ai < 2; ++ai)
#pragma unroll
            for (int m = 0; m < 4; ++m) { bf16* rowp = base + (size_t)(row0 + ai * 128 + m * 16) * ldc + col0;
#pragma unroll
                for (int bj = 0; bj < 2; ++bj) { const f32x4 v0 = acc[ai][bj][m][0], v1 = acc[ai][bj][m][1];
                    v4u wv; wv.x = cvt_pk_bf16(v0[0], v0[1]); wv.y = cvt_pk_bf16(v0[2], v0[3]); wv.z = cvt_pk_bf16(v1[0], v1[1]); wv.w = cvt_pk_bf16(v1[2], v1[3]);
                    *(v4u*)(rowp + bj * 128) = wv; } }
    }
};
struct EpiInIdx {
    static constexpr bool PERM = false, MID = false; int tmid;
    float *QI, *KI, *WI;
    __device__ __forceinline__ void mid(f32x4 (&)[2][2][4][2], const Unit&, int, int, int, int) const {}
    __device__ __forceinline__ void operator()(const f32x4 (&acc)[2][2][4][2], const Unit& u, int wr, int wc, int fr, int fq) const {
        const int row0 = u.pm * 256 + wr * 64 + fr;
        if (u.pn < 2) {
            const int col0 = u.pn * 256 + wc * 32 + 4 * fq;
#pragma unroll
            for (int ai = 0; ai < 2; ++ai)
#pragma unroll
                for (int m = 0; m < 4; ++m) { float* rowp = QI + (size_t)(row0 + ai * 128 + m * 16) * 512 + col0;
#pragma unroll
                    for (int bj = 0; bj < 2; ++bj)
#pragma unroll
                        for (int n = 0; n < 2; ++n) *(f32x4*)(rowp + bj * 128 + n * 16) = acc[ai][bj][m][n]; }
        } else {
#pragma unroll
            for (int ai = 0; ai < 2; ++ai)
#pragma unroll
                for (int m = 0; m < 4; ++m) { const size_t row = (size_t)(row0 + ai * 128 + m * 16);
#pragma unroll
                    for (int n = 0; n < 2; ++n) { const int col = wc * 32 + 16 * n + 4 * fq;
                        if (col < 64) *(f32x4*)(KI + row * 64 + col) = acc[ai][0][m][n];
                        else if (col < 72) *(f32x4*)(WI + row * 8 + (col - 64)) = acc[ai][0][m][n]; } }
        }
    }
};
struct EpiGlu {
    static constexpr bool PERM = true, MID = false; int tmid;
    const bf16* Z; bf16* MIX; const float* bglu; float* SSQS;
    __device__ __forceinline__ void mid(f32x4 (&)[2][2][4][2], const Unit&, int, int, int, int) const {}
    __device__ __forceinline__ void operator()(const f32x4 (&acc)[2][2][4][2], const Unit& u, int wr, int wc, int fr, int fq) const {
        const int row0 = u.pm * 256 + wr * 64 + fr, col0 = u.pn * 256 + wc * 32 + 8 * fq;
#pragma unroll
        for (int ai = 0; ai < 2; ++ai)
#pragma unroll
            for (int m = 0; m < 4; ++m) { const size_t row = (size_t)(row0 + ai * 128 + m * 16); float ss = 0.f;
#pragma unroll
                for (int bj = 0; bj < 2; ++bj) { const int col = col0 + bj * 128;
                    const v4u zz = *(const v4u*)(Z + row * 512 + col);
                    const f32x4 b0 = *(const f32x4*)(bglu + col), b1 = *(const f32x4*)(bglu + col + 4);
                    const f32x4 a0 = acc[ai][bj][m][0] + b0, a1 = acc[ai][bj][m][1] + b1;
                    float zf[8] = {bflo(zz.x), bfhi(zz.x), bflo(zz.y), bfhi(zz.y), bflo(zz.z), bfhi(zz.z), bflo(zz.w), bfhi(zz.w)};
                    float av[8] = {a0[0], a0[1], a0[2], a0[3], a1[0], a1[1], a1[2], a1[3]}, y[8];
#pragma unroll
                    for (int e = 0; e < 8; ++e) { y[e] = zf[e] / (1.f + __expf(-av[e])); ss += y[e] * y[e]; }
                    v4u wv; wv.x = cvt_pk_bf16(y[0], y[1]); wv.y = cvt_pk_bf16(y[2], y[3]); wv.z = cvt_pk_bf16(y[4], y[5]); wv.w = cvt_pk_bf16(y[6], y[7]);
                    *(v4u*)(MIX + row * 1024 + col) = wv; }
                ss += __shfl_xor(ss, 16); ss += __shfl_xor(ss, 32);
                if (fq == 0) SSQS[row * 8 + u.pn * 4 + wc] = ss; }
    }
};
struct EpiOut {
    static constexpr bool PERM = true, MID = true; int tmid;
    const float* x; float* x1; bf16* A2; const float* MOD; const float* g2n; const float* SSQS; float* SSQ2;
    __device__ __forceinline__ void mid(f32x4 (&acc)[2][2][4][2], const Unit& u, int wr, int wc, int fr, int fq) const {
#pragma unroll
        for (int ai = 0; ai < 2; ++ai)
#pragma unroll
            for (int m = 0; m < 4; ++m) { const size_t row = (size_t)(u.pm * 256 + ai * 128 + wr * 64 + m * 16 + fr);
                const f32x4 p = *(const f32x4*)(SSQS + row * 8 + 4 * (fq & 1)); float s = (p.x + p.y) + (p.z + p.w); s += __shfl_xor(s, 16);
                const float rstd = 1.0f / sqrtf(s * (1.f / 512.f) + EPS);
#pragma unroll
                for (int bj = 0; bj < 2; ++bj)
#pragma unroll
                    for (int n = 0; n < 2; ++n) acc[ai][bj][m][n] *= rstd; }
    }
    __device__ __forceinline__ void operator()(const f32x4 (&acc)[2][2][4][2], const Unit& u, int wr, int wc, int fr, int fq) const {
        const int b = u.pm >> 3; const float* mod = MOD + (size_t)b * 6144;
        const int row0 = u.pm * 256 + wr * 64 + fr, col0 = u.pn * 256 + wc * 32 + 8 * fq;
#pragma unroll
        for (int ai = 0; ai < 2; ++ai)
#pragma unroll
            for (int m = 0; m < 4; ++m) { const size_t row = (size_t)(row0 + ai * 128 + m * 16); float ss = 0.f;
#pragma unroll
                for (int bj = 0; bj < 2; ++bj) { const int col = col0 + bj * 128; float a2[8];
#pragma unroll
                    for (int n = 0; n < 2; ++n) { const int c4 = col + 4 * n;
                        const f32x4 xv = *(const f32x4*)(x + row * 1024 + c4); const f32x4 g1 = *(const f32x4*)(mod + 2048 + c4);
                        const f32x4 v = xv + g1 * acc[ai][bj][m][n];
                        *(f32x4*)(x1 + row * 1024 + c4) = v; ss += (v.x * v.x + v.y * v.y) + (v.z * v.z + v.w * v.w);
                        const f32x4 sc2 = *(const f32x4*)(mod + 4096 + c4); const f32x4 gg = *(const f32x4*)(g2n + c4);
                        const f32x4 a = v * gg * (sc2 + 1.0f); a2[4 * n] = a.x; a2[4 * n + 1] = a.y; a2[4 * n + 2] = a.z; a2[4 * n + 3] = a.w; }
                    v4u wv; wv.x = cvt_pk_bf16(a2[0], a2[1]); wv.y = cvt_pk_bf16(a2[2], a2[3]); wv.z = cvt_pk_bf16(a2[4], a2[5]); wv.w = cvt_pk_bf16(a2[6], a2[7]);
                    *(v4u*)(A2 + row * 1024 + col) = wv; }
                ss += __shfl_xor(ss, 16); ss += __shfl_xor(ss, 32);
                if (fq == 0) SSQ2[row * 16 + u.pn * 4 + wc] = ss; }
    }
};
struct EpiUp {
    static constexpr bool PERM = true, MID = false; int tmid;
    const float* SSQ2; const float* BIAS2; bf16* H;
    __device__ __forceinline__ void mid(f32x4 (&)[2][2][4][2], const Unit&, int, int, int, int) const {}
    __device__ __forceinline__ void operator()(const f32x4 (&acc)[2][2][4][2], const Unit& u, int wr, int wc, int fr, int fq) const {
        const int b = u.pm >> 3; const float* bias = BIAS2 + (size_t)b * DFF;
        const int row0 = u.pm * 256 + wr * 64 + fr, col0 = u.pn * 256 + wc * 32 + 8 * fq;
        f32x4 bv[2][2];
#pragma unroll
        for (int bj = 0; bj < 2; ++bj)
#pragma unroll
            for (int n = 0; n < 2; ++n) bv[bj][n] = *(const f32x4*)(bias + col0 + bj * 128 + 4 * n);
#pragma unroll
        for (int ai = 0; ai < 2; ++ai)
#pragma unroll
            for (int m = 0; m < 4; ++m) { const size_t row = (size_t)(row0 + ai * 128 + m * 16);
                const f32x4 p = *(const f32x4*)(SSQ2 + row * 16 + 4 * fq); float s = (p.x + p.y) + (p.z + p.w); s += __shfl_xor(s, 16); s += __shfl_xor(s, 32);
                const float rstd = 1.0f / sqrtf(s * (1.f / 1024.f) + EPS);
#pragma unroll
                for (int bj = 0; bj < 2; ++bj) { f32x4 v0 = acc[ai][bj][m][0] * rstd + bv[bj][0], v1 = acc[ai][bj][m][1] * rstd + bv[bj][1];
                    float h[8] = {v0[0], v0[1], v0[2], v0[3], v1[0], v1[1], v1[2], v1[3]};
#pragma unroll
                    for (int e = 0; e < 8; ++e) { const float r = fmaxf(h[e], 0.f); h[e] = r * r; }
                    v4u wv; wv.x = cvt_pk_bf16(h[0], h[1]); wv.y = cvt_pk_bf16(h[2], h[3]); wv.z = cvt_pk_bf16(h[4], h[5]); wv.w = cvt_pk_bf16(h[6], h[7]);
                    *(v4u*)(H + row * DFF + col0 + bj * 128) = wv; } }
    }
};
struct EpiDown {
    static constexpr bool PERM = false, MID = false; int tmid;
    float* out; const float* MOD;
    __device__ __forceinline__ void mid(f32x4 (&)[2][2][4][2], const Unit&, int, int, int, int) const {}
    __device__ __forceinline__ void operator()(const f32x4 (&acc)[2][2][4][2], const Unit& u, int wr, int wc, int fr, int fq) const {
        const int b = u.pm >> 3; const float* g2 = MOD + (size_t)b * 6144 + 5120;
        const int row0 = u.pm * 256 + wr * 64 + fr, col0 = u.pn * 256 + wc * 32 + 4 * fq;
        f32x4 gv[2][2];
#pragma unroll
        for (int bj = 0; bj < 2; ++bj)
#pragma unroll
            for (int n = 0; n < 2; ++n) gv[bj][n] = *(const f32x4*)(g2 + col0 + bj * 128 + n * 16);
#pragma unroll
        for (int ai = 0; ai < 2; ++ai)
#pragma unroll
            for (int m = 0; m < 4; ++m) { float* rowp = out + (size_t)(row0 + ai * 128 + m * 16) * 1024 + col0;
#pragma unroll
                for (int bj = 0; bj < 2; ++bj)
#pragma unroll
                    for (int n = 0; n < 2; ++n) { const f32x4 x1 = *(const f32x4*)(rowp + bj * 128 + n * 16); *(f32x4*)(rowp + bj * 128 + n * 16) = x1 + gv[bj][n] * acc[ai][bj][m][n]; } }
    }
};

__device__ __forceinline__ float gelu_tanh(float v) {
    const float a = 0.7978845608028654f * (v + 0.044715f * v * v * v);
    const float th = 1.f - 2.f / (__expf(2.f * a) + 1.f);
    return 0.5f * v * (1.f + th);
}
__device__ __forceinline__ void bias2_item(Frame& F, int item, LAS float* scr) {
    const int b = item >> 6, n = (item & 63) * 64 + F.lane;
    for (int e = F.lane; e < 1024; e += 64) scr[e] = F.MOD[(size_t)b * 6144 + 3072 + e];
    LDS_WAIT(); asm volatile("" ::: "memory");
    float acc = 0.f;
#pragma unroll 8
    for (int k = 0; k < 1024; ++k) acc += scr[k] * F.w_ff1[(size_t)k * DFF + n];
    F.BIAS2[(size_t)b * DFF + n] = acc;
    LDS_WAIT(); asm volatile("" ::: "memory");
}
__device__ __forceinline__ void ssm_naive_unit(Frame& F, int b, int g, LAS unsigned char* wl) {
    const int lane = F.lane;
    LAS f32x2* Cl = (LAS f32x2*)wl;
    LAS f32x2* xs = Cl + 16 * 65;
#pragma unroll
    for (int c = 0; c < 16; ++c) Cl[c * 65 + lane] = (f32x2){F.c_re[(g * 16 + c) * 64 + lane], F.c_im[(g * 16 + c) * 64 + lane]};
    const f32x2 lam = F.LAMB[g * 64 + lane];
    f32x2 Bb[16];
#pragma unroll
    for (int c = 0; c < 16; ++c) Bb[c] = F.BBAR[(g * 64 + lane) * 16 + c];
    float dsk[4];
#pragma unroll
    for (int k = 0; k < 4; ++k) dsk[k] = F.d_skip[g * 16 + (lane >> 4) * 4 + k];
    LDS_WAIT(); asm volatile("" ::: "memory");
    float xr = 0.f, xi = 0.f;
    for (int ch = 0; ch < SEQ / 16; ++ch) {
        const int t0 = ch * 16;
#pragma unroll 4
        for (int tt = 0; tt < 16; ++tt) {
            const bf16* up = F.U + ((size_t)b * SEQ + t0 + tt) * 512 + g * 16;
            const v4u ua = *(const v4u*)up, ub = *(const v4u*)(up + 8);
            const float u[16] = {bflo(ua.x), bfhi(ua.x), bflo(ua.y), bfhi(ua.y), bflo(ua.z), bfhi(ua.z), bflo(ua.w), bfhi(ua.w),
                                 bflo(ub.x), bfhi(ub.x), bflo(ub.y), bfhi(ub.y), bflo(ub.z), bfhi(ub.z), bflo(ub.w), bfhi(ub.w)};
            float br = 0.f, bi = 0.f;
#pragma unroll
            for (int c = 0; c < 16; ++c) { br += Bb[c].x * u[c]; bi += Bb[c].y * u[c]; }
            const float nr = lam.x * xr - lam.y * xi + br, ni = lam.x * xi + lam.y * xr + bi; xr = nr; xi = ni;
            xs[tt * 65 + lane] = (f32x2){xr, xi};
        }
        LDS_WAIT(); asm volatile("" ::: "memory");
        const int tt = lane & 15, cq = lane >> 4;
        float y[4] = {0.f, 0.f, 0.f, 0.f};
#pragma unroll 4
        for (int p = 0; p < 64; ++p) { const f32x2 xv = xs[tt * 65 + p];
#pragma unroll
            for (int k = 0; k < 4; ++k) { const f32x2 cv = Cl[(cq * 4 + k) * 65 + p]; y[k] += cv.x * xv.x - cv.y * xv.y; } }
        const size_t off = ((size_t)b * SEQ + t0 + tt) * 512 + g * 16 + cq * 4;
        const v2u uu = *(const v2u*)(F.U + off);
        const float uf[4] = {bflo(uu.x), bfhi(uu.x), bflo(uu.y), bfhi(uu.y)};
        float z[4];
#pragma unroll
        for (int k = 0; k < 4; ++k) z[k] = gelu_tanh(y[k] + dsk[k] * uf[k]);
        *(v2u*)(F.Z + off) = (v2u){pk2(z[0], z[1]), pk2(z[2], z[3])};
        LDS_WAIT(); asm volatile("" ::: "memory");
    }
}

__device__ __forceinline__ unsigned fkey(float f) { const unsigned u = __float_as_uint(f); return (u & 0x80000000u) ? ~u : (u | 0x80000000u); }

__device__ __forceinline__ void attn_naive_query(Frame& F, int b, int t, LAS unsigned char* wl) {
    const int lane = F.lane; const size_t m = (size_t)b * SEQ + t;
    LAS float* qi = (LAS float*)wl;
    LAS float* qn = qi + 512;
    LAS unsigned* keys = (LAS unsigned*)(qn + 512);
    LAS unsigned* sel = keys + 2048;
    LAS float* pl = (LAS float*)keys;
    { const f32x4 a = *(const f32x4*)(F.QI + m * 512 + lane * 8), bq = *(const f32x4*)(F.QI + m * 512 + lane * 8 + 4);
      *(LAS f32x4*)(qi + lane * 8) = a; *(LAS f32x4*)(qi + lane * 8 + 4) = bq; }
    LAS float* wi = (LAS float*)(sel + 256);
    if (lane < 8) wi[lane] = F.WI[m * 8 + lane];
    { const v4u qv = *(const v4u*)(F.Q + m * 512 + lane * 8);
      float q[8] = {bflo(qv.x), bfhi(qv.x), bflo(qv.y), bfhi(qv.y), bflo(qv.z), bfhi(qv.z), bflo(qv.w), bfhi(qv.w)};
      float ss = 0.f;
#pragma unroll
      for (int j = 0; j < 8; ++j) ss += q[j] * q[j];
      ss += __shfl_xor(ss, 1); ss += __shfl_xor(ss, 2); ss += __shfl_xor(ss, 4);
      const float rstd = 1.0f / sqrtf(ss * (1.f / 64.f) + EPS); const int d0 = (lane & 7) * 8;
#pragma unroll
      for (int j = 0; j < 8; ++j) qn[lane * 8 + j] = q[j] * rstd * F.q_gain[d0 + j] * 0.125f; }
    LDS_WAIT(); asm volatile("" ::: "memory");
#pragma unroll 1
    for (int j = 0; j < 32; ++j) {
        const int s = lane + 64 * j; unsigned key = 0u;
        if (s <= t) {
            const float* kp = F.KI + ((size_t)b * SEQ + s) * 64;
            f32x4 kk[16];
#pragma unroll
            for (int i = 0; i < 16; ++i) kk[i] = *(const f32x4*)(kp + 4 * i);
            float sc = 0.f;
#pragma unroll 1
            for (int h = 0; h < 8; ++h) { float d = 0.f;
#pragma unroll
                for (int i = 0; i < 16; ++i) { const f32x4 qv = *(const LAS f32x4*)(qi + h * 64 + 4 * i); d += (qv.x * kk[i].x + qv.y * kk[i].y) + (qv.z * kk[i].z + qv.w * kk[i].w); }
                sc += wi[h] * fmaxf(d, 0.f); }
            key = fkey(sc * IDX_SCALE + 0.0f);
        }
        keys[s] = key;
    }
    LDS_WAIT(); asm volatile("" ::: "memory");
    unsigned kreg[32];
#pragma unroll
    for (int j = 0; j < 32; ++j) kreg[j] = keys[lane + 64 * j];
    LDS_WAIT(); asm volatile("" ::: "memory");
    const int n = t + 1; unsigned tau = 0u; int need = 0;
    if (n > TOPK) {
#pragma unroll 1
        for (int bit = 31; bit >= 0; --bit) { const unsigned cand = tau | (1u << bit); int c = 0;
#pragma unroll
            for (int j = 0; j < 32; ++j) c += (kreg[j] >= cand) ? 1 : 0;
            c = wave_sum_i(c); if (c >= TOPK) tau = cand; }
        int cg = 0;
#pragma unroll
        for (int j = 0; j < 32; ++j) cg += (kreg[j] > tau) ? 1 : 0;
        cg = wave_sum_i(cg); need = TOPK - cg;
    }
    const unsigned long long lt = (1ull << lane) - 1ull;
    int base = 0, eqb = 0;
#pragma unroll
    for (int j = 0; j < 32; ++j) {
        const int s = lane + 64 * j; bool sf;
        if (n > TOPK) { const bool gt = kreg[j] > tau, eq = kreg[j] == tau; const unsigned long long em = __ballot(eq);
            const int rank = eqb + __popcll(em & lt); sf = gt || (eq && rank < need); eqb += __popcll(em); }
        else sf = (s <= t);
        const unsigned long long sm = __ballot(sf);
        if (sf) sel[base + __popcll(sm & lt)] = (unsigned)s;
        base += __popcll(sm);
    }
    const int nsel = base;
#pragma unroll
    for (int i = 0; i < 4; ++i) { const int idx = lane + 64 * i; if (idx >= nsel) sel[idx] = 0u; }
    LDS_WAIT(); asm volatile("" ::: "memory");
#pragma unroll 1
    for (int i = 0; i < 4; ++i) {
        const int idx = lane + 64 * i; const bool act = idx < nsel; const unsigned s = sel[idx];
        const bf16* kp = F.KV + ((size_t)b * SEQ + s) * 256;
#pragma unroll 1
        for (int kvh = 0; kvh < 2; ++kvh) {
            float k[64]; float ss = 0.f;
#pragma unroll
            for (int c8 = 0; c8 < 8; ++c8) { const v4u kv = *(const v4u*)(kp + kvh * 64 + c8 * 8);
                k[c8 * 8 + 0] = bflo(kv.x); k[c8 * 8 + 1] = bfhi(kv.x); k[c8 * 8 + 2] = bflo(kv.y); k[c8 * 8 + 3] = bfhi(kv.y);
                k[c8 * 8 + 4] = bflo(kv.z); k[c8 * 8 + 5] = bfhi(kv.z); k[c8 * 8 + 6] = bflo(kv.w); k[c8 * 8 + 7] = bfhi(kv.w); }
#pragma unroll
            for (int d = 0; d < 64; ++d) ss += k[d] * k[d];
            const float rstd = 1.0f / sqrtf(ss * (1.f / 64.f) + EPS);
#pragma unroll
            for (int d = 0; d < 64; ++d) k[d] *= rstd * F.k_gain[d];
#pragma unroll 1
            for (int gq = 0; gq < 4; ++gq) { const int h = kvh * 4 + gq; float d = 0.f;
#pragma unroll
                for (int i4 = 0; i4 < 16; ++i4) { const f32x4 qv = *(const LAS f32x4*)(qn + h * 64 + 4 * i4); d += (qv.x * k[4 * i4] + qv.y * k[4 * i4 + 1]) + (qv.z * k[4 * i4 + 2] + qv.w * k[4 * i4 + 3]); }
                pl[idx * 8 + h] = act ? d : -INFINITY; }
        }
    }
    LDS_WAIT(); asm volatile("" ::: "memory");
    {
        float l[4][8];
#pragma unroll
        for (int i = 0; i < 4; ++i) { const f32x4 a = *(const LAS f32x4*)(pl + (lane + 64 * i) * 8), c = *(const LAS f32x4*)(pl + (lane + 64 * i) * 8 + 4);
            l[i][0] = a.x; l[i][1] = a.y; l[i][2] = a.z; l[i][3] = a.w; l[i][4] = c.x; l[i][5] = c.y; l[i][6] = c.z; l[i][7] = c.w; }
#pragma unroll
        for (int h = 0; h < 8; ++h) {
            float mx = fmaxf(fmaxf(l[0][h], l[1][h]), fmaxf(l[2][h], l[3][h])); mx = wave_max(mx);
            float sum = 0.f;
#pragma unroll
            for (int i = 0; i < 4; ++i) { l[i][h] = __expf(l[i][h] - mx); sum += l[i][h]; }
            sum = wave_sum(sum); const float inv = 1.0f / sum;
#pragma unroll
            for (int i = 0; i < 4; ++i) l[i][h] *= inv;
        }
        LDS_WAIT(); asm volatile("" ::: "memory");
#pragma unroll
        for (int i = 0; i < 4; ++i) { *(LAS f32x4*)(pl + (lane + 64 * i) * 8) = (f32x4){l[i][0], l[i][1], l[i][2], l[i][3]}; *(LAS f32x4*)(pl + (lane + 64 * i) * 8 + 4) = (f32x4){l[i][4], l[i][5], l[i][6], l[i][7]}; }
    }
    LDS_WAIT(); asm volatile("" ::: "memory");
    float o[8];
#pragma unroll
    for (int h = 0; h < 8; ++h) o[h] = 0.f;
    const int nsel4 = (nsel + 3) & ~3;
    for (int n0 = 0; n0 < nsel4; n0 += 4) {
#pragma unroll
        for (int u = 0; u < 4; ++u) {
            const unsigned s = sel[n0 + u]; const bf16* vp = F.KV + ((size_t)b * SEQ + s) * 256 + 128;
            const float v0 = bf2f(vp[lane]), v1 = bf2f(vp[64 + lane]);
            const f32x4 pa = *(const LAS f32x4*)(pl + (n0 + u) * 8), pb = *(const LAS f32x4*)(pl + (n0 + u) * 8 + 4);
            o[0] += pa.x * v0; o[1] += pa.y * v0; o[2] += pa.z * v0; o[3] += pa.w * v0;
            o[4] += pb.x * v1; o[5] += pb.y * v1; o[6] += pb.z * v1; o[7] += pb.w * v1;
        }
    }
    float ss = 0.f;
#pragma unroll
    for (int h = 0; h < 8; ++h) ss += o[h] * o[h];
    ss = wave_sum(ss); const float rstd = 1.0f / sqrtf(ss * (1.f / 512.f) + EPS);
#pragma unroll
    for (int h = 0; h < 8; ++h) F.MIX[m * 1024 + 512 + h * 64 + lane] = (bf16)f2bf(o[h] * rstd);
    LDS_WAIT(); asm volatile("" ::: "memory");
}

__device__ __forceinline__ void p3_phase(Frame& F) {
    LAS unsigned char* wl = F.lds + RING_OFF + F.wave * WAVE_LDS;
    const int gw = F.vcu * NWAVES + F.wave, NGW = F.G * NWAVES;
    for (int it = gw; it < 1024; it += NGW) bias2_item(F, it, (LAS float*)wl);
    for (int it = gw; it < BATCH * NG; it += NGW) ssm_naive_unit(F, it >> 5, it & 31, wl);
    for (int wv = gw; wv < BATCH * 128; wv += NGW) {
        const int b = wv >> 7, r = wv & 127;
        for (int j = 0; j < 16; ++j) { const int t = (j & 1) ? 128 * j + (127 - r) : 128 * j + r; attn_naive_query(F, b, t, wl); }
    }
}

struct Args { const float* in[24]; float* out; unsigned char* ws; int ph_lo, ph_hi, li, pad; };
__global__ void __launch_bounds__(NWAVES * 64, 2) fwd_kernel(Args args) {
    extern __shared__ __attribute__((aligned(16))) unsigned char lds[];
    Frame F;
    F.lds = (LAS unsigned char*)lds;
    F.MISC = (volatile LAS unsigned*)(F.lds + MISC_OFF);
    F.tid = threadIdx.x; F.lane = F.tid & 63; F.wave = __builtin_amdgcn_readfirstlane(F.tid >> 6);
    F.G = gridDim.x; { const int bx = blockIdx.x; F.vcu = (F.G % 8 == 0) ? (bx % 8) * (F.G / 8) + bx / 8 : bx; }
    unsigned char* ws = args.ws;
    F.ctl = (gu32*)(ws + WS_CTL);
    F.x = args.in[0]; F.c = args.in[1]; F.norm1_g = args.in[2]; F.norm2_g = args.in[3]; F.w_ada = args.in[4]; F.b_ada = args.in[5]; F.w_in = args.in[6];
    F.lam_re = args.in[7]; F.lam_im = args.in[8]; F.log_dt = args.in[9]; F.b_re = args.in[10]; F.b_im = args.in[11]; F.c_re = args.in[12]; F.c_im = args.in[13];
    F.d_skip = args.in[14]; F.w_glu = args.in[15]; F.b_glu = args.in[16]; F.q_gain = args.in[17]; F.k_gain = args.in[18]; F.gn_ssm = args.in[19]; F.gn_attn = args.in[20];
    F.w_out = args.in[21]; F.w_ff1 = args.in[22]; F.w_ff2 = args.in[23]; F.out = args.out;
    F.MODP = (float*)(ws + WS_MODP); F.MOD = (float*)(ws + WS_MOD); F.BIAS2 = (float*)(ws + WS_BIAS2); F.SSQS = (float*)(ws + WS_SSQS); F.SSQ2 = (float*)(ws + WS_SSQ2);
    F.KI = (float*)(ws + WS_KI); F.WI = (float*)(ws + WS_WI); F.QI = (float*)(ws + WS_QI);
    F.LAMB = (f32x2*)(ws + WS_SSMP); F.BBAR = (f32x2*)(ws + WS_SSMP + 16384);
    F.WINP = (bf16*)(ws + WS_WINP); F.WINI = (bf16*)(ws + WS_WINI); F.WGLU = (bf16*)(ws + WS_WGLU); F.WOUT = (bf16*)(ws + WS_WOUT); F.W1 = (bf16*)(ws + WS_W1); F.W2 = (bf16*)(ws + WS_W2);
    F.U = (bf16*)(ws + WS_U); F.Q = (bf16*)(ws + WS_Q); F.A2 = (bf16*)(ws + WS_A2); F.XN = (bf16*)(ws + WS_XN); F.KV = (bf16*)(ws + WS_KV); F.Z = (bf16*)(ws + WS_Z); F.MIX = (bf16*)(ws + WS_MIX); F.H = (bf16*)(ws + WS_H);
    for (int u = F.tid; u < (LDS_BYTES - LDSCTL_OFF) / 4; u += NWAVES * 64) ((LAS unsigned*)(F.lds + LDSCTL_OFF))[u] = 0u;
    __syncthreads();
    XcdBarrier bar; bar.bar = (unsigned*)(F.ctl + CW_BAR); bar.x = 0; bar.st = nullptr;
    if (N_LAUNCHES == 1) bar = xcd_barrier_post((unsigned*)(F.ctl + CW_BAR), F.MISC + 8);
#define GRID_BAR() do { if (N_LAUNCHES == 1) xcd_barrier(bar); } while (0)
    const int lo = args.ph_lo, hi = args.ph_hi;
#ifndef PHASE_MASK
#define PHASE_MASK 0xFF
#endif
#define IN(k) (((PHASE_MASK >> (k)) & 1) && lo <= (k) && (k) < hi)
#define BOTH(k) (IN(k) && IN((k) + 1))

    if (IN(0)) { p0a_phase(F); if (BOTH(0)) GRID_BAR(); }
    if (IN(1)) { p0b_phase(F); if (BOTH(1)) GRID_BAR(); }
    if (IN(2)) {
        { pg8::Gemm g{F.XN, F.WINP, M, N_PLAIN, 1024, 2048, 1 << 30}; pg8::StaticOrder S; S.init(M, N_PLAIN, F.G, (int)blockIdx.x);
          EpiInPlain E{0, F.U, F.Q, F.KV};
          pg8::gemm_phase<EpiInPlain, pg8::StaticOrder, true>(F.lds + RING_OFF, g, S, E); }
        { pg8::Gemm g{F.XN, F.WINI, M, N_IDX_PAD, K3, 2048, 32}; pg8::StaticOrder S; S.init(M, N_IDX_PAD, F.G, F.G - 1 - (int)blockIdx.x);
          EpiInIdx E{0, F.QI, F.KI, F.WI};
          pg8::gemm_phase<EpiInIdx, pg8::StaticOrder, true>(F.lds + RING_OFF, g, S, E); }
        if (BOTH(2)) GRID_BAR();
    }
    if (IN(3)) { p3_phase(F); if (BOTH(3)) GRID_BAR(); }
    if (IN(4)) {
        pg8::Gemm g{F.Z, F.WGLU, M, 512, 512, 512, 1 << 30}; pg8::StaticOrder S; S.init(M, 512, F.G, (int)blockIdx.x);
        EpiGlu E{0, F.Z, F.MIX, F.b_glu, F.SSQS};
        pg8::gemm_phase<EpiGlu, pg8::StaticOrder, true>(F.lds + RING_OFF, g, S, E);
        if (BOTH(4)) GRID_BAR();
    }
    if (IN(5)) {
        pg8::Gemm g{F.MIX, F.WOUT, M, 1024, 1024, 1024, 1 << 30}; pg8::StaticOrder S; S.init(M, 1024, F.G, (int)blockIdx.x);
        EpiOut E{8, F.x, F.out, F.A2, F.MOD, F.norm2_g, F.SSQS, F.SSQ2};
        pg8::gemm_phase<EpiOut, pg8::StaticOrder, true>(F.lds + RING_OFF, g, S, E);
        if (BOTH(5)) GRID_BAR();
    }
    if (IN(6)) {
        pg8::Gemm g{F.A2, F.W1, M, DFF, 1024, 1024, 1 << 30}; pg8::StaticOrder S; S.init(M, DFF, F.G, (int)blockIdx.x);
        EpiUp E{0, F.SSQ2, F.BIAS2, F.H};
        pg8::gemm_phase<EpiUp, pg8::StaticOrder, true>(F.lds + RING_OFF, g, S, E);
        if (BOTH(6)) GRID_BAR();
    }
    if (IN(7)) {
        pg8::Gemm g{F.H, F.W2, M, 1024, DFF, DFF, 1 << 30}; pg8::StaticOrder S; S.init(M, 1024, F.G, (int)blockIdx.x);
        EpiDown E{0, F.out, F.MOD};
        pg8::gemm_phase<EpiDown, pg8::StaticOrder, true>(F.lds + RING_OFF, g, S, E);
    }
#undef IN
#undef BOTH
}

extern "C" void kernel_launch(void* const* d_in, const int* in_sizes, int n_in, void* d_out, int out_size, void* d_ws, size_t ws_size, hipStream_t stream) {
    static int grid = 0;
    if (grid == 0) {
        if (n_in != 24 || in_sizes[0] != M * DM || out_size != M * DM || ws_size < WS_END) { fprintf(stderr, "kernel_launch: unexpected shapes (n_in %d, in0 %d, out %d, ws %zu); nothing launched\n", n_in, n_in > 0 ? in_sizes[0] : -1, out_size, ws_size); grid = -1; return; }
        int dev = 0, cus = 0, per_cu = 0;
        if (hipGetDevice(&dev) != hipSuccess || hipDeviceGetAttribute(&cus, hipDeviceAttributeMultiprocessorCount, dev) != hipSuccess) { fprintf(stderr, "kernel_launch: device query failed\n"); grid = -1; return; }
        if (hipFuncSetAttribute((const void*)fwd_kernel, hipFuncAttributeMaxDynamicSharedMemorySize, LDS_BYTES) != hipSuccess) { fprintf(stderr, "kernel_launch: hipFuncSetAttribute failed\n"); grid = -1; return; }
        if (hipOccupancyMaxActiveBlocksPerMultiprocessor(&per_cu, (const void*)fwd_kernel, NWAVES * 64, LDS_BYTES) != hipSuccess || per_cu < 1)
            fprintf(stderr, "kernel_launch: note: occupancy query reports %d workgroups per CU\n", per_cu);
        (void)hipGetLastError();
        grid = cus;
    }
    if (grid < 0) return;
    if (hipMemsetAsync((char*)d_ws + WS_CTL, 0, CTL_ZERO_BYTES, stream) != hipSuccess) { fprintf(stderr, "kernel_launch: memset failed\n"); return; }
    Args a{};
    for (int i = 0; i < 24; ++i) a.in[i] = (const float*)d_in[i];
    a.out = (float*)d_out; a.ws = (unsigned char*)d_ws;
    for (int li = 0; li < N_LAUNCHES; ++li) {
        a.ph_lo = (N_LAUNCHES == 1) ? 0 : li; a.ph_hi = (N_LAUNCHES == 1) ? NPHASE : li + 1; a.li = li;
        hipLaunchKernelGGL(fwd_kernel, dim3(grid), dim3(NWAVES * 64), LDS_BYTES, stream, a);
        const hipError_t le = hipPeekAtLastError();
        if (le != hipSuccess) { fprintf(stderr, "kernel_launch: launch %d failed: %s\n", li, hipGetErrorName(le)); break; }
    }
}
```

```cpp
#include <hip/hip_runtime.h>
#include <cstdio>
#include <cstdint>

#ifndef MK_N_LAUNCHES
#define MK_N_LAUNCHES 1
#endif

namespace pg8 {
#define PG8_LAS __attribute__((address_space(3)))
typedef unsigned short bf16_t;
typedef short bf16x8 __attribute__((ext_vector_type(8)));
typedef float f32x4 __attribute__((ext_vector_type(4)));
typedef unsigned u32x4 __attribute__((ext_vector_type(4)));
typedef unsigned u32x2 __attribute__((ext_vector_type(2)));
constexpr int BM = 256, BK = 64, HALF = 128, HTB = HALF * BK * 2, STAGE_BYTES = 8 * HTB, NXCD = 8, WGM = 8;

__host__ __device__ __forceinline__ int lds_byte(int r, int c) { const int st = (r >> 4) * 2 + (c >> 5), rr = r & 15, cc = c & 31, ob = rr * 64 + cc * 2; return st * 1024 + (ob ^ (((ob >> 9) & 1) << 5)); }
__host__ __device__ __forceinline__ void stage_rc(int b, int& R, int& C) { const int st = b / 1024, sb = b % 1024, swz = sb ^ (((sb >> 9) & 1) << 5); R = (st >> 1) * 16 + swz / 64; C = (st & 1) * 32 + (swz % 64) / 2; }
__host__ __device__ __forceinline__ int perm32(int rho) { const int n = rho >> 4, i = rho & 15; return 8 * (i >> 2) + 4 * n + (i & 3); }

struct Unit { int pm, pn; };
struct Gemm { const bf16_t* A; const bf16_t* Bt; int M, N, K, lda, wrapA; };

struct StaticOrder {
    int nM, nN, nwg, G, c;
    __host__ __device__ void init(int M, int N, int G_, int c_) { nM = M / BM; nN = N / BM; nwg = nM * nN; G = G_; c = c_; }
    __host__ __device__ bool next(int i, Unit& u) const {
        const long L = (long)i * G + c; if (L >= nwg) return false;
        int wgid = (int)L; { const int q = nwg / NXCD, r = nwg % NXCD, xcd = wgid % NXCD, off = wgid / NXCD; wgid = (xcd < r ? xcd * (q + 1) : r * (q + 1) + (xcd - r) * q) + off; }
        const int nig = WGM * nN, gid = wgid / nig, fm = gid * WGM, gsz = (nM - fm) < WGM ? (nM - fm) : WGM;
        u.pm = fm + ((wgid % nig) % gsz); u.pn = (wgid % nig) / gsz; return true;
    }
};

__device__ __forceinline__ unsigned cvt_pk_bf16(float lo, float hi) { unsigned r; asm volatile("v_cvt_pk_bf16_f32 %0, %1, %2" : "=v"(r) : "v"(lo), "v"(hi)); return r; }

template <class Epi, class Sched, bool ALIGN_EPI>
__device__ __forceinline__ void gemm_phase(PG8_LAS unsigned char* lds, const Gemm g, const Sched& S, const Epi& E) {
    const int tid = threadIdx.x, wid = __builtin_amdgcn_readfirstlane(tid >> 6), lane = tid & 63, wr = wid >> 2, wc = wid & 3, fr = lane & 15, fq = lane >> 4;
    const int K = g.K, nt = K / BK, lda = g.lda, wrapA = g.wrapA;
    unsigned voffA[2], voffB[2];
#pragma unroll
    for (int i = 0; i < 2; ++i) { int R, C; stage_rc(tid * 16 + i * 8192, R, C); const int Rb = Epi::PERM ? ((R & ~31) + perm32(R & 31)) : R;
        voffA[i] = (unsigned)(R * lda + C) * 2u; voffB[i] = (unsigned)(Rb * K + C) * 2u; }
    const size_t kstep = (size_t)(BK * 2);
    const size_t hsA = (size_t)HALF * lda * 2, hsB = (size_t)HALF * K * 2;
    const size_t tsA = 2 * hsA, tsB = 2 * hsB;
    const unsigned ldsw = (unsigned)wid * 1024u;
    const int aoff = lds_byte(wr * 64 + fr, fq * 8), boff = lds_byte(wc * 32 + fr, fq * 8);
#define PG8_SA(b, h) (((b) * 2 + (h)) * HTB)
#define PG8_SB(b, h) ((4 + (b) * 2 + (h)) * HTB)
#define PG8_STAGE(bufoff, gbase, voff) do { _Pragma("unroll") for (int _i = 0; _i < 2; ++_i) \
        __builtin_amdgcn_global_load_lds((const unsigned*)((const char*)(gbase) + (voff)[_i]), (PG8_LAS unsigned*)(lds + (bufoff) + ldsw + _i * 8192), 16, 0, 0); } while (0)
#define PG8_LDA(dst, b, h) do { _Pragma("unroll") for (int m = 0; m < 4; ++m) _Pragma("unroll") for (int k = 0; k < 2; ++k) dst[m][k] = *(const PG8_LAS bf16x8*)(lds + PG8_SA(b, h) + aoff + m * 2048 + k * 1024); } while (0)
#define PG8_LDB(dst, b, h) do { _Pragma("unroll") for (int n = 0; n < 2; ++n) _Pragma("unroll") for (int k = 0; k < 2; ++k) dst[n][k] = *(const PG8_LAS bf16x8*)(lds + PG8_SB(b, h) + boff + n * 2048 + k * 1024); } while (0)
#define PG8_MMA(ai, bj, At, Bt) do { __builtin_amdgcn_s_setprio(1); _Pragma("unroll") for (int m = 0; m < 4; ++m) _Pragma("unroll") for (int n = 0; n < 2; ++n) _Pragma("unroll") for (int k = 0; k < 2; ++k) \
        acc[ai][bj][m][n] = __builtin_amdgcn_mfma_f32_16x16x32_bf16(Bt[n][k], At[m][k], acc[ai][bj][m][n], 0, 0, 0); __builtin_amdgcn_s_setprio(0); } while (0)
#define PG8_WAIT_V(n) asm volatile("s_waitcnt vmcnt(" #n ")" ::: "memory")
#define PG8_WAIT_L(n) asm volatile("s_waitcnt lgkmcnt(" #n ")" ::: "memory")
#define PG8_BAR __builtin_amdgcn_s_barrier()
#define PG8_SCHED __builtin_amdgcn_sched_barrier(0)
#define PG8_AT(t) ((t) >= wrapA ? (t) - wrapA : (t))
    Unit cur, nxt; int ui = 0;
    if (!S.next(0, cur)) return;
    f32x4 acc[2][2][4][2];
#pragma unroll
    for (int a = 0; a < 2; ++a)
#pragma unroll
        for (int b = 0; b < 2; ++b)
#pragma unroll
            for (int m = 0; m < 4; ++m)
#pragma unroll
                for (int n = 0; n < 2; ++n) acc[a][b][m][n] = (f32x4){0.f, 0.f, 0.f, 0.f};
    bf16x8 At[4][2], B0[2][2], B1[2][2];
    const char* cA = (const char*)g.A + (size_t)cur.pm * tsA; const char* cB = (const char*)g.Bt + (size_t)cur.pn * tsB;
    PG8_STAGE(PG8_SB(0, 0), cB, voffB); PG8_STAGE(PG8_SB(0, 1), cB + hsB, voffB); PG8_STAGE(PG8_SA(0, 0), cA, voffA); PG8_STAGE(PG8_SA(0, 1), cA + hsA, voffA);
    if (wr == 1) PG8_BAR;
    PG8_WAIT_V(2); PG8_BAR;
    PG8_STAGE(PG8_SB(1, 0), cB + kstep, voffB); PG8_STAGE(PG8_SA(1, 0), cA + kstep, voffA); PG8_STAGE(PG8_SB(1, 1), cB + hsB + kstep, voffB);
    PG8_WAIT_V(6); PG8_BAR;
    for (;;) {
        const bool has_next = S.next(ui + 1, nxt);
        const char* nA = has_next ? (const char*)g.A + (size_t)nxt.pm * tsA : cA; const char* nB = has_next ? (const char*)g.Bt + (size_t)nxt.pn * tsB : cB;
        for (int t = 0; t < nt; t += 2) {
            const bool last = (t == nt - 2);
            const char* a1 = cA + (size_t)PG8_AT(t + 1) * kstep;
            const char* a2 = last ? nA : cA + (size_t)PG8_AT(t + 2) * kstep; const char* b2 = last ? nB : cB + (size_t)(t + 2) * kstep;
            const char* a3 = a2 + kstep; const char* b3 = b2 + kstep;
            if constexpr (Epi::MID) { if (t == E.tmid) E.mid(acc, cur, wr, wc, fr, fq); }
            PG8_LDB(B0, 0, 0); PG8_LDB(B1, 0, 1); PG8_SCHED; PG8_LDA(At, 0, 0); PG8_STAGE(PG8_SA(1, 1), a1 + hsA, voffA);
            PG8_WAIT_V(8); PG8_WAIT_L(0); PG8_BAR; PG8_MMA(0, 0, At, B0); PG8_MMA(0, 1, At, B1); PG8_BAR; PG8_SCHED;
            PG8_LDA(At, 0, 1); PG8_STAGE(PG8_SB(0, 0), b2, voffB); PG8_STAGE(PG8_SB(0, 1), b2 + hsB, voffB); PG8_STAGE(PG8_SA(0, 0), a2, voffA);
            PG8_WAIT_V(8); PG8_WAIT_L(0); PG8_BAR; PG8_MMA(1, 0, At, B0); PG8_MMA(1, 1, At, B1); PG8_BAR; PG8_SCHED;
            PG8_LDB(B0, 1, 0); PG8_LDB(B1, 1, 1); PG8_SCHED; PG8_LDA(At, 1, 0); PG8_STAGE(PG8_SA(0, 1), a2 + hsA, voffA);
            PG8_WAIT_V(8); PG8_WAIT_L(0); PG8_BAR; PG8_MMA(0, 0, At, B0); PG8_MMA(0, 1, At, B1); PG8_BAR; PG8_SCHED;
            PG8_LDA(At, 1, 1); PG8_STAGE(PG8_SB(1, 0), b3, voffB); PG8_STAGE(PG8_SB(1, 1), b3 + hsB, voffB); PG8_STAGE(PG8_SA(1, 0), a3, voffA);
            PG8_WAIT_V(8); PG8_WAIT_L(0); PG8_BAR; PG8_MMA(1, 0, At, B0); PG8_MMA(1, 1, At, B1); PG8_BAR; PG8_SCHED;
        }
        if constexpr (ALIGN_EPI) { if (wr == 0) PG8_BAR; }
        E(acc, cur, wr, wc, fr, fq);
        if (!has_next) break;
#pragma unroll
        for (int a = 0; a < 2; ++a)
#pragma unroll
            for (int b = 0; b < 2; ++b)
#pragma unroll
                for (int m = 0; m < 4; ++m)
#pragma unroll
                    for (int n = 0; n < 2; ++n) acc[a][b][m][n] = (f32x4){0.f, 0.f, 0.f, 0.f};
        cur = nxt; cA = nA; cB = nB; ++ui;
        if constexpr (ALIGN_EPI) { if (wr == 1) PG8_BAR; }
    }
    PG8_WAIT_V(0);
    if constexpr (!ALIGN_EPI) { if (wr == 0) PG8_BAR; }
    PG8_BAR;
#undef PG8_SA
#undef PG8_SB
#undef PG8_STAGE
#undef PG8_LDA
#undef PG8_LDB
#undef PG8_MMA
#undef PG8_WAIT_V
#undef PG8_WAIT_L
#undef PG8_BAR
#undef PG8_SCHED
#undef PG8_AT
}
}

constexpr int NWAVES = 8;
constexpr int NPHASE = 8;
constexpr int N_LAUNCHES = MK_N_LAUNCHES;
constexpr int BATCH = 16, SEQ = 2048, DM = 1024, M = BATCH * SEQ;
constexpr int D_SSM = 512, NG = 32, GC = 16, NP = 64, D_ATT = 512, HD = 64, NH = 8, IH = 8, ID = 64, TOPK = 256, DFF = 4096, D_IN = 1864;
constexpr int N_PLAIN = 1280, N_IDX_PAD = 768, K3 = 3072;
constexpr float EPS = 1e-6f;
constexpr float IDX_SCALE = 0.125f * 0.35355339059327373f;

constexpr size_t MiB = 1u << 20;
constexpr size_t WS_CTL = 0, CTL_ZERO_BYTES = 1 * MiB;
constexpr size_t WS_MODP = 1 * MiB;
constexpr size_t WS_MOD = 4 * MiB;
constexpr size_t WS_BIAS2 = 4 * MiB + 512 * 1024;
constexpr size_t WS_SSQS = 5 * MiB;
constexpr size_t WS_SSQ2 = 6 * MiB;
constexpr size_t WS_SSQA = 35 * MiB + 512 * 1024;
constexpr size_t WS_WINP = 8 * MiB;
constexpr size_t WS_WINI = 11 * MiB;
constexpr size_t WS_WGLU = 16 * MiB;
constexpr size_t WS_WOUT = 17 * MiB;
constexpr size_t WS_W1 = 19 * MiB;
constexpr size_t WS_W2 = 27 * MiB;
constexpr size_t WS_SSMP = 35 * MiB;
constexpr size_t WS_U = 36 * MiB;
constexpr size_t WS_Q = 68 * MiB;
constexpr size_t WS_A2 = 36 * MiB;
constexpr size_t WS_XN = 100 * MiB;
constexpr size_t WS_KV = 228 * MiB;
constexpr size_t WS_KI = 244 * MiB;
constexpr size_t WS_WI = 252 * MiB;
constexpr size_t WS_QI = 256 * MiB;
constexpr size_t WS_Z = 320 * MiB;
constexpr size_t WS_MIX = 352 * MiB;
constexpr size_t WS_H = 256 * MiB;
constexpr size_t WS_END = 512 * MiB;
constexpr int CW_BAR = 4096;

constexpr int RING_OFF = 0;
constexpr int WAVE_LDS = 17920;
constexpr int BM_OFF = 131072;
constexpr int LDSCTL_OFF = 147456, MISC_OFF = LDSCTL_OFF + 320;
constexpr int LDS_BYTES = 151552;

#define GAS __attribute__((address_space(1)))
#define LAS __attribute__((address_space(3)))
typedef unsigned short bf16;
typedef unsigned v4u __attribute__((ext_vector_type(4)));
typedef unsigned v2u __attribute__((ext_vector_type(2)));
typedef float f32x4 __attribute__((ext_vector_type(4)));
typedef float f32x2 __attribute__((ext_vector_type(2)));
typedef GAS unsigned gu32;
#define RLX_AGENT __ATOMIC_RELAXED, __HIP_MEMORY_SCOPE_AGENT
#define LDS_WAIT() asm volatile("s_waitcnt lgkmcnt(0)" ::: "memory")
#define VM_WAIT() asm volatile("s_waitcnt vmcnt(0)" ::: "memory")
__device__ __forceinline__ unsigned f2bf(float f) { unsigned u = __builtin_bit_cast(unsigned, f); return (u + 0x7fffu + ((u >> 16) & 1u)) >> 16; }
__device__ __forceinline__ unsigned pk2(float lo, float hi) { return f2bf(lo) | (f2bf(hi) << 16); }
__device__ __forceinline__ float bf2f(unsigned h) { return __builtin_bit_cast(float, h << 16); }
__device__ __forceinline__ float bflo(unsigned w) { return __builtin_bit_cast(float, w << 16); }
__device__ __forceinline__ float bfhi(unsigned w) { return __builtin_bit_cast(float, w & 0xffff0000u); }

#define XB_TMO      128
#define XB_XCNT(j)  (256  + 64 * (j))
#define XB_XSUB(j)  (1280 + 64 * (j))
#define XB_XGEN(j)  (2304 + 64 * (j))
#define XB_TOP      3328
#define XB_TOPGEN   3392
#define XCD_BAR_WORDS 3456
#define XB_SPIN_CAP (1u << 18)
__device__ __forceinline__ unsigned xb_ld(unsigned* p)              { return __hip_atomic_load(p, __ATOMIC_RELAXED, __HIP_MEMORY_SCOPE_AGENT); }
__device__ __forceinline__ unsigned xb_add(unsigned* p, unsigned v) { return __hip_atomic_fetch_add(p, v, __ATOMIC_RELAXED, __HIP_MEMORY_SCOPE_AGENT); }
__device__ __forceinline__ unsigned xb_xcc_id() { return (unsigned)__builtin_amdgcn_s_getreg((3 << 11) | 20) & 0xFu; }
#define XB_SPIN(cond, bar) do { unsigned _sp = 0; while (cond) { __builtin_amdgcn_s_sleep(1); \
    if ((++_sp & 255u) == 0u) { if (xb_ld(&(bar)[XB_TMO])) break; if (_sp > XB_SPIN_CAP) { atomicAdd(&(bar)[XB_TMO], 1u); break; } } } } while (0)
struct XcdBarrier { unsigned* bar; unsigned x; volatile LAS unsigned* st; };
__device__ __forceinline__ XcdBarrier xcd_barrier_post(unsigned* bar, volatile LAS unsigned* st) {
    XcdBarrier b; b.bar = bar; b.x = xb_xcc_id(); b.st = st;
    if (threadIdx.x == 0) (void)xb_add(&bar[XB_XCNT(b.x)], 1u);
    return b;
}
__device__ __forceinline__ void xcd_barrier_complete(unsigned* bar, unsigned x, unsigned& nloc, unsigned& nx) {
    const unsigned G = gridDim.x * gridDim.y * gridDim.z;
    unsigned sum, cnt, mine, sp = 0u;
    for (;;) {
        sum = 0u; cnt = 0u; mine = 0u;
#pragma unroll
        for (unsigned j = 0; j < 16; ++j) { const unsigned c = xb_ld(&bar[XB_XCNT(j)]); sum += c; cnt += (c > 0u) ? 1u : 0u; mine = (j == x) ? c : mine; }
        if (sum == G) break;
        __builtin_amdgcn_s_sleep(1);
        if ((++sp & 255u) == 0u) { if (xb_ld(&bar[XB_TMO])) break; if (sp > XB_SPIN_CAP) { atomicAdd(&bar[XB_TMO], 1u); break; } }
    }
    nloc = mine > 0u ? mine : 1u; nx = cnt > 0u ? cnt : 1u;
}
__device__ __forceinline__ void xcd_barrier(const XcdBarrier& b) {
    asm volatile("s_waitcnt vmcnt(0)" ::: "memory");
    __syncthreads();
    if (threadIdx.x == 0) {
        unsigned* bar = b.bar;
        __builtin_amdgcn_s_waitcnt(0);
        unsigned nloc = b.st[0], nx = b.st[1];
        if (nloc == 0u) { xcd_barrier_complete(bar, b.x, nloc, nx); b.st[0] = nloc; b.st[1] = nx; }
        const unsigned old = xb_add(&bar[XB_XSUB(b.x)], 1u);
        const unsigned gen = old / nloc;
        if (old + 1u == (gen + 1u) * nloc) {
            __builtin_amdgcn_fence(__ATOMIC_RELEASE, "agent");
            asm volatile("s_waitcnt vmcnt(0)" ::: "memory");
            const unsigned og = xb_add(&bar[XB_TOP], 1u);
            const unsigned tg = og / nx;
            if (og + 1u == (tg + 1u) * nx) xb_add(&bar[XB_TOPGEN], 1u);
            else XB_SPIN(xb_ld(&bar[XB_TOPGEN]) == tg, bar);
            __builtin_amdgcn_fence(__ATOMIC_ACQUIRE, "agent");
            xb_add(&bar[XB_XGEN(b.x)], 1u);
            asm volatile("s_waitcnt vmcnt(0)" ::: "memory");
        } else {
            XB_SPIN(xb_ld(&bar[XB_XGEN(b.x)]) == gen, bar);
            __builtin_amdgcn_fence(__ATOMIC_ACQUIRE, "agent");
            asm volatile("s_waitcnt vmcnt(0)" ::: "memory");
        }
    }
    __syncthreads();
}

struct Frame {
    LAS unsigned char* lds;
    volatile LAS unsigned* MISC;
    gu32* ctl;
    int tid, lane, wave;
    int vcu, G;
    const float *x, *c, *norm1_g, *norm2_g, *w_ada, *b_ada, *w_in, *lam_re, *lam_im, *log_dt, *b_re, *b_im, *c_re, *c_im, *d_skip, *w_glu, *b_glu, *q_gain, *k_gain, *gn_ssm, *gn_attn, *w_out, *w_ff1, *w_ff2;
    float* out;
    float *MODP, *MOD, *BIAS2, *SSQS, *SSQ2, *SSQA, *WI;
    bf16 *KI2, *QI2;
    f32x2 *LAMB, *BBAR;
    bf16 *WINP, *WINI, *WGLU, *WOUT, *W1, *W2, *U, *Q, *A2, *XN, *KV, *Z, *MIX, *H;
};

__device__ __forceinline__ float wave_sum(float v) {
#pragma unroll
    for (int o = 1; o < 64; o <<= 1) v += __shfl_xor(v, o);
    return v;
}
__device__ __forceinline__ float wave_max(float v) {
#pragma unroll
    for (int o = 1; o < 64; o <<= 1) v = fmaxf(v, __shfl_xor(v, o));
    return v;
}
__device__ __forceinline__ int wave_sum_i(int v) {
#pragma unroll
    for (int o = 1; o < 64; o <<= 1) v += __shfl_xor(v, o);
    return v;
}

__device__ __forceinline__ double exp_d(double x) {
    const double n = __builtin_rint(x * 1.4426950408889634);
    const double r = (x - n * 0.693147180369123816490e+00) - n * 1.90821492927058770002e-10;
    double p = 1.0 / 87178291200.0;
    p = p * r + 1.0 / 6227020800.0; p = p * r + 1.0 / 479001600.0; p = p * r + 1.0 / 39916800.0; p = p * r + 1.0 / 3628800.0; p = p * r + 1.0 / 362880.0;
    p = p * r + 1.0 / 40320.0; p = p * r + 1.0 / 5040.0; p = p * r + 1.0 / 720.0; p = p * r + 1.0 / 120.0; p = p * r + 1.0 / 24.0; p = p * r + 1.0 / 6.0; p = p * r + 0.5; p = p * r + 1.0; p = p * r + 1.0;
    const long long e = (long long)n + 1023;
    return p * __builtin_bit_cast(double, (unsigned long long)e << 52);
}
__device__ __forceinline__ void sincos_d(double x, double& s, double& c) {
    const double n = __builtin_rint(x * 0.63661977236758134308);
    double r = (x - n * 1.57079632673412561417e+00) - n * 6.07710050650619224932e-11;
    r = r - n * 2.02226624879595063154e-21;
    const double r2 = r * r;
    double sp = -1.0 / 1307674368000.0;
    sp = sp * r2 + 1.0 / 6227020800.0; sp = sp * r2 - 1.0 / 39916800.0; sp = sp * r2 + 1.0 / 362880.0; sp = sp * r2 - 1.0 / 5040.0; sp = sp * r2 + 1.0 / 120.0; sp = sp * r2 - 1.0 / 6.0; sp = sp * r2 + 1.0;
    const double sr = sp * r;
    double cp = 1.0 / 20922789888000.0;
    cp = cp * r2 - 1.0 / 87178291200.0; cp = cp * r2 + 1.0 / 479001600.0; cp = cp * r2 - 1.0 / 3628800.0; cp = cp * r2 + 1.0 / 40320.0; cp = cp * r2 - 1.0 / 720.0; cp = cp * r2 + 1.0 / 24.0; cp = cp * r2 - 0.5; cp = cp * r2 + 1.0;
    const long long q = (long long)n & 3;
    s = (q == 0) ? sr : (q == 1) ? cp : (q == 2) ? -sr : -cp;
    c = (q == 0) ? cp : (q == 1) ? -sr : (q == 2) ? -cp : sr;
}

template <int MODE>
__device__ __forceinline__ void p0_transpose_item(Frame& F, const float* W, int K, int N, bf16* WT, LAS float* scr, int item, int lane) {
    const int nblk = (N + 31) / 32, kb = item / nblk, nb = item % nblk, k0 = 64 * kb, n0 = 32 * nb;
#pragma unroll 8
    for (int i = 0; i < 32; ++i) { const int kk = 2 * i + (lane >> 5); const int n = n0 + (lane & 31);
        float v = (MODE != 1 || n < N) ? W[(size_t)(k0 + kk) * N + n] : 0.f;
        if (MODE == 2) { const int k = k0 + kk; v *= (k < D_SSM) ? F.gn_ssm[k] : F.gn_attn[k - D_SSM]; }
        scr[kk * 33 + (lane & 31)] = v; }
    LDS_WAIT(); asm volatile("" ::: "memory");
    const int c = lane & 7;
#pragma unroll
    for (int j = 0; j < 4; ++j) { const int n = (lane >> 3) + 8 * j; const LAS float* s = scr + (8 * c) * 33 + n;
        float v[8];
#pragma unroll
        for (int e = 0; e < 8; ++e) v[e] = s[e * 33];
        v4u o; o.x = pk2(v[0], v[1]); o.y = pk2(v[2], v[3]); o.z = pk2(v[4], v[5]); o.w = pk2(v[6], v[7]);
        if (MODE != 1) { *(GAS v4u*)(WT + (size_t)(n0 + n) * K + k0 + 8 * c) = o; }
        else {
            const int ng = n0 + n;
            if (ng < N_PLAIN) { *(GAS v4u*)(F.WINP + (size_t)ng * 1024 + k0 + 8 * c) = o; }
            else {
                float l[8];
#pragma unroll
                for (int e = 0; e < 8; ++e) l[e] = v[e] - bf2f(f2bf(v[e]));
                v4u ol; ol.x = pk2(l[0], l[1]); ol.y = pk2(l[2], l[3]); ol.z = pk2(l[4], l[5]); ol.w = pk2(l[6], l[7]);
                bf16* d = F.WINI + (size_t)(ng - N_PLAIN) * K3 + k0 + 8 * c;
                *(GAS v4u*)(d) = o; *(GAS v4u*)(d + 1024) = o; *(GAS v4u*)(d + 2048) = ol;
            }
        } }
    LDS_WAIT(); asm volatile("" ::: "memory");
}

__device__ __forceinline__ void p0_mod_item(Frame& F, int item, LAS float* scr) {
    const int cg = item >> 3, ks = item & 7, j = cg * 64 + F.lane, k0 = ks * 128;
    for (int e = F.lane; e < 2048; e += 64) { const int b = e >> 7, i = e & 127; const float cv = F.c[b * 1024 + k0 + i]; scr[e] = cv / (1.f + __expf(-cv)); }
    LDS_WAIT(); asm volatile("" ::: "memory");
    float acc[16];
#pragma unroll
    for (int b = 0; b < 16; ++b) acc[b] = 0.f;
    for (int i4 = 0; i4 < 32; ++i4) {
        const float* wp = F.w_ada + (size_t)(k0 + 4 * i4) * 6144 + j;
        const float w0 = wp[0], w1 = wp[6144], w2 = wp[2 * 6144], w3 = wp[3 * 6144];
#pragma unroll
        for (int b = 0; b < 16; ++b) { const f32x4 s = *(const LAS f32x4*)(scr + b * 128 + 4 * i4); acc[b] += s.x * w0 + s.y * w1 + s.z * w2 + s.w * w3; }
    }
#pragma unroll
    for (int b = 0; b < 16; ++b) F.MODP[(size_t)(ks * 16 + b) * 6144 + j] = acc[b];
    LDS_WAIT(); asm volatile("" ::: "memory");
}

__device__ __forceinline__ void p0_ssm_item(Frame& F, int g) {
    const int p = F.lane, gp = g * 64 + p;
    const double lre = (double)F.lam_re[gp], lim = (double)F.lam_im[gp], dt = exp_d((double)F.log_dt[g]);
    double s, c; sincos_d(lim * dt, s, c);
    const double mag = exp_d(lre * dt), lbr = mag * c, lbi = mag * s;
    const double a = lbr - 1.0, b = lbi, den = lre * lre + lim * lim;
    const double cr = (a * lre + b * lim) / den, ci = (b * lre - a * lim) / den;
    F.LAMB[gp] = (f32x2){(float)lbr, (float)lbi};
#pragma unroll
    for (int cc = 0; cc < 16; ++cc) { const double br = (double)F.b_re[gp * 16 + cc], bi = (double)F.b_im[gp * 16 + cc];
        F.BBAR[gp * 16 + cc] = (f32x2){(float)(cr * br - ci * bi), (float)(cr * bi + ci * br)}; }
}

__device__ __forceinline__ void p0a_phase(Frame& F) {
    LAS float* scr = (LAS float*)(F.lds + RING_OFF + F.wave * WAVE_LDS);
    const int gw = F.vcu * NWAVES + F.wave, NGW = F.G * NWAVES;
    constexpr int I_MOD = 96 * 8, I_SSM = 32;
    constexpr int I_IN = 16 * 59, I_GLU = 8 * 16, I_OUT = 16 * 32, I_1 = 16 * 128, I_2 = 64 * 32;
    constexpr int NITEMS = I_MOD + I_SSM + I_IN + I_GLU + I_OUT + I_1 + I_2;
    for (int it = gw; it < NITEMS; it += NGW) {
        int r = it;
        if (r < I_MOD) { p0_mod_item(F, r, scr); continue; } r -= I_MOD;
        if (r < I_SSM) { p0_ssm_item(F, r); continue; } r -= I_SSM;
        if (r < I_IN) { p0_transpose_item<1>(F, F.w_in, 1024, D_IN, nullptr, scr, r, F.lane); continue; } r -= I_IN;
        if (r < I_GLU) { p0_transpose_item<0>(F, F.w_glu, 512, 512, F.WGLU, scr, r, F.lane); continue; } r -= I_GLU;
        if (r < I_OUT) { p0_transpose_item<2>(F, F.w_out, 1024, 1024, F.WOUT, scr, r, F.lane); continue; } r -= I_OUT;
        if (r < I_1) { p0_transpose_item<0>(F, F.w_ff1, 1024, DFF, F.W1, scr, r, F.lane); continue; } r -= I_1;
        p0_transpose_item<0>(F, F.w_ff2, DFF, 1024, F.W2, scr, r, F.lane);
    }
    { const int gt = (F.vcu * NWAVES + F.wave) * 64 + F.lane, NT = F.G * NWAVES * 64; GAS v4u* z = (GAS v4u*)(F.WINI + (size_t)608 * K3);
      for (int i = gt; i < 160 * K3 / 8; i += NT) z[i] = (v4u){0u, 0u, 0u, 0u}; }
}

__device__ __forceinline__ void p0b_phase(Frame& F) {
    const int w = F.vcu;
    { const int idx = w * 384 + F.tid;
      if (F.tid < 384 && idx < 16 * 6144) { const int j = idx % 6144; float s = F.b_ada[j];
#pragma unroll
          for (int ks = 0; ks < 8; ++ks) s += F.MODP[(size_t)ks * 16 * 6144 + idx];
          F.MOD[idx] = s; } }
    LAS float* sh = (LAS float*)(F.lds + RING_OFF);
    for (int rb = w; rb < M / 128; rb += F.G) {
        const int b = rb / 16;
        __syncthreads();
        for (int e = F.tid; e < 2048; e += NWAVES * 64) { float s = F.b_ada[e];
#pragma unroll
            for (int ks = 0; ks < 8; ++ks) s += F.MODP[(size_t)(ks * 16 + b) * 6144 + e];
            sh[e] = s; }
        __syncthreads();
        for (int r = 0; r < 16; ++r) {
            const size_t m = (size_t)rb * 128 + F.wave * 16 + r;
            const GAS f32x4* xr = (const GAS f32x4*)(F.x + m * DM) + F.lane;
            f32x4 v[4]; float ss = 0.f;
#pragma unroll
            for (int j = 0; j < 4; ++j) { v[j] = xr[64 * j]; ss += (v[j].x * v[j].x + v[j].y * v[j].y) + (v[j].z * v[j].z + v[j].w * v[j].w); }
            const float rstd = 1.0f / sqrtf(wave_sum(ss) * (1.f / DM) + EPS);
            GAS v2u* oh = (GAS v2u*)(F.XN + m * 2048) + F.lane;
#pragma unroll
            for (int j = 0; j < 4; ++j) { const int col = 4 * F.lane + 256 * j;
                const f32x4 g = *(const f32x4*)(F.norm1_g + col); const f32x4 s1 = *(const LAS f32x4*)(sh + col); const f32x4 c1 = *(const LAS f32x4*)(sh + 1024 + col);
                f32x4 h = v[j] * rstd * g * (c1 + 1.0f) + s1;
                float hh[4] = {h.x, h.y, h.z, h.w}, hl[4];
#pragma unroll
                for (int e = 0; e < 4; ++e) hl[e] = hh[e] - bf2f(f2bf(hh[e]));
                oh[64 * j] = (v2u){pk2(hh[0], hh[1]), pk2(hh[2], hh[3])};
                oh[256 + 64 * j] = (v2u){pk2(hl[0], hl[1]), pk2(hl[2], hl[3])}; }
        }
    }
}

using pg8::Unit; using pg8::cvt_pk_bf16;
struct EpiInPlain {
    static constexpr bool PERM = true, MID = false; int tmid;
    bf16 *U, *Q, *KV;
    __device__ __forceinline__ void mid(f32x4 (&)[2][2][4][2], const Unit&, int, int, int, int) const {}
    __device__ __forceinline__ void operator()(const f32x4 (&acc)[2][2][4][2], const Unit& u, int wr, int wc, int fr, int fq) const {
        bf16* base; int ldc, colt;
        if (u.pn < 2) { base = U; ldc = 512; colt = u.pn * 256; } else if (u.pn < 4) { base = Q; ldc = 512; colt = (u.pn - 2) * 256; } else { base = KV; ldc = 256; colt = 0; }
        const int row0 = u.pm * 256 + wr * 64 + fr, col0 = colt + wc * 32 + 8 * fq;
#pragma unroll
        for (int ai = 0; ai < 2; ++ai)
#pragma unroll
            for (int m = 0; m < 4; ++m) { bf16* rowp = base + (size_t)(row0 + ai * 128 + m * 16) * ldc + col0;
#pragma unroll
                for (int bj = 0; bj < 2; ++bj) { const f32x4 v0 = acc[ai][bj][m][0], v1 = acc[ai][bj][m][1];
                    v4u wv; wv.x = cvt_pk_bf16(v0[0], v0[1]); wv.y = cvt_pk_bf16(v0[2], v0[3]); wv.z = cvt_pk_bf16(v1[0], v1[1]); wv.w = cvt_pk_bf16(v1[2], v1[3]);
                    *(v4u*)(rowp + bj * 128) = wv; } }
    }
};
struct EpiInIdx {
    static constexpr bool PERM = false, MID = false; int tmid;
    bf16 *QI2, *KI2; float* WI;
    __device__ __forceinline__ void mid(f32x4 (&)[2][2][4][2], const Unit&, int, int, int, int) const {}
    __device__ __forceinline__ static void st_hilo(bf16* hp, bf16* lp, const f32x4 v) {
        const float l0 = v[0] - bf2f(f2bf(v[0])), l1 = v[1] - bf2f(f2bf(v[1])), l2 = v[2] - bf2f(f2bf(v[2])), l3 = v[3] - bf2f(f2bf(v[3]));
        *(v2u*)hp = (v2u){pk2(v[0], v[1]), pk2(v[2], v[3])}; *(v2u*)lp = (v2u){pk2(l0, l1), pk2(l2, l3)};
    }
    __device__ __forceinline__ void operator()(const f32x4 (&acc)[2][2][4][2], const Unit& u, int wr, int wc, int fr, int fq) const {
        const int row0 = u.pm * 256 + wr * 64 + fr;
        if (u.pn < 2) {
            const int col0 = u.pn * 256 + wc * 32 + 4 * fq;
#pragma unroll
            for (int ai = 0; ai < 2; ++ai)
#pragma unroll
                for (int m = 0; m < 4; ++m) { bf16* rowp = QI2 + (size_t)(row0 + ai * 128 + m * 16) * 1024 + col0;
#pragma unroll
                    for (int bj = 0; bj < 2; ++bj)
#pragma unroll
                        for (int n = 0; n < 2; ++n) st_hilo(rowp + bj * 128 + n * 16, rowp + 512 + bj * 128 + n * 16, acc[ai][bj][m][n]); }
        } else {
#pragma unroll
            for (int ai = 0; ai < 2; ++ai)
#pragma unroll
                for (int m = 0; m < 4; ++m) { const size_t row = (size_t)(row0 + ai * 128 + m * 16);
#pragma unroll
                    for (int n = 0; n < 2; ++n) { const int col = wc * 32 + 16 * n + 4 * fq;
                        if (col < 64) st_hilo(KI2 + row * 128 + col, KI2 + row * 128 + 64 + col, acc[ai][0][m][n]);
                        else if (col < 72) *(f32x4*)(WI + row * 8 + (col - 64)) = acc[ai][0][m][n]; } }
        }
    }
};
struct EpiGlu {
    static constexpr bool PERM = true, MID = false; int tmid;
    const bf16* Z; bf16* MIX; const float* bglu; float* SSQS;
    __device__ __forceinline__ void mid(f32x4 (&)[2][2][4][2], const Unit&, int, int, int, int) const {}
    __device__ __forceinline__ void operator()(const f32x4 (&acc)[2][2][4][2], const Unit& u, int wr, int wc, int fr, int fq) const {
        const int row0 = u.pm * 256 + wr * 64 + fr, col0 = u.pn * 256 + wc * 32 + 8 * fq;
#pragma unroll
        for (int ai = 0; ai < 2; ++ai)
#pragma unroll
            for (int m = 0; m < 4; ++m) { const size_t row = (size_t)(row0 + ai * 128 + m * 16); float ss = 0.f;
#pragma unroll
                for (int bj = 0; bj < 2; ++bj) { const int col = col0 + bj * 128;
                    const v4u zz = *(const v4u*)(Z + row * 512 + col);
                    const f32x4 b0 = *(const f32x4*)(bglu + col), b1 = *(const f32x4*)(bglu + col + 4);
                    const f32x4 a0 = acc[ai][bj][m][0] + b0, a1 = acc[ai][bj][m][1] + b1;
                    float zf[8] = {bflo(zz.x), bfhi(zz.x), bflo(zz.y), bfhi(zz.y), bflo(zz.z), bfhi(zz.z), bflo(zz.w), bfhi(zz.w)};
                    float av[8] = {a0[0], a0[1], a0[2], a0[3], a1[0], a1[1], a1[2], a1[3]}, y[8];
#pragma unroll
                    for (int e = 0; e < 8; ++e) { y[e] = zf[e] / (1.f + __expf(-av[e])); ss += y[e] * y[e]; }
                    v4u wv; wv.x = cvt_pk_bf16(y[0], y[1]); wv.y = cvt_pk_bf16(y[2], y[3]); wv.z = cvt_pk_bf16(y[4], y[5]); wv.w = cvt_pk_bf16(y[6], y[7]);
                    *(v4u*)(MIX + row * 1024 + col) = wv; }
                ss += __shfl_xor(ss, 16); ss += __shfl_xor(ss, 32);
                if (fq == 0) SSQS[row * 8 + u.pn * 4 + wc] = ss; }
    }
};
struct EpiOut {
    static constexpr bool PERM = true, MID = true; int tmid;
    const float* x; float* x1; bf16* A2; const float* MOD; const float* g2n; const float* SSQS; float* SSQ2; const float* SSQA;
    __device__ __forceinline__ void mid(f32x4 (&acc)[2][2][4][2], const Unit& u, int wr, int wc, int fr_, int fq_) const {
        int fr = fr_, fq = fq_; asm volatile("" : "+v"(fr), "+v"(fq));
#pragma unroll
        for (int ai = 0; ai < 2; ++ai)
#pragma unroll
            for (int m = 0; m < 4; ++m) { const size_t row = (size_t)(u.pm * 256 + ai * 128 + wr * 64 + m * 16 + fr);
                const f32x4 p = *(const f32x4*)(SSQS + row * 8 + 4 * (fq & 1)); float s = (p.x + p.y) + (p.z + p.w); s += __shfl_xor(s, 16);
                const f32x2 sa = *(const f32x2*)(SSQA + row * 2);
                const float rstd = sqrtf((sa.x + sa.y) * (1.f / 512.f) + EPS) / sqrtf(s * (1.f / 512.f) + EPS);
#pragma unroll
                for (int bj = 0; bj < 2; ++bj)
#pragma unroll
                    for (int n = 0; n < 2; ++n) acc[ai][bj][m][n] *= rstd; }
    }
    __device__ __forceinline__ void operator()(const f32x4 (&acc)[2][2][4][2], const Unit& u, int wr, int wc, int fr, int fq) const {
        const int b = u.pm >> 3; const float* mod = MOD + (size_t)b * 6144;
        const int row0 = u.pm * 256 + wr * 64 + fr, col0 = u.pn * 256 + wc * 32 + 8 * fq;
#pragma unroll
        for (int ai = 0; ai < 2; ++ai)
#pragma unroll
            for (int m = 0; m < 4; ++m) { const size_t row = (size_t)(row0 + ai * 128 + m * 16); float ss = 0.f;
                const f32x2 sa = *(const f32x2*)(SSQA + row * 2); const float ra = 1.0f / sqrtf((sa.x + sa.y) * (1.f / 512.f) + EPS);
#pragma unroll
                for (int bj = 0; bj < 2; ++bj) { const int col = col0 + bj * 128; float a2[8];
#pragma unroll
                    for (int n = 0; n < 2; ++n) { const int c4 = col + 4 * n;
                        const f32x4 xv = *(const f32x4*)(x + row * 1024 + c4); const f32x4 g1 = *(const f32x4*)(mod + 2048 + c4);
                        const f32x4 v = xv + g1 * (acc[ai][bj][m][n] * ra);
                        *(f32x4*)(x1 + row * 1024 + c4) = v; ss += (v.x * v.x + v.y * v.y) + (v.z * v.z + v.w * v.w);
                        const f32x4 sc2 = *(const f32x4*)(mod + 4096 + c4); const f32x4 gg = *(const f32x4*)(g2n + c4);
                        const f32x4 a = v * gg * (sc2 + 1.0f); a2[4 * n] = a.x; a2[4 * n + 1] = a.y; a2[4 * n + 2] = a.z; a2[4 * n + 3] = a.w; }
                    v4u wv; wv.x = cvt_pk_bf16(a2[0], a2[1]); wv.y = cvt_pk_bf16(a2[2], a2[3]); wv.z = cvt_pk_bf16(a2[4], a2[5]); wv.w = cvt_pk_bf16(a2[6], a2[7]);
                    *(v4u*)(A2 + row * 1024 + col) = wv; }
                ss += __shfl_xor(ss, 16); ss += __shfl_xor(ss, 32);
                if (fq == 0) SSQ2[row * 16 + u.pn * 4 + wc] = ss;
                asm volatile("" ::: "memory"); }
    }
};
struct EpiUp {
    static constexpr bool PERM = true, MID = false; int tmid;
    const float* SSQ2; const float* BIAS2; bf16* H;
    __device__ __forceinline__ void mid(f32x4 (&)[2][2][4][2], const Unit&, int, int, int, int) const {}
    __device__ __forceinline__ void operator()(const f32x4 (&acc)[2][2][4][2], const Unit& u, int wr, int wc, int fr, int fq) const {
        const int b = u.pm >> 3; const float* bias = BIAS2 + (size_t)b * DFF;
        const int row0 = u.pm * 256 + wr * 64 + fr, col0 = u.pn * 256 + wc * 32 + 8 * fq;
        f32x4 bv[2][2];
#pragma unroll
        for (int bj = 0; bj < 2; ++bj)
#pragma unroll
            for (int n = 0; n < 2; ++n) bv[bj][n] = *(const f32x4*)(bias + col0 + bj * 128 + 4 * n);
#pragma unroll
        for (int ai = 0; ai < 2; ++ai)
#pragma unroll
            for (int m = 0; m < 4; ++m) { const size_t row = (size_t)(row0 + ai * 128 + m * 16);
                const f32x4 p = *(const f32x4*)(SSQ2 + row * 16 + 4 * fq); float s = (p.x + p.y) + (p.z + p.w); s += __shfl_xor(s, 16); s += __shfl_xor(s, 32);
                const float rstd = 1.0f / sqrtf(s * (1.f / 1024.f) + EPS);
#pragma unroll
                for (int bj = 0; bj < 2; ++bj) { f32x4 v0 = acc[ai][bj][m][0] * rstd + bv[bj][0], v1 = acc[ai][bj][m][1] * rstd + bv[bj][1];
                    float h[8] = {v0[0], v0[1], v0[2], v0[3], v1[0], v1[1], v1[2], v1[3]};
#pragma unroll
                    for (int e = 0; e < 8; ++e) { const float r = fmaxf(h[e], 0.f); h[e] = r * r; }
                    v4u wv; wv.x = cvt_pk_bf16(h[0], h[1]); wv.y = cvt_pk_bf16(h[2], h[3]); wv.z = cvt_pk_bf16(h[4], h[5]); wv.w = cvt_pk_bf16(h[6], h[7]);
                    *(v4u*)(H + row * DFF + col0 + bj * 128) = wv; } }
    }
};
struct EpiDown {
    static constexpr bool PERM = false, MID = false; int tmid;
    float* out; const float* MOD;
    __device__ __forceinline__ void mid(f32x4 (&)[2][2][4][2], const Unit&, int, int, int, int) const {}
    __device__ __forceinline__ void operator()(const f32x4 (&acc)[2][2][4][2], const Unit& u, int wr, int wc, int fr, int fq) const {
        const int b = u.pm >> 3; const float* g2 = MOD + (size_t)b * 6144 + 5120;
        const int row0 = u.pm * 256 + wr * 64 + fr, col0 = u.pn * 256 + wc * 32 + 4 * fq;
        f32x4 gv[2][2];
#pragma unroll
        for (int bj = 0; bj < 2; ++bj)
#pragma unroll
            for (int n = 0; n < 2; ++n) gv[bj][n] = *(const f32x4*)(g2 + col0 + bj * 128 + n * 16);
#pragma unroll
        for (int ai = 0; ai < 2; ++ai)
#pragma unroll
            for (int m = 0; m < 4; ++m) { float* rowp = out + (size_t)(row0 + ai * 128 + m * 16) * 1024 + col0;
#pragma unroll
                for (int bj = 0; bj < 2; ++bj)
#pragma unroll
                    for (int n = 0; n < 2; ++n) { const f32x4 x1 = *(const f32x4*)(rowp + bj * 128 + n * 16); *(f32x4*)(rowp + bj * 128 + n * 16) = x1 + gv[bj][n] * acc[ai][bj][m][n]; } }
    }
};

__device__ __forceinline__ float gelu_tanh(float v) {
    const float a = 0.7978845608028654f * (v + 0.044715f * v * v * v);
    const float th = 1.f - 2.f / (__expf(2.f * a) + 1.f);
    return 0.5f * v * (1.f + th);
}
__device__ __forceinline__ void bias2_item(Frame& F, int item, LAS float* scr) {
    const int b = item >> 6, n = (item & 63) * 64 + F.lane;
    for (int e = F.lane; e < 1024; e += 64) scr[e] = F.MOD[(size_t)b * 6144 + 3072 + e];
    LDS_WAIT(); asm volatile("" ::: "memory");
    float acc = 0.f;
#pragma unroll 8
    for (int k = 0; k < 1024; ++k) acc += scr[k] * F.w_ff1[(size_t)k * DFF + n];
    F.BIAS2[(size_t)b * DFF + n] = acc;
    LDS_WAIT(); asm volatile("" ::: "memory");
}
__device__ __forceinline__ void ssm_naive_unit(Frame& F, int b, int g, LAS unsigned char* wl) {
    const int lane = F.lane;
    LAS f32x2* Cl = (LAS f32x2*)wl;
    LAS f32x2* xs = Cl + 16 * 65;
#pragma unroll
    for (int c = 0; c < 16; ++c) Cl[c * 65 + lane] = (f32x2){F.c_re[(g * 16 + c) * 64 + lane], F.c_im[(g * 16 + c) * 64 + lane]};
    const f32x2 lam = F.LAMB[g * 64 + lane];
    f32x2 Bb[16];
#pragma unroll
    for (int c = 0; c < 16; ++c) Bb[c] = F.BBAR[(g * 64 + lane) * 16 + c];
    float dsk[4];
#pragma unroll
    for (int k = 0; k < 4; ++k) dsk[k] = F.d_skip[g * 16 + (lane >> 4) * 4 + k];
    LDS_WAIT(); asm volatile("" ::: "memory");
    float xr = 0.f, xi = 0.f;
    for (int ch = 0; ch < SEQ / 16; ++ch) {
        const int t0 = ch * 16;
#pragma unroll 4
        for (int tt = 0; tt < 16; ++tt) {
            const bf16* up = F.U + ((size_t)b * SEQ + t0 + tt) * 512 + g * 16;
            const v4u ua = *(const v4u*)up, ub = *(const v4u*)(up + 8);
            const float u[16] = {bflo(ua.x), bfhi(ua.x), bflo(ua.y), bfhi(ua.y), bflo(ua.z), bfhi(ua.z), bflo(ua.w), bfhi(ua.w),
                                 bflo(ub.x), bfhi(ub.x), bflo(ub.y), bfhi(ub.y), bflo(ub.z), bfhi(ub.z), bflo(ub.w), bfhi(ub.w)};
            float br = 0.f, bi = 0.f;
#pragma unroll
            for (int c = 0; c < 16; ++c) { br += Bb[c].x * u[c]; bi += Bb[c].y * u[c]; }
            const float nr = lam.x * xr - lam.y * xi + br, ni = lam.x * xi + lam.y * xr + bi; xr = nr; xi = ni;
            xs[tt * 65 + lane] = (f32x2){xr, xi};
        }
        LDS_WAIT(); asm volatile("" ::: "memory");
        const int tt = lane & 15, cq = lane >> 4;
        float y[4] = {0.f, 0.f, 0.f, 0.f};
#pragma unroll 4
        for (int p = 0; p < 64; ++p) { const f32x2 xv = xs[tt * 65 + p];
#pragma unroll
            for (int k = 0; k < 4; ++k) { const f32x2 cv = Cl[(cq * 4 + k) * 65 + p]; y[k] += cv.x * xv.x - cv.y * xv.y; } }
        const size_t off = ((size_t)b * SEQ + t0 + tt) * 512 + g * 16 + cq * 4;
        const v2u uu = *(const v2u*)(F.U + off);
        const float uf[4] = {bflo(uu.x), bfhi(uu.x), bflo(uu.y), bfhi(uu.y)};
        float z[4];
#pragma unroll
        for (int k = 0; k < 4; ++k) z[k] = gelu_tanh(y[k] + dsk[k] * uf[k]);
        *(v2u*)(F.Z + off) = (v2u){pk2(z[0], z[1]), pk2(z[2], z[3])};
        LDS_WAIT(); asm volatile("" ::: "memory");
    }
}

__device__ __forceinline__ unsigned fkey(float f) { const unsigned u = __float_as_uint(f); return (u & 0x80000000u) ? ~u : (u | 0x80000000u); }

typedef short bf16x8 __attribute__((ext_vector_type(8)));
typedef float f32x16 __attribute__((ext_vector_type(16)));
__device__ __forceinline__ int crow(int r, int hi) { return (r & 3) + 8 * (r >> 2) + 4 * hi; }

__device__ __forceinline__ void select_query(const LAS unsigned* SCq, int t, int nvalid, LAS unsigned long long* BMq, int lane) {
    unsigned kreg[32];
#pragma unroll
    for (int j = 0; j < 32; ++j) kreg[j] = (64 * j + lane < nvalid) ? SCq[64 * j + lane] : 0u;
    const int n = t + 1; unsigned tau = 0u; int need = 0;
    if (n > TOPK) {
#pragma unroll 1
        for (int bit = 31; bit >= 0; --bit) { const unsigned cand = tau | (1u << bit); int c = 0;
#pragma unroll
            for (int j = 0; j < 32; ++j) c += (kreg[j] >= cand) ? 1 : 0;
            c = wave_sum_i(c); if (c >= TOPK) tau = cand; }
        int cg = 0;
#pragma unroll
        for (int j = 0; j < 32; ++j) cg += (kreg[j] > tau) ? 1 : 0;
        cg = wave_sum_i(cg); need = TOPK - cg;
    }
    const unsigned long long lt = (1ull << lane) - 1ull;
    int eqb = 0;
#pragma unroll
    for (int j = 0; j < 32; ++j) {
        const int s = lane + 64 * j; bool sf;
        if (n > TOPK) { const bool gt = kreg[j] > tau, eq = kreg[j] == tau; const unsigned long long em = __ballot(eq);
            const int rank = eqb + __popcll(em & lt); sf = gt || (eq && rank < need); eqb += __popcll(em); }
        else sf = (s <= t);
        const unsigned long long sm = __ballot(sf);
        if (lane == 0) BMq[j] = sm;
    }
}

__device__ __forceinline__ void idx_subunit(Frame& F, int b, int t0, int qoff) {
    const int lane = F.lane, w = F.wave, rt = w & 3, kp = w >> 2, r32 = lane & 31, hh = lane >> 5;
    LAS unsigned* SC = (LAS unsigned*)(F.lds);
    LAS unsigned long long* BM = (LAS unsigned long long*)(F.lds + BM_OFF);
    const int nk = t0 + 16, nkt = (nk + 31) >> 5;
    const bf16* qp = F.QI2 + (size_t)(b * SEQ + t0 + 4 * rt + (r32 >> 3)) * 1024 + (r32 & 7) * 64 + 8 * hh;
    bf16x8 qh[4], ql[4];
#pragma unroll
    for (int d0 = 0; d0 < 4; ++d0) { qh[d0] = *(const bf16x8*)(qp + 16 * d0); ql[d0] = *(const bf16x8*)(qp + 512 + 16 * d0); }
    f32x4 wq[4];
#pragma unroll
    for (int tq = 0; tq < 4; ++tq) wq[tq] = *(const f32x4*)(F.WI + (size_t)(b * SEQ + t0 + 4 * rt + tq) * 8 + 4 * hh);
    __syncthreads();
    for (int kt = kp; kt < nkt; kt += 2) {
        const int key = 32 * kt + r32;
        const bf16* kptr = F.KI2 + (size_t)(b * SEQ + key) * 128 + 8 * hh;
        bf16x8 kh[4], kl[4];
#pragma unroll
        for (int d0 = 0; d0 < 4; ++d0) { kh[d0] = *(const bf16x8*)(kptr + 16 * d0); kl[d0] = *(const bf16x8*)(kptr + 64 + 16 * d0); }
        f32x16 acc;
#pragma unroll
        for (int r = 0; r < 16; ++r) acc[r] = 0.f;
#pragma unroll
        for (int d0 = 0; d0 < 4; ++d0) {
            acc = __builtin_amdgcn_mfma_f32_32x32x16_bf16(ql[d0], kh[d0], acc, 0, 0, 0);
            acc = __builtin_amdgcn_mfma_f32_32x32x16_bf16(qh[d0], kl[d0], acc, 0, 0, 0);
            acc = __builtin_amdgcn_mfma_f32_32x32x16_bf16(qh[d0], kh[d0], acc, 0, 0, 0);
        }
        float part[4];
#pragma unroll
        for (int tq = 0; tq < 4; ++tq) { float p = 0.f;
#pragma unroll
            for (int i = 0; i < 4; ++i) p += fmaxf(acc[4 * tq + i], 0.f) * wq[tq][i];
            part[tq] = p + __shfl_xor(p, 32); }
#pragma unroll
        for (int e = 0; e < 2; ++e) { const float v = hh ? part[2 + e] : part[e]; const int ql_ = 4 * rt + 2 * hh + e, t = t0 + ql_;
            SC[ql_ * 2048 + key] = (key <= t) ? fkey(v * IDX_SCALE + 0.0f) : 0u; }
    }
    __syncthreads();
#pragma unroll 1
    for (int e = 0; e < 2; ++e) { const int ql_ = 2 * w + e; select_query(SC + ql_ * 2048, t0 + ql_, nkt * 32, BM + (qoff + ql_) * 32, lane); }
}

__device__ __forceinline__ void attn_subunit(Frame& F, int b, int kvh, int t0) {
    const int lane = F.lane, w = F.wave, r32 = lane & 31, hi = lane >> 5, tid = F.tid;
    LAS unsigned char* Kt = F.lds;
    LAS unsigned char* Vt = F.lds + 8192;
    LAS float* rkL = (LAS float*)(F.lds + 16384);
    LAS float* wsf = (LAS float*)(F.lds + 16640) + w * 64;
    const LAS unsigned long long* BM = (const LAS unsigned long long*)(F.lds + BM_OFF);
    const int ntile = (t0 + 64) >> 6;
    const int tl = 8 * w + (r32 >> 2), g = r32 & 3;
    bf16x8 qr[4];
    { const bf16* qp = F.Q + (size_t)(b * SEQ + t0 + tl) * 512 + (4 * kvh + g) * 64 + 8 * hi;
      float qf[32]; float ss = 0.f;
#pragma unroll
      for (int d0 = 0; d0 < 4; ++d0) { const v4u qv = *(const v4u*)(qp + 16 * d0);
          qf[8 * d0 + 0] = bflo(qv.x); qf[8 * d0 + 1] = bfhi(qv.x); qf[8 * d0 + 2] = bflo(qv.y); qf[8 * d0 + 3] = bfhi(qv.y);
          qf[8 * d0 + 4] = bflo(qv.z); qf[8 * d0 + 5] = bfhi(qv.z); qf[8 * d0 + 6] = bflo(qv.w); qf[8 * d0 + 7] = bfhi(qv.w); }
#pragma unroll
      for (int i = 0; i < 32; ++i) ss += qf[i] * qf[i];
      ss += __shfl_xor(ss, 32);
      const float rstd = (1.0f / sqrtf(ss * (1.f / 64.f) + EPS)) * (0.125f * 1.4426950408889634f);
#pragma unroll
      for (int d0 = 0; d0 < 4; ++d0) { float v[8];
#pragma unroll
          for (int j = 0; j < 8; ++j) { const int d = 16 * d0 + 8 * hi + j; v[j] = qf[8 * d0 + j] * rstd * F.q_gain[d] * F.k_gain[d]; }
          v4u pk; pk.x = pk2(v[0], v[1]); pk.y = pk2(v[2], v[3]); pk.z = pk2(v[4], v[5]); pk.w = pk2(v[6], v[7]);
          qr[d0] = __builtin_bit_cast(bf16x8, pk); } }
    const int skey = tid >> 3, sc = tid & 7;
    const bf16* kvp = F.KV + (size_t)(b * SEQ + skey) * 256 + kvh * 64 + 8 * sc;
    const int spos = (skey & ~15) + 8 * ((skey >> 2) & 1) + 4 * ((skey >> 3) & 1) + (skey & 3);
    float m = -INFINITY, l = 0.f;
    f32x16 o[2];
#pragma unroll
    for (int r = 0; r < 16; ++r) { o[0][r] = 0.f; o[1][r] = 0.f; }
    v4u kreg = *(const v4u*)(kvp), vreg = *(const v4u*)(kvp + 128);
    for (int tile = 0; tile < ntile; ++tile) {
        __syncthreads();
        { *(LAS v4u*)(Kt + skey * 128 + ((sc ^ (skey & 7)) * 16)) = kreg;
          const float kf[8] = {bflo(kreg.x), bfhi(kreg.x), bflo(kreg.y), bfhi(kreg.y), bflo(kreg.z), bfhi(kreg.z), bflo(kreg.w), bfhi(kreg.w)};
          float ss = 0.f;
#pragma unroll
          for (int j = 0; j < 8; ++j) ss += kf[j] * kf[j];
          ss += __shfl_xor(ss, 1); ss += __shfl_xor(ss, 2); ss += __shfl_xor(ss, 4);
          if (sc == 0) rkL[skey] = 1.0f / sqrtf(ss * (1.f / 64.f) + EPS);
          const unsigned short ve[8] = {(unsigned short)(vreg.x & 0xffffu), (unsigned short)(vreg.x >> 16), (unsigned short)(vreg.y & 0xffffu), (unsigned short)(vreg.y >> 16),
                                        (unsigned short)(vreg.z & 0xffffu), (unsigned short)(vreg.z >> 16), (unsigned short)(vreg.w & 0xffffu), (unsigned short)(vreg.w >> 16)};
#pragma unroll
          for (int e = 0; e < 8; ++e) { const int d = 8 * sc + e; *(LAS unsigned short*)(Vt + d * 128 + (((spos >> 3) ^ (d & 7)) * 16) + (spos & 7) * 2) = ve[e]; } }
        if (tile + 1 < ntile) { const bf16* np = kvp + (size_t)(tile + 1) * 64 * 256; kreg = *(const v4u*)(np); vreg = *(const v4u*)(np + 128); }
        __syncthreads();
        f32x16 p0, p1;
#pragma unroll
        for (int r = 0; r < 16; ++r) { p0[r] = 0.f; p1[r] = 0.f; }
#pragma unroll
        for (int d0 = 0; d0 < 4; ++d0) {
            const bf16x8 a0 = *(const LAS bf16x8*)(Kt + r32 * 128 + (((2 * d0 + hi) ^ (r32 & 7)) * 16));
            const bf16x8 a1 = *(const LAS bf16x8*)(Kt + (32 + r32) * 128 + (((2 * d0 + hi) ^ (r32 & 7)) * 16));
            p0 = __builtin_amdgcn_mfma_f32_32x32x16_bf16(a0, qr[d0], p0, 0, 0, 0);
            p1 = __builtin_amdgcn_mfma_f32_32x32x16_bf16(a1, qr[d0], p1, 0, 0, 0);
        }
        const unsigned long long mw = BM[tl * 32 + tile];
        const unsigned mlo = (unsigned)mw >> (4 * hi), mhi = (unsigned)(mw >> 32) >> (4 * hi);
        float mt = -INFINITY;
#pragma unroll
        for (int q4 = 0; q4 < 4; ++q4) { const f32x4 k0 = *(const LAS f32x4*)(rkL + 8 * q4 + 4 * hi), k1 = *(const LAS f32x4*)(rkL + 32 + 8 * q4 + 4 * hi);
#pragma unroll
            for (int i = 0; i < 4; ++i) { const int r = 4 * q4 + i, cb = 8 * q4 + i;
                p0[r] = ((mlo >> cb) & 1u) ? p0[r] * k0[i] : -INFINITY; p1[r] = ((mhi >> cb) & 1u) ? p1[r] * k1[i] : -INFINITY;
                mt = fmaxf(mt, fmaxf(p0[r], p1[r])); } }
        mt = fmaxf(mt, __shfl_xor(mt, 32));
        const float mn = fmaxf(m, mt), mref = (mn == -INFINITY) ? 0.f : mn;
        const float alpha = __builtin_amdgcn_exp2f(m - mref);
        m = mn;
        float ps = 0.f;
#pragma unroll
        for (int r = 0; r < 16; ++r) { p0[r] = __builtin_amdgcn_exp2f(p0[r] - mref); p1[r] = __builtin_amdgcn_exp2f(p1[r] - mref); ps += p0[r] + p1[r]; }
        l = l * alpha + ps;
        if (!__all(alpha == 1.0f)) {
            if (hi == 0) wsf[r32] = alpha;
            LDS_WAIT(); asm volatile("" ::: "memory");
#pragma unroll
            for (int q4 = 0; q4 < 4; ++q4) { const f32x4 av = *(const LAS f32x4*)(wsf + 8 * q4 + 4 * hi);
#pragma unroll
                for (int i = 0; i < 4; ++i) { o[0][4 * q4 + i] *= av[i]; o[1][4 * q4 + i] *= av[i]; } }
            LDS_WAIT(); asm volatile("" ::: "memory");
        }
        bf16x8 pa[4];
        { v4u t_;
          t_.x = pk2(p0[0], p0[1]); t_.y = pk2(p0[2], p0[3]); t_.z = pk2(p0[4], p0[5]); t_.w = pk2(p0[6], p0[7]); pa[0] = __builtin_bit_cast(bf16x8, t_);
          t_.x = pk2(p0[8], p0[9]); t_.y = pk2(p0[10], p0[11]); t_.z = pk2(p0[12], p0[13]); t_.w = pk2(p0[14], p0[15]); pa[1] = __builtin_bit_cast(bf16x8, t_);
          t_.x = pk2(p1[0], p1[1]); t_.y = pk2(p1[2], p1[3]); t_.z = pk2(p1[4], p1[5]); t_.w = pk2(p1[6], p1[7]); pa[2] = __builtin_bit_cast(bf16x8, t_);
          t_.x = pk2(p1[8], p1[9]); t_.y = pk2(p1[10], p1[11]); t_.z = pk2(p1[12], p1[13]); t_.w = pk2(p1[14], p1[15]); pa[3] = __builtin_bit_cast(bf16x8, t_); }
#pragma unroll
        for (int dh = 0; dh < 2; ++dh) { const int d = 32 * dh + r32;
#pragma unroll
            for (int s_ = 0; s_ < 4; ++s_) { const bf16x8 vb = *(const LAS bf16x8*)(Vt + d * 128 + (((2 * s_ + hi) ^ (d & 7)) * 16));
                o[dh] = __builtin_amdgcn_mfma_f32_32x32x16_bf16(pa[s_], vb, o[dh], 0, 0, 0); } }
    }
    l += __shfl_xor(l, 32);
    if (hi == 0) wsf[r32] = 1.0f / l;
    LDS_WAIT(); asm volatile("" ::: "memory");
    float ssq[4];
#pragma unroll
    for (int q4 = 0; q4 < 4; ++q4) { const f32x4 av = *(const LAS f32x4*)(wsf + 8 * q4 + 4 * hi); float s2 = 0.f;
        const size_t row = (size_t)(b * SEQ + t0 + 8 * w + 2 * q4 + hi);
#pragma unroll
        for (int i = 0; i < 4; ++i) { const float v0 = o[0][4 * q4 + i] * av[i], v1 = o[1][4 * q4 + i] * av[i]; s2 += v0 * v0 + v1 * v1;
            bf16* op = F.MIX + row * 1024 + 512 + (4 * kvh + i) * 64 + r32;
            op[0] = (bf16)f2bf(v0); op[32] = (bf16)f2bf(v1); }
        ssq[q4] = s2; }
#pragma unroll
    for (int q4 = 0; q4 < 4; ++q4) { float s2 = ssq[q4];
        s2 += __shfl_xor(s2, 1); s2 += __shfl_xor(s2, 2); s2 += __shfl_xor(s2, 4); s2 += __shfl_xor(s2, 8); s2 += __shfl_xor(s2, 16);
        if (r32 == 0) F.SSQA[(size_t)(b * SEQ + t0 + 8 * w + 2 * q4 + hi) * 2 + kvh] = s2; }
    LDS_WAIT(); asm volatile("" ::: "memory");
}

__device__ __forceinline__ void p3_phase(Frame& F) {
    LAS unsigned char* wl = F.lds + RING_OFF + F.wave * WAVE_LDS;
    const int gw = F.vcu * NWAVES + F.wave, NGW = F.G * NWAVES;
    for (int it = gw; it < 1024; it += NGW) bias2_item(F, it, (LAS float*)wl);
    for (int it = gw; it < BATCH * NG; it += NGW) ssm_naive_unit(F, it >> 5, it & 31, wl);
    for (int u = F.vcu; u < BATCH * 16; u += F.G) {
        const int b = u >> 4, p = u & 15;
#pragma unroll 1
        for (int side = 0; side < 2; ++side) { const int t0 = 64 * (side ? 31 - p : p);
#pragma unroll 1
            for (int sub = 0; sub < 4; ++sub) idx_subunit(F, b, t0 + 16 * sub, 16 * sub);
#pragma unroll 1
            for (int kvh = 0; kvh < 2; ++kvh) attn_subunit(F, b, kvh, t0); }
    }
    __syncthreads();
}

struct Args { const float* in[24]; float* out; unsigned char* ws; int ph_lo, ph_hi, li, pad; };
__global__ void __launch_bounds__(NWAVES * 64, 2) fwd_kernel(Args args) {
    extern __shared__ __attribute__((aligned(16))) unsigned char lds[];
    Frame F;
    F.lds = (LAS unsigned char*)lds;
    F.MISC = (volatile LAS unsigned*)(F.lds + MISC_OFF);
    F.tid = threadIdx.x; F.lane = F.tid & 63; F.wave = __builtin_amdgcn_readfirstlane(F.tid >> 6);
    F.G = gridDim.x; { const int bx = blockIdx.x; F.vcu = (F.G % 8 == 0) ? (bx % 8) * (F.G / 8) + bx / 8 : bx; }
    unsigned char* ws = args.ws;
    F.ctl = (gu32*)(ws + WS_CTL);
    F.x = args.in[0]; F.c = args.in[1]; F.norm1_g = args.in[2]; F.norm2_g = args.in[3]; F.w_ada = args.in[4]; F.b_ada = args.in[5]; F.w_in = args.in[6];
    F.lam_re = args.in[7]; F.lam_im = args.in[8]; F.log_dt = args.in[9]; F.b_re = args.in[10]; F.b_im = args.in[11]; F.c_re = args.in[12]; F.c_im = args.in[13];
    F.d_skip = args.in[14]; F.w_glu = args.in[15]; F.b_glu = args.in[16]; F.q_gain = args.in[17]; F.k_gain = args.in[18]; F.gn_ssm = args.in[19]; F.gn_attn = args.in[20];
    F.w_out = args.in[21]; F.w_ff1 = args.in[22]; F.w_ff2 = args.in[23]; F.out = args.out;
    F.MODP = (float*)(ws + WS_MODP); F.MOD = (float*)(ws + WS_MOD); F.BIAS2 = (float*)(ws + WS_BIAS2); F.SSQS = (float*)(ws + WS_SSQS); F.SSQ2 = (float*)(ws + WS_SSQ2);
    F.KI2 = (bf16*)(ws + WS_KI); F.WI = (float*)(ws + WS_WI); F.QI2 = (bf16*)(ws + WS_QI); F.SSQA = (float*)(ws + WS_SSQA);
    F.LAMB = (f32x2*)(ws + WS_SSMP); F.BBAR = (f32x2*)(ws + WS_SSMP + 16384);
    F.WINP = (bf16*)(ws + WS_WINP); F.WINI = (bf16*)(ws + WS_WINI); F.WGLU = (bf16*)(ws + WS_WGLU); F.WOUT = (bf16*)(ws + WS_WOUT); F.W1 = (bf16*)(ws + WS_W1); F.W2 = (bf16*)(ws + WS_W2);
    F.U = (bf16*)(ws + WS_U); F.Q = (bf16*)(ws + WS_Q); F.A2 = (bf16*)(ws + WS_A2); F.XN = (bf16*)(ws + WS_XN); F.KV = (bf16*)(ws + WS_KV); F.Z = (bf16*)(ws + WS_Z); F.MIX = (bf16*)(ws + WS_MIX); F.H = (bf16*)(ws + WS_H);
    for (int u = F.tid; u < (LDS_BYTES - LDSCTL_OFF) / 4; u += NWAVES * 64) ((LAS unsigned*)(F.lds + LDSCTL_OFF))[u] = 0u;
    __syncthreads();
    XcdBarrier bar; bar.bar = (unsigned*)(F.ctl + CW_BAR); bar.x = 0; bar.st = nullptr;
    if (N_LAUNCHES == 1) bar = xcd_barrier_post((unsigned*)(F.ctl + CW_BAR), F.MISC + 8);
#define GRID_BAR() do { if (N_LAUNCHES == 1) xcd_barrier(bar); } while (0)
    const int lo = args.ph_lo, hi = args.ph_hi;
#ifndef PHASE_MASK
#define PHASE_MASK 0xFF
#endif
#define IN(k) (((PHASE_MASK >> (k)) & 1) && lo <= (k) && (k) < hi)
#define BOTH(k) (IN(k) && IN((k) + 1))

    if (IN(0)) { p0a_phase(F); if (BOTH(0)) GRID_BAR(); }
    if (IN(1)) { p0b_phase(F); if (BOTH(1)) GRID_BAR(); }
    if (IN(2)) {
        { pg8::Gemm g{F.XN, F.WINP, M, N_PLAIN, 1024, 2048, 1 << 30}; pg8::StaticOrder S; S.init(M, N_PLAIN, F.G, (int)blockIdx.x);
          EpiInPlain E{0, F.U, F.Q, F.KV};
          pg8::gemm_phase<EpiInPlain, pg8::StaticOrder, true>(F.lds + RING_OFF, g, S, E); }
        { pg8::Gemm g{F.XN, F.WINI, M, N_IDX_PAD, K3, 2048, 32}; pg8::StaticOrder S; S.init(M, N_IDX_PAD, F.G, F.G - 1 - (int)blockIdx.x);
          EpiInIdx E{0, F.QI2, F.KI2, F.WI};
          pg8::gemm_phase<EpiInIdx, pg8::StaticOrder, true>(F.lds + RING_OFF, g, S, E); }
        if (BOTH(2)) GRID_BAR();
    }
    if (IN(3)) { p3_phase(F); if (BOTH(3)) GRID_BAR(); }
    if (IN(4)) {
        pg8::Gemm g{F.Z, F.WGLU, M, 512, 512, 512, 1 << 30}; pg8::StaticOrder S; S.init(M, 512, F.G, (int)blockIdx.x);
        EpiGlu E{0, F.Z, F.MIX, F.b_glu, F.SSQS};
        pg8::gemm_phase<EpiGlu, pg8::StaticOrder, true>(F.lds + RING_OFF, g, S, E);
        if (BOTH(4)) GRID_BAR();
    }
    if (IN(5)) {
        pg8::Gemm g{F.MIX, F.WOUT, M, 1024, 1024, 1024, 1 << 30}; pg8::StaticOrder S; S.init(M, 1024, F.G, (int)blockIdx.x);
        EpiOut E{8, F.x, F.out, F.A2, F.MOD, F.norm2_g, F.SSQS, F.SSQ2, F.SSQA};
        pg8::gemm_phase<EpiOut, pg8::StaticOrder, true>(F.lds + RING_OFF, g, S, E);
        if (BOTH(5)) GRID_BAR();
    }
    if (IN(6)) {
        pg8::Gemm g{F.A2, F.W1, M, DFF, 1024, 1024, 1 << 30}; pg8::StaticOrder S; S.init(M, DFF, F.G, (int)blockIdx.x);
        EpiUp E{0, F.SSQ2, F.BIAS2, F.H};
        pg8::gemm_phase<EpiUp, pg8::StaticOrder, true>(F.lds + RING_OFF, g, S, E);
        if (BOTH(6)) GRID_BAR();
    }
    if (IN(7)) {
        pg8::Gemm g{F.H, F.W2, M, 1024, DFF, DFF, 1 << 30}; pg8::StaticOrder S; S.init(M, 1024, F.G, (int)blockIdx.x);
        EpiDown E{0, F.out, F.MOD};
        pg8::gemm_phase<EpiDown, pg8::StaticOrder, true>(F.lds + RING_OFF, g, S, E);
    }
#undef IN
#undef BOTH
}

extern "C" void kernel_launch(void* const* d_in, const int* in_sizes, int n_in, void* d_out, int out_size, void* d_ws, size_t ws_size, hipStream_t stream) {
    static int grid = 0;
    if (grid == 0) {
        if (n_in != 24 || in_sizes[0] != M * DM || out_size != M * DM || ws_size < WS_END) { fprintf(stderr, "kernel_launch: unexpected shapes (n_in %d, in0 %d, out %d, ws %zu); nothing launched\n", n_in, n_in > 0 ? in_sizes[0] : -1, out_size, ws_size); grid = -1; return; }
        int dev = 0, cus = 0, per_cu = 0;
        if (hipGetDevice(&dev) != hipSuccess || hipDeviceGetAttribute(&cus, hipDeviceAttributeMultiprocessorCount, dev) != hipSuccess) { fprintf(stderr, "kernel_launch: device query failed\n"); grid = -1; return; }
        if (hipFuncSetAttribute((const void*)fwd_kernel, hipFuncAttributeMaxDynamicSharedMemorySize, LDS_BYTES) != hipSuccess) { fprintf(stderr, "kernel_launch: hipFuncSetAttribute failed\n"); grid = -1; return; }
        if (hipOccupancyMaxActiveBlocksPerMultiprocessor(&per_cu, (const void*)fwd_kernel, NWAVES * 64, LDS_BYTES) != hipSuccess || per_cu < 1)
            fprintf(stderr, "kernel_launch: note: occupancy query reports %d workgroups per CU\n", per_cu);
        (void)hipGetLastError();
        grid = cus;
    }
    if (grid < 0) return;
    if (hipMemsetAsync((char*)d_ws + WS_CTL, 0, CTL_ZERO_BYTES, stream) != hipSuccess) { fprintf(stderr, "kernel_launch: memset failed\n"); return; }
    Args a{};
    for (int i = 0; i < 24; ++i) a.in[i] = (const float*)d_in[i];
    a.out = (float*)d_out; a.ws = (unsigned char*)d_ws;
    for (int li = 0; li < N_LAUNCHES; ++li) {
        a.ph_lo = (N_LAUNCHES == 1) ? 0 : li; a.ph_hi = (N_LAUNCHES == 1) ? NPHASE : li + 1; a.li = li;
        hipLaunchKernelGGL(fwd_kernel, dim3(grid), dim3(NWAVES * 64), LDS_BYTES, stream, a);
        const hipError_t le = hipPeekAtLastError();
        if (le != hipSuccess) { fprintf(stderr, "kernel_launch: launch %d failed: %s\n", li, hipGetErrorName(le)); break; }
    }
}
```

```cpp
#include <hip/hip_runtime.h>
#include <cstdio>
#include <cstdint>

#ifndef MK_N_LAUNCHES
#define MK_N_LAUNCHES 1
#endif

namespace pg8 {
#define PG8_LAS __attribute__((address_space(3)))
typedef unsigned short bf16_t;
typedef short bf16x8 __attribute__((ext_vector_type(8)));
typedef float f32x4 __attribute__((ext_vector_type(4)));
typedef unsigned u32x4 __attribute__((ext_vector_type(4)));
typedef unsigned u32x2 __attribute__((ext_vector_type(2)));
constexpr int BM = 256, BK = 64, HALF = 128, HTB = HALF * BK * 2, STAGE_BYTES = 8 * HTB, NXCD = 8, WGM = 8;

__host__ __device__ __forceinline__ int lds_byte(int r, int c) { const int st = (r >> 4) * 2 + (c >> 5), rr = r & 15, cc = c & 31, ob = rr * 64 + cc * 2; return st * 1024 + (ob ^ (((ob >> 9) & 1) << 5)); }
__host__ __device__ __forceinline__ void stage_rc(int b, int& R, int& C) { const int st = b / 1024, sb = b % 1024, swz = sb ^ (((sb >> 9) & 1) << 5); R = (st >> 1) * 16 + swz / 64; C = (st & 1) * 32 + (swz % 64) / 2; }
__host__ __device__ __forceinline__ int perm32(int rho) { const int n = rho >> 4, i = rho & 15; return 8 * (i >> 2) + 4 * n + (i & 3); }

struct Unit { int pm, pn; };
struct Gemm { const bf16_t* A; const bf16_t* Bt; int M, N, K, lda, wrapA; };

struct StaticOrder {
    int nM, nN, nwg, G, c;
    __host__ __device__ void init(int M, int N, int G_, int c_) { nM = M / BM; nN = N / BM; nwg = nM * nN; G = G_; c = c_; }
    __host__ __device__ bool next(int i, Unit& u) const {
        const long L = (long)i * G + c; if (L >= nwg) return false;
        int wgid = (int)L; { const int q = nwg / NXCD, r = nwg % NXCD, xcd = wgid % NXCD, off = wgid / NXCD; wgid = (xcd < r ? xcd * (q + 1) : r * (q + 1) + (xcd - r) * q) + off; }
        const int nig = WGM * nN, gid = wgid / nig, fm = gid * WGM, gsz = (nM - fm) < WGM ? (nM - fm) : WGM;
        u.pm = fm + ((wgid % nig) % gsz); u.pn = (wgid % nig) / gsz; return true;
    }
};

__device__ __forceinline__ unsigned cvt_pk_bf16(float lo, float hi) { unsigned r; asm volatile("v_cvt_pk_bf16_f32 %0, %1, %2" : "=v"(r) : "v"(lo), "v"(hi)); return r; }

template <class Epi, class Sched, bool ALIGN_EPI>
__device__ __forceinline__ void gemm_phase(PG8_LAS unsigned char* lds, const Gemm g, const Sched& S, const Epi& E) {
    const int tid = threadIdx.x, wid = __builtin_amdgcn_readfirstlane(tid >> 6), lane = tid & 63, wr = wid >> 2, wc = wid & 3, fr = lane & 15, fq = lane >> 4;
    const int K = g.K, nt = K / BK, lda = g.lda, wrapA = g.wrapA;
    unsigned voffA[2], voffB[2];
#pragma unroll
    for (int i = 0; i < 2; ++i) { int R, C; stage_rc(tid * 16 + i * 8192, R, C); const int Rb = Epi::PERM ? ((R & ~31) + perm32(R & 31)) : R;
        voffA[i] = (unsigned)(R * lda + C) * 2u; voffB[i] = (unsigned)(Rb * K + C) * 2u; }
    const size_t kstep = (size_t)(BK * 2);
    const size_t hsA = (size_t)HALF * lda * 2, hsB = (size_t)HALF * K * 2;
    const size_t tsA = 2 * hsA, tsB = 2 * hsB;
    const unsigned ldsw = (unsigned)wid * 1024u;
    const int aoff = lds_byte(wr * 64 + fr, fq * 8), boff = lds_byte(wc * 32 + fr, fq * 8);
#define PG8_SA(b, h) (((b) * 2 + (h)) * HTB)
#define PG8_SB(b, h) ((4 + (b) * 2 + (h)) * HTB)
#define PG8_STAGE(bufoff, gbase, voff) do { _Pragma("unroll") for (int _i = 0; _i < 2; ++_i) \
        __builtin_amdgcn_global_load_lds((const unsigned*)((const char*)(gbase) + (voff)[_i]), (PG8_LAS unsigned*)(lds + (bufoff) + ldsw + _i * 8192), 16, 0, 0); } while (0)
#define PG8_LDA(dst, b, h) do { _Pragma("unroll") for (int m = 0; m < 4; ++m) _Pragma("unroll") for (int k = 0; k < 2; ++k) dst[m][k] = *(const PG8_LAS bf16x8*)(lds + PG8_SA(b, h) + aoff + m * 2048 + k * 1024); } while (0)
#define PG8_LDB(dst, b, h) do { _Pragma("unroll") for (int n = 0; n < 2; ++n) _Pragma("unroll") for (int k = 0; k < 2; ++k) dst[n][k] = *(const PG8_LAS bf16x8*)(lds + PG8_SB(b, h) + boff + n * 2048 + k * 1024); } while (0)
#define PG8_MMA(ai, bj, At, Bt) do { __builtin_amdgcn_s_setprio(1); _Pragma("unroll") for (int m = 0; m < 4; ++m) _Pragma("unroll") for (int n = 0; n < 2; ++n) _Pragma("unroll") for (int k = 0; k < 2; ++k) \
        acc[ai][bj][m][n] = __builtin_amdgcn_mfma_f32_16x16x32_bf16(Bt[n][k], At[m][k], acc[ai][bj][m][n], 0, 0, 0); __builtin_amdgcn_s_setprio(0); } while (0)
#define PG8_WAIT_V(n) asm volatile("s_waitcnt vmcnt(" #n ")" ::: "memory")
#define PG8_WAIT_L(n) asm volatile("s_waitcnt lgkmcnt(" #n ")" ::: "memory")
#define PG8_BAR __builtin_amdgcn_s_barrier()
#define PG8_SCHED __builtin_amdgcn_sched_barrier(0)
#define PG8_AT(t) ((t) >= wrapA ? (t) - wrapA : (t))
    Unit cur, nxt; int ui = 0;
    if (!S.next(0, cur)) return;
    f32x4 acc[2][2][4][2];
#pragma unroll
    for (int a = 0; a < 2; ++a)
#pragma unroll
        for (int b = 0; b < 2; ++b)
#pragma unroll
            for (int m = 0; m < 4; ++m)
#pragma unroll
                for (int n = 0; n < 2; ++n) acc[a][b][m][n] = (f32x4){0.f, 0.f, 0.f, 0.f};
    bf16x8 At[4][2], B0[2][2], B1[2][2];
    const char* cA = (const char*)g.A + (size_t)cur.pm * tsA; const char* cB = (const char*)g.Bt + (size_t)cur.pn * tsB;
    PG8_STAGE(PG8_SB(0, 0), cB, voffB); PG8_STAGE(PG8_SB(0, 1), cB + hsB, voffB); PG8_STAGE(PG8_SA(0, 0), cA, voffA); PG8_STAGE(PG8_SA(0, 1), cA + hsA, voffA);
    if (wr == 1) PG8_BAR;
    PG8_WAIT_V(2); PG8_BAR;
    PG8_STAGE(PG8_SB(1, 0), cB + kstep, voffB); PG8_STAGE(PG8_SA(1, 0), cA + kstep, voffA); PG8_STAGE(PG8_SB(1, 1), cB + hsB + kstep, voffB);
    PG8_WAIT_V(6); PG8_BAR;
    for (;;) {
        const bool has_next = S.next(ui + 1, nxt);
        const char* nA = has_next ? (const char*)g.A + (size_t)nxt.pm * tsA : cA; const char* nB = has_next ? (const char*)g.Bt + (size_t)nxt.pn * tsB : cB;
        for (int t = 0; t < nt; t += 2) {
            const bool last = (t == nt - 2);
            const char* a1 = cA + (size_t)PG8_AT(t + 1) * kstep;
            const char* a2 = last ? nA : cA + (size_t)PG8_AT(t + 2) * kstep; const char* b2 = last ? nB : cB + (size_t)(t + 2) * kstep;
            const char* a3 = a2 + kstep; const char* b3 = b2 + kstep;
            if constexpr (Epi::MID) { if (t == E.tmid) E.mid(acc, cur, wr, wc, fr, fq); }
            PG8_LDB(B0, 0, 0); PG8_LDB(B1, 0, 1); PG8_SCHED; PG8_LDA(At, 0, 0); PG8_STAGE(PG8_SA(1, 1), a1 + hsA, voffA);
            PG8_WAIT_V(8); PG8_WAIT_L(0); PG8_BAR; PG8_MMA(0, 0, At, B0); PG8_MMA(0, 1, At, B1); PG8_BAR; PG8_SCHED;
            PG8_LDA(At, 0, 1); PG8_STAGE(PG8_SB(0, 0), b2, voffB); PG8_STAGE(PG8_SB(0, 1), b2 + hsB, voffB); PG8_STAGE(PG8_SA(0, 0), a2, voffA);
            PG8_WAIT_V(8); PG8_WAIT_L(0); PG8_BAR; PG8_MMA(1, 0, At, B0); PG8_MMA(1, 1, At, B1); PG8_BAR; PG8_SCHED;
            PG8_LDB(B0, 1, 0); PG8_LDB(B1, 1, 1); PG8_SCHED; PG8_LDA(At, 1, 0); PG8_STAGE(PG8_SA(0, 1), a2 + hsA, voffA);
            PG8_WAIT_V(8); PG8_WAIT_L(0); PG8_BAR; PG8_MMA(0, 0, At, B0); PG8_MMA(0, 1, At, B1); PG8_BAR; PG8_SCHED;
            PG8_LDA(At, 1, 1); PG8_STAGE(PG8_SB(1, 0), b3, voffB); PG8_STAGE(PG8_SB(1, 1), b3 + hsB, voffB); PG8_STAGE(PG8_SA(1, 0), a3, voffA);
            PG8_WAIT_V(8); PG8_WAIT_L(0); PG8_BAR; PG8_MMA(1, 0, At, B0); PG8_MMA(1, 1, At, B1); PG8_BAR; PG8_SCHED;
        }
        if constexpr (ALIGN_EPI) { if (wr == 0) PG8_BAR; }
        E(acc, cur, wr, wc, fr, fq);
        if (!has_next) break;
#pragma unroll
        for (int a = 0; a < 2; ++a)
#pragma unroll
            for (int b = 0; b < 2; ++b)
#pragma unroll
                for (int m = 0; m < 4; ++m)
#pragma unroll
                    for (int n = 0; n < 2; ++n) acc[a][b][m][n] = (f32x4){0.f, 0.f, 0.f, 0.f};
        cur = nxt; cA = nA; cB = nB; ++ui;
        if constexpr (ALIGN_EPI) { if (wr == 1) PG8_BAR; }
    }
    PG8_WAIT_V(0);
    if constexpr (!ALIGN_EPI) { if (wr == 0) PG8_BAR; }
    PG8_BAR;
#undef PG8_SA
#undef PG8_SB
#undef PG8_STAGE
#undef PG8_LDA
#undef PG8_LDB
#undef PG8_MMA
#undef PG8_WAIT_V
#undef PG8_WAIT_L
#undef PG8_BAR
#undef PG8_SCHED
#undef PG8_AT
}
}

constexpr int NWAVES = 8;
constexpr int NPHASE = 8;
constexpr int N_LAUNCHES = MK_N_LAUNCHES;
constexpr int BATCH = 16, SEQ = 2048, DM = 1024, M = BATCH * SEQ;
constexpr int D_SSM = 512, NG = 32, GC = 16, NP = 64, D_ATT = 512, HD = 64, NH = 8, IH = 8, ID = 64, TOPK = 256, DFF = 4096, D_IN = 1864;
constexpr int N_PLAIN = 1280, N_IDX_PAD = 768, K3 = 3072;
constexpr float EPS = 1e-6f;
constexpr float IDX_SCALE = 0.125f * 0.35355339059327373f;

constexpr size_t MiB = 1u << 20;
constexpr size_t WS_CTL = 0, CTL_ZERO_BYTES = 1 * MiB;
constexpr size_t WS_MODP = 1 * MiB;
constexpr size_t WS_MOD = 4 * MiB;
constexpr size_t WS_BIAS2 = 4 * MiB + 512 * 1024;
constexpr size_t WS_SSQS = 5 * MiB;
constexpr size_t WS_SSQ2 = 6 * MiB;
constexpr size_t WS_SSQA = 35 * MiB + 512 * 1024;
constexpr size_t WS_WINP = 8 * MiB;
constexpr size_t WS_WINI = 11 * MiB;
constexpr size_t WS_WGLU = 16 * MiB;
constexpr size_t WS_WOUT = 17 * MiB;
constexpr size_t WS_W1 = 19 * MiB;
constexpr size_t WS_W2 = 27 * MiB;
constexpr size_t WS_SSMP = 35 * MiB;
constexpr size_t WS_U = 36 * MiB;
constexpr size_t WS_Q = 68 * MiB;
constexpr size_t WS_A2 = 36 * MiB;
constexpr size_t WS_XN = 100 * MiB;
constexpr size_t WS_KV = 228 * MiB;
constexpr size_t WS_KI = 244 * MiB;
constexpr size_t WS_WI = 252 * MiB;
constexpr size_t WS_QI = 256 * MiB;
constexpr size_t WS_Z = 320 * MiB;
constexpr size_t WS_MIX = 352 * MiB;
constexpr size_t WS_H = 256 * MiB;
constexpr size_t WS_SSMF = 416 * MiB;
constexpr size_t WS_END = 512 * MiB;
constexpr int CW_BAR = 4096;

constexpr int RING_OFF = 0;
constexpr int WAVE_LDS = 17920;
constexpr int BM_OFF = 131072;
constexpr int XCH_OFF = 147456;
constexpr int LDSCTL_OFF = 155648, MISC_OFF = LDSCTL_OFF + 320;
constexpr int LDS_BYTES = 159744;

#define GAS __attribute__((address_space(1)))
#define LAS __attribute__((address_space(3)))
typedef unsigned short bf16;
typedef unsigned v4u __attribute__((ext_vector_type(4)));
typedef unsigned v2u __attribute__((ext_vector_type(2)));
typedef float f32x4 __attribute__((ext_vector_type(4)));
typedef float f32x2 __attribute__((ext_vector_type(2)));
typedef GAS unsigned gu32;
#define RLX_AGENT __ATOMIC_RELAXED, __HIP_MEMORY_SCOPE_AGENT
#define LDS_WAIT() asm volatile("s_waitcnt lgkmcnt(0)" ::: "memory")
#define VM_WAIT() asm volatile("s_waitcnt vmcnt(0)" ::: "memory")
__device__ __forceinline__ unsigned f2bf(float f) { unsigned u = __builtin_bit_cast(unsigned, f); return (u + 0x7fffu + ((u >> 16) & 1u)) >> 16; }
__device__ __forceinline__ unsigned pk2(float lo, float hi) { return f2bf(lo) | (f2bf(hi) << 16); }
typedef __bf16 bf16x2_t __attribute__((ext_vector_type(2)));
__device__ __forceinline__ unsigned cvtpk(float lo, float hi) { const f32x2 v = {lo, hi}; return __builtin_bit_cast(unsigned, __builtin_convertvector(v, bf16x2_t)); }
__device__ __forceinline__ float bf2f(unsigned h) { return __builtin_bit_cast(float, h << 16); }
__device__ __forceinline__ float bflo(unsigned w) { return __builtin_bit_cast(float, w << 16); }
__device__ __forceinline__ float bfhi(unsigned w) { return __builtin_bit_cast(float, w & 0xffff0000u); }

#define XB_TMO      128
#define XB_XCNT(j)  (256  + 64 * (j))
#define XB_XSUB(j)  (1280 + 64 * (j))
#define XB_XGEN(j)  (2304 + 64 * (j))
#define XB_TOP      3328
#define XB_TOPGEN   3392
#define XCD_BAR_WORDS 3456
#define XB_SPIN_CAP (1u << 18)
__device__ __forceinline__ unsigned xb_ld(unsigned* p)              { return __hip_atomic_load(p, __ATOMIC_RELAXED, __HIP_MEMORY_SCOPE_AGENT); }
__device__ __forceinline__ unsigned xb_add(unsigned* p, unsigned v) { return __hip_atomic_fetch_add(p, v, __ATOMIC_RELAXED, __HIP_MEMORY_SCOPE_AGENT); }
__device__ __forceinline__ unsigned xb_xcc_id() { return (unsigned)__builtin_amdgcn_s_getreg((3 << 11) | 20) & 0xFu; }
#define XB_SPIN(cond, bar) do { unsigned _sp = 0; while (cond) { __builtin_amdgcn_s_sleep(1); \
    if ((++_sp & 255u) == 0u) { if (xb_ld(&(bar)[XB_TMO])) break; if (_sp > XB_SPIN_CAP) { atomicAdd(&(bar)[XB_TMO], 1u); break; } } } } while (0)
struct XcdBarrier { unsigned* bar; unsigned x; volatile LAS unsigned* st; };
__device__ __forceinline__ XcdBarrier xcd_barrier_post(unsigned* bar, volatile LAS unsigned* st) {
    XcdBarrier b; b.bar = bar; b.x = xb_xcc_id(); b.st = st;
    if (threadIdx.x == 0) (void)xb_add(&bar[XB_XCNT(b.x)], 1u);
    return b;
}
__device__ __forceinline__ void xcd_barrier_complete(unsigned* bar, unsigned x, unsigned& nloc, unsigned& nx) {
    const unsigned G = gridDim.x * gridDim.y * gridDim.z;
    unsigned sum, cnt, mine, sp = 0u;
    for (;;) {
        sum = 0u; cnt = 0u; mine = 0u;
#pragma unroll
        for (unsigned j = 0; j < 16; ++j) { const unsigned c = xb_ld(&bar[XB_XCNT(j)]); sum += c; cnt += (c > 0u) ? 1u : 0u; mine = (j == x) ? c : mine; }
        if (sum == G) break;
        __builtin_amdgcn_s_sleep(1);
        if ((++sp & 255u) == 0u) { if (xb_ld(&bar[XB_TMO])) break; if (sp > XB_SPIN_CAP) { atomicAdd(&bar[XB_TMO], 1u); break; } }
    }
    nloc = mine > 0u ? mine : 1u; nx = cnt > 0u ? cnt : 1u;
}
__device__ __forceinline__ void xcd_barrier(const XcdBarrier& b) {
    asm volatile("s_waitcnt vmcnt(0)" ::: "memory");
    __syncthreads();
    if (threadIdx.x == 0) {
        unsigned* bar = b.bar;
        __builtin_amdgcn_s_waitcnt(0);
        unsigned nloc = b.st[0], nx = b.st[1];
        if (nloc == 0u) { xcd_barrier_complete(bar, b.x, nloc, nx); b.st[0] = nloc; b.st[1] = nx; }
        const unsigned old = xb_add(&bar[XB_XSUB(b.x)], 1u);
        const unsigned gen = old / nloc;
        if (old + 1u == (gen + 1u) * nloc) {
            __builtin_amdgcn_fence(__ATOMIC_RELEASE, "agent");
            asm volatile("s_waitcnt vmcnt(0)" ::: "memory");
            const unsigned og = xb_add(&bar[XB_TOP], 1u);
            const unsigned tg = og / nx;
            if (og + 1u == (tg + 1u) * nx) xb_add(&bar[XB_TOPGEN], 1u);
            else XB_SPIN(xb_ld(&bar[XB_TOPGEN]) == tg, bar);
            __builtin_amdgcn_fence(__ATOMIC_ACQUIRE, "agent");
            xb_add(&bar[XB_XGEN(b.x)], 1u);
            asm volatile("s_waitcnt vmcnt(0)" ::: "memory");
        } else {
            XB_SPIN(xb_ld(&bar[XB_XGEN(b.x)]) == gen, bar);
            __builtin_amdgcn_fence(__ATOMIC_ACQUIRE, "agent");
            asm volatile("s_waitcnt vmcnt(0)" ::: "memory");
        }
    }
    __syncthreads();
}

struct Frame {
    LAS unsigned char* lds;
    volatile LAS unsigned* MISC;
    gu32* ctl;
    int tid, lane, wave;
    int vcu, G;
    const float *x, *c, *norm1_g, *norm2_g, *w_ada, *b_ada, *w_in, *lam_re, *lam_im, *log_dt, *b_re, *b_im, *c_re, *c_im, *d_skip, *w_glu, *b_glu, *q_gain, *k_gain, *gn_ssm, *gn_attn, *w_out, *w_ff1, *w_ff2;
    float* out;
    float *MODP, *MOD, *BIAS2, *SSQS, *SSQ2, *SSQA, *WI;
    bf16 *KI2, *QI2, *SSMF;
    f32x2 *LAMB, *BBAR;
    bf16 *WINP, *WINI, *WGLU, *WOUT, *W1, *W2, *U, *Q, *A2, *XN, *KV, *Z, *MIX, *H;
};

__device__ __forceinline__ float wave_sum(float v) {
#pragma unroll
    for (int o = 1; o < 64; o <<= 1) v += __shfl_xor(v, o);
    return v;
}
__device__ __forceinline__ float wave_max(float v) {
#pragma unroll
    for (int o = 1; o < 64; o <<= 1) v = fmaxf(v, __shfl_xor(v, o));
    return v;
}
__device__ __forceinline__ int wave_sum_i(int v) {
#pragma unroll
    for (int o = 1; o < 64; o <<= 1) v += __shfl_xor(v, o);
    return v;
}

__device__ __forceinline__ double exp_d(double x) {
    const double n = __builtin_rint(x * 1.4426950408889634);
    const double r = (x - n * 0.693147180369123816490e+00) - n * 1.90821492927058770002e-10;
    double p = 1.0 / 87178291200.0;
    p = p * r + 1.0 / 6227020800.0; p = p * r + 1.0 / 479001600.0; p = p * r + 1.0 / 39916800.0; p = p * r + 1.0 / 3628800.0; p = p * r + 1.0 / 362880.0;
    p = p * r + 1.0 / 40320.0; p = p * r + 1.0 / 5040.0; p = p * r + 1.0 / 720.0; p = p * r + 1.0 / 120.0; p = p * r + 1.0 / 24.0; p = p * r + 1.0 / 6.0; p = p * r + 0.5; p = p * r + 1.0; p = p * r + 1.0;
    const long long e = (long long)n + 1023;
    return p * __builtin_bit_cast(double, (unsigned long long)e << 52);
}
__device__ __forceinline__ void sincos_d(double x, double& s, double& c) {
    const double n = __builtin_rint(x * 0.63661977236758134308);
    double r = (x - n * 1.57079632673412561417e+00) - n * 6.07710050650619224932e-11;
    r = r - n * 2.02226624879595063154e-21;
    const double r2 = r * r;
    double sp = -1.0 / 1307674368000.0;
    sp = sp * r2 + 1.0 / 6227020800.0; sp = sp * r2 - 1.0 / 39916800.0; sp = sp * r2 + 1.0 / 362880.0; sp = sp * r2 - 1.0 / 5040.0; sp = sp * r2 + 1.0 / 120.0; sp = sp * r2 - 1.0 / 6.0; sp = sp * r2 + 1.0;
    const double sr = sp * r;
    double cp = 1.0 / 20922789888000.0;
    cp = cp * r2 - 1.0 / 87178291200.0; cp = cp * r2 + 1.0 / 479001600.0; cp = cp * r2 - 1.0 / 3628800.0; cp = cp * r2 + 1.0 / 40320.0; cp = cp * r2 - 1.0 / 720.0; cp = cp * r2 + 1.0 / 24.0; cp = cp * r2 - 0.5; cp = cp * r2 + 1.0;
    const long long q = (long long)n & 3;
    s = (q == 0) ? sr : (q == 1) ? cp : (q == 2) ? -sr : -cp;
    c = (q == 0) ? cp : (q == 1) ? -sr : (q == 2) ? -cp : sr;
}

template <int MODE>
__device__ __forceinline__ void p0_transpose_item(Frame& F, const float* W, int K, int N, bf16* WT, LAS float* scr, int item, int lane) {
    const int nblk = (N + 31) / 32, kb = item / nblk, nb = item % nblk, k0 = 64 * kb, n0 = 32 * nb;
#pragma unroll 8
    for (int i = 0; i < 32; ++i) { const int kk = 2 * i + (lane >> 5); const int n = n0 + (lane & 31);
        float v = (MODE != 1 || n < N) ? W[(size_t)(k0 + kk) * N + n] : 0.f;
        if (MODE == 2) { const int k = k0 + kk; v *= (k < D_SSM) ? F.gn_ssm[k] : F.gn_attn[k - D_SSM]; }
        scr[kk * 33 + (lane & 31)] = v; }
    LDS_WAIT(); asm volatile("" ::: "memory");
    const int c = lane & 7;
#pragma unroll
    for (int j = 0; j < 4; ++j) { const int n = (lane >> 3) + 8 * j; const LAS float* s = scr + (8 * c) * 33 + n;
        float v[8];
#pragma unroll
        for (int e = 0; e < 8; ++e) v[e] = s[e * 33];
        v4u o; o.x = pk2(v[0], v[1]); o.y = pk2(v[2], v[3]); o.z = pk2(v[4], v[5]); o.w = pk2(v[6], v[7]);
        if (MODE != 1) { *(GAS v4u*)(WT + (size_t)(n0 + n) * K + k0 + 8 * c) = o; }
        else {
            const int ng = n0 + n;
            if (ng < N_PLAIN) { *(GAS v4u*)(F.WINP + (size_t)ng * 1024 + k0 + 8 * c) = o; }
            else {
                float l[8];
#pragma unroll
                for (int e = 0; e < 8; ++e) l[e] = v[e] - bf2f(f2bf(v[e]));
                v4u ol; ol.x = pk2(l[0], l[1]); ol.y = pk2(l[2], l[3]); ol.z = pk2(l[4], l[5]); ol.w = pk2(l[6], l[7]);
                bf16* d = F.WINI + (size_t)(ng - N_PLAIN) * K3 + k0 + 8 * c;
                *(GAS v4u*)(d) = o; *(GAS v4u*)(d + 1024) = o; *(GAS v4u*)(d + 2048) = ol;
            }
        } }
    LDS_WAIT(); asm volatile("" ::: "memory");
}

__device__ __forceinline__ void p0_mod_item(Frame& F, int item, LAS float* scr) {
    const int cg = item >> 3, ks = item & 7, j = cg * 64 + F.lane, k0 = ks * 128;
    for (int e = F.lane; e < 2048; e += 64) { const int b = e >> 7, i = e & 127; const float cv = F.c[b * 1024 + k0 + i]; scr[e] = cv / (1.f + __expf(-cv)); }
    LDS_WAIT(); asm volatile("" ::: "memory");
    float acc[16];
#pragma unroll
    for (int b = 0; b < 16; ++b) acc[b] = 0.f;
    for (int i4 = 0; i4 < 32; ++i4) {
        const float* wp = F.w_ada + (size_t)(k0 + 4 * i4) * 6144 + j;
        const float w0 = wp[0], w1 = wp[6144], w2 = wp[2 * 6144], w3 = wp[3 * 6144];
#pragma unroll
        for (int b = 0; b < 16; ++b) { const f32x4 s = *(const LAS f32x4*)(scr + b * 128 + 4 * i4); acc[b] += s.x * w0 + s.y * w1 + s.z * w2 + s.w * w3; }
    }
#pragma unroll
    for (int b = 0; b < 16; ++b) F.MODP[(size_t)(ks * 16 + b) * 6144 + j] = acc[b];
    LDS_WAIT(); asm volatile("" ::: "memory");
}

__device__ __forceinline__ void p0_ssm_item(Frame& F, int g) {
    const int p = F.lane, gp = g * 64 + p;
    const double lre = (double)F.lam_re[gp], lim = (double)F.lam_im[gp], dt = exp_d((double)F.log_dt[g]);
    double s, c; sincos_d(lim * dt, s, c);
    const double mag = exp_d(lre * dt), lbr = mag * c, lbi = mag * s;
    const double a = lbr - 1.0, b = lbi, den = lre * lre + lim * lim;
    const double cr = (a * lre + b * lim) / den, ci = (b * lre - a * lim) / den;
    F.LAMB[gp] = (f32x2){(float)lbr, (float)lbi};
#pragma unroll
    for (int cc = 0; cc < 16; ++cc) { const double br = (double)F.b_re[gp * 16 + cc], bi = (double)F.b_im[gp * 16 + cc];
        F.BBAR[gp * 16 + cc] = (f32x2){(float)(cr * br - ci * bi), (float)(cr * bi + ci * br)}; }
}

__device__ __forceinline__ void p0a_phase(Frame& F) {
    LAS float* scr = (LAS float*)(F.lds + RING_OFF + F.wave * WAVE_LDS);
    const int gw = F.vcu * NWAVES + F.wave, NGW = F.G * NWAVES;
    constexpr int I_MOD = 96 * 8, I_SSM = 32;
    constexpr int I_IN = 16 * 59, I_GLU = 8 * 16, I_OUT = 16 * 32, I_1 = 16 * 128, I_2 = 64 * 32;
    constexpr int NITEMS = I_MOD + I_SSM + I_IN + I_GLU + I_OUT + I_1 + I_2;
    for (int it = gw; it < NITEMS; it += NGW) {
        int r = it;
        if (r < I_MOD) { p0_mod_item(F, r, scr); continue; } r -= I_MOD;
        if (r < I_SSM) { p0_ssm_item(F, r); continue; } r -= I_SSM;
        if (r < I_IN) { p0_transpose_item<1>(F, F.w_in, 1024, D_IN, nullptr, scr, r, F.lane); continue; } r -= I_IN;
        if (r < I_GLU) { p0_transpose_item<0>(F, F.w_glu, 512, 512, F.WGLU, scr, r, F.lane); continue; } r -= I_GLU;
        if (r < I_OUT) { p0_transpose_item<2>(F, F.w_out, 1024, 1024, F.WOUT, scr, r, F.lane); continue; } r -= I_OUT;
        if (r < I_1) { p0_transpose_item<0>(F, F.w_ff1, 1024, DFF, F.W1, scr, r, F.lane); continue; } r -= I_1;
        p0_transpose_item<0>(F, F.w_ff2, DFF, 1024, F.W2, scr, r, F.lane);
    }
    { const int gt = (F.vcu * NWAVES + F.wave) * 64 + F.lane, NT = F.G * NWAVES * 64; GAS v4u* z = (GAS v4u*)(F.WINI + (size_t)608 * K3);
      for (int i = gt; i < 160 * K3 / 8; i += NT) z[i] = (v4u){0u, 0u, 0u, 0u}; }
}

__device__ __forceinline__ f32x2 cmul(f32x2 a, f32x2 b) { return (f32x2){a.x * b.x - a.y * b.y, a.x * b.y + a.y * b.x}; }
__device__ __forceinline__ f32x2 cpow(f32x2 a, int e) { f32x2 r = {1.f, 0.f}; f32x2 bq = a;
#pragma unroll
    for (int k = 0; k < 5; ++k) { if (e & (1 << k)) r = cmul(r, bq); bq = cmul(bq, bq); }
    return r; }
__device__ __forceinline__ void ssm_frag_item(Frame& F, int item) {
    const int g = item / 144, bi = item % 144, lane = F.lane, il = lane & 15, kq = lane >> 4;
    float v[8];
#pragma unroll
    for (int j = 0; j < 8; ++j) v[j] = 0.f;
    if (bi < 16) {
        const int d = bi - (kq >> 1);
        if (d >= 0) {
            for (int p = 0; p < 64; ++p) {
                const f32x2 pw = cpow(F.LAMB[g * 64 + p], d);
                const f32x2 cw = cmul((f32x2){F.c_re[(g * 16 + il) * 64 + p], F.c_im[(g * 16 + il) * 64 + p]}, pw);
                const f32x2* bb = F.BBAR + (g * 64 + p) * 16 + 8 * (kq & 1);
#pragma unroll
                for (int j = 0; j < 8; ++j) { const f32x2 bv = bb[j]; v[j] += cw.x * bv.x - cw.y * bv.y; }
            }
        }
    } else if (bi < 80) {
        const int e = bi - 16, i = e >> 3, kb = e & 7, R = 16 * i + il, p = R & 63, s_ = 2 * kb + (kq >> 1);
        const f32x2 pw = cpow(F.LAMB[g * 64 + p], 15 - s_);
        const f32x2* bb = F.BBAR + (g * 64 + p) * 16 + 8 * (kq & 1);
#pragma unroll
        for (int j = 0; j < 8; ++j) { const f32x2 wv = cmul(pw, bb[j]); v[j] = (R >= 64) ? wv.y : wv.x; }
    } else {
        const int e = bi - 80, t = e >> 2, ks = e & 3;
#pragma unroll
        for (int j = 0; j < 8; ++j) { const int sg = 16 * (2 * ks + (j >> 2)) + 4 * kq + (j & 3), p = sg & 63;
            const f32x2 pw = cpow(F.LAMB[g * 64 + p], t + 1);
            const f32x2 cw = cmul((f32x2){F.c_re[(g * 16 + il) * 64 + p], F.c_im[(g * 16 + il) * 64 + p]}, pw);
            v[j] = (sg >= 64) ? -cw.y : cw.x; }
    }
    v4u o; o.x = pk2(v[0], v[1]); o.y = pk2(v[2], v[3]); o.z = pk2(v[4], v[5]); o.w = pk2(v[6], v[7]);
    *(GAS v4u*)(F.SSMF + (size_t)item * 512 + lane * 8) = o;
}

__device__ __forceinline__ void p0b_phase(Frame& F) {
    const int w = F.vcu;
    { const int idx = w * 384 + F.tid;
      if (F.tid < 384 && idx < 16 * 6144) { const int j = idx % 6144; float s = F.b_ada[j];
#pragma unroll
          for (int ks = 0; ks < 8; ++ks) s += F.MODP[(size_t)ks * 16 * 6144 + idx];
          F.MOD[idx] = s; } }
    for (int it = F.vcu * NWAVES + F.wave; it < NG * 144; it += F.G * NWAVES) ssm_frag_item(F, it);
    LAS float* sh = (LAS float*)(F.lds + RING_OFF);
    for (int rb = w; rb < M / 128; rb += F.G) {
        const int b = rb / 16;
        __syncthreads();
        for (int e = F.tid; e < 2048; e += NWAVES * 64) { float s = F.b_ada[e];
#pragma unroll
            for (int ks = 0; ks < 8; ++ks) s += F.MODP[(size_t)(ks * 16 + b) * 6144 + e];
            sh[e] = s; }
        __syncthreads();
        for (int r = 0; r < 16; ++r) {
            const size_t m = (size_t)rb * 128 + F.wave * 16 + r;
            const GAS f32x4* xr = (const GAS f32x4*)(F.x + m * DM) + F.lane;
            f32x4 v[4]; float ss = 0.f;
#pragma unroll
            for (int j = 0; j < 4; ++j) { v[j] = xr[64 * j]; ss += (v[j].x * v[j].x + v[j].y * v[j].y) + (v[j].z * v[j].z + v[j].w * v[j].w); }
            const float rstd = 1.0f / sqrtf(wave_sum(ss) * (1.f / DM) + EPS);
            GAS v2u* oh = (GAS v2u*)(F.XN + m * 2048) + F.lane;
#pragma unroll
            for (int j = 0; j < 4; ++j) { const int col = 4 * F.lane + 256 * j;
                const f32x4 g = *(const f32x4*)(F.norm1_g + col); const f32x4 s1 = *(const LAS f32x4*)(sh + col); const f32x4 c1 = *(const LAS f32x4*)(sh + 1024 + col);
                f32x4 h = v[j] * rstd * g * (c1 + 1.0f) + s1;
                float hh[4] = {h.x, h.y, h.z, h.w}, hl[4];
#pragma unroll
                for (int e = 0; e < 4; ++e) hl[e] = hh[e] - bf2f(f2bf(hh[e]));
                oh[64 * j] = (v2u){pk2(hh[0], hh[1]), pk2(hh[2], hh[3])};
                oh[256 + 64 * j] = (v2u){pk2(hl[0], hl[1]), pk2(hl[2], hl[3])}; }
        }
    }
}

using pg8::Unit; using pg8::cvt_pk_bf16;
struct EpiInPlain {
    static constexpr bool PERM = true, MID = false; int tmid;
    bf16 *U, *Q, *KV;
    __device__ __forceinline__ void mid(f32x4 (&)[2][2][4][2], const Unit&, int, int, int, int) const {}
    __device__ __forceinline__ void operator()(const f32x4 (&acc)[2][2][4][2], const Unit& u, int wr, int wc, int fr, int fq) const {
        bf16* base; int ldc, colt;
        if (u.pn < 2) { base = U; ldc = 512; colt = u.pn * 256; } else if (u.pn < 4) { base = Q; ldc = 512; colt = (u.pn - 2) * 256; } else { base = KV; ldc = 256; colt = 0; }
        const int row0 = u.pm * 256 + wr * 64 + fr, col0 = colt + wc * 32 + 8 * fq;
#pragma unroll
        for (int ai = 0; ai < 2; ++ai)
#pragma unroll
            for (int m = 0; m < 4; ++m) { bf16* rowp = base + (size_t)(row0 + ai * 128 + m * 16) * ldc + col0;
#pragma unroll
                for (int bj = 0; bj < 2; ++bj) { const f32x4 v0 = acc[ai][bj][m][0], v1 = acc[ai][bj][m][1];
                    v4u wv; wv.x = cvt_pk_bf16(v0[0], v0[1]); wv.y = cvt_pk_bf16(v0[2], v0[3]); wv.z = cvt_pk_bf16(v1[0], v1[1]); wv.w = cvt_pk_bf16(v1[2], v1[3]);
                    *(v4u*)(rowp + bj * 128) = wv; } }
    }
};
struct EpiInIdx {
    static constexpr bool PERM = false, MID = false; int tmid;
    bf16 *QI2, *KI2; float* WI;
    __device__ __forceinline__ void mid(f32x4 (&)[2][2][4][2], const Unit&, int, int, int, int) const {}
    __device__ __forceinline__ static void st_hilo(bf16* hp, bf16* lp, const f32x4 v) {
        const float l0 = v[0] - bf2f(f2bf(v[0])), l1 = v[1] - bf2f(f2bf(v[1])), l2 = v[2] - bf2f(f2bf(v[2])), l3 = v[3] - bf2f(f2bf(v[3]));
        *(v2u*)hp = (v2u){pk2(v[0], v[1]), pk2(v[2], v[3])}; *(v2u*)lp = (v2u){pk2(l0, l1), pk2(l2, l3)};
    }
    __device__ __forceinline__ void operator()(const f32x4 (&acc)[2][2][4][2], const Unit& u, int wr, int wc, int fr, int fq) const {
        const int row0 = u.pm * 256 + wr * 64 + fr;
        if (u.pn < 2) {
            const int col0 = u.pn * 256 + wc * 32 + 4 * fq;
#pragma unroll
            for (int ai = 0; ai < 2; ++ai)
#pragma unroll
                for (int m = 0; m < 4; ++m) { bf16* rowp = QI2 + (size_t)(row0 + ai * 128 + m * 16) * 1024 + col0;
#pragma unroll
                    for (int bj = 0; bj < 2; ++bj)
#pragma unroll
                        for (int n = 0; n < 2; ++n) st_hilo(rowp + bj * 128 + n * 16, rowp + 512 + bj * 128 + n * 16, acc[ai][bj][m][n]); }
        } else {
#pragma unroll
            for (int ai = 0; ai < 2; ++ai)
#pragma unroll
                for (int m = 0; m < 4; ++m) { const size_t row = (size_t)(row0 + ai * 128 + m * 16);
#pragma unroll
                    for (int n = 0; n < 2; ++n) { const int col = wc * 32 + 16 * n + 4 * fq;
                        if (col < 64) st_hilo(KI2 + row * 128 + col, KI2 + row * 128 + 64 + col, acc[ai][0][m][n]);
                        else if (col < 72) *(f32x4*)(WI + row * 8 + (col - 64)) = acc[ai][0][m][n]; } }
        }
    }
};
struct EpiGlu {
    static constexpr bool PERM = true, MID = false; int tmid;
    const bf16* Z; bf16* MIX; const float* bglu; float* SSQS;
    __device__ __forceinline__ void mid(f32x4 (&)[2][2][4][2], const Unit&, int, int, int, int) const {}
    __device__ __forceinline__ void operator()(const f32x4 (&acc)[2][2][4][2], const Unit& u, int wr, int wc, int fr, int fq) const {
        const int row0 = u.pm * 256 + wr * 64 + fr, col0 = u.pn * 256 + wc * 32 + 8 * fq;
#pragma unroll
        for (int ai = 0; ai < 2; ++ai)
#pragma unroll
            for (int m = 0; m < 4; ++m) { const size_t row = (size_t)(row0 + ai * 128 + m * 16); float ss = 0.f;
#pragma unroll
                for (int bj = 0; bj < 2; ++bj) { const int col = col0 + bj * 128;
                    const v4u zz = *(const v4u*)(Z + row * 512 + col);
                    const f32x4 b0 = *(const f32x4*)(bglu + col), b1 = *(const f32x4*)(bglu + col + 4);
                    const f32x4 a0 = acc[ai][bj][m][0] + b0, a1 = acc[ai][bj][m][1] + b1;
                    float zf[8] = {bflo(zz.x), bfhi(zz.x), bflo(zz.y), bfhi(zz.y), bflo(zz.z), bfhi(zz.z), bflo(zz.w), bfhi(zz.w)};
                    float av[8] = {a0[0], a0[1], a0[2], a0[3], a1[0], a1[1], a1[2], a1[3]}, y[8];
#pragma unroll
                    for (int e = 0; e < 8; ++e) { y[e] = zf[e] / (1.f + __expf(-av[e])); ss += y[e] * y[e]; }
                    v4u wv; wv.x = cvt_pk_bf16(y[0], y[1]); wv.y = cvt_pk_bf16(y[2], y[3]); wv.z = cvt_pk_bf16(y[4], y[5]); wv.w = cvt_pk_bf16(y[6], y[7]);
                    *(v4u*)(MIX + row * 1024 + col) = wv; }
                ss += __shfl_xor(ss, 16); ss += __shfl_xor(ss, 32);
                if (fq == 0) SSQS[row * 8 + u.pn * 4 + wc] = ss; }
    }
};
struct EpiOut {
    static constexpr bool PERM = true, MID = true; int tmid;
    const float* x; float* x1; bf16* A2; const float* MOD; const float* g2n; const float* SSQS; float* SSQ2; const float* SSQA;
    __device__ __forceinline__ void mid(f32x4 (&acc)[2][2][4][2], const Unit& u, int wr, int wc, int fr_, int fq_) const {
        int fr = fr_, fq = fq_; asm volatile("" : "+v"(fr), "+v"(fq));
#pragma unroll
        for (int ai = 0; ai < 2; ++ai)
#pragma unroll
            for (int m = 0; m < 4; ++m) { const size_t row = (size_t)(u.pm * 256 + ai * 128 + wr * 64 + m * 16 + fr);
                const f32x4 p = *(const f32x4*)(SSQS + row * 8 + 4 * (fq & 1)); float s = (p.x + p.y) + (p.z + p.w); s += __shfl_xor(s, 16);
                const f32x2 sa = *(const f32x2*)(SSQA + row * 2);
                const float rstd = sqrtf((sa.x + sa.y) * (1.f / 512.f) + EPS) / sqrtf(s * (1.f / 512.f) + EPS);
#pragma unroll
                for (int bj = 0; bj < 2; ++bj)
#pragma unroll
                    for (int n = 0; n < 2; ++n) acc[ai][bj][m][n] *= rstd; }
    }
    __device__ __forceinline__ void operator()(const f32x4 (&acc)[2][2][4][2], const Unit& u, int wr, int wc, int fr, int fq) const {
        const int b = u.pm >> 3; const float* mod = MOD + (size_t)b * 6144;
        const int row0 = u.pm * 256 + wr * 64 + fr, col0 = u.pn * 256 + wc * 32 + 8 * fq;
#pragma unroll
        for (int ai = 0; ai < 2; ++ai)
#pragma unroll
            for (int m = 0; m < 4; ++m) { const size_t row = (size_t)(row0 + ai * 128 + m * 16); float ss = 0.f;
                const f32x2 sa = *(const f32x2*)(SSQA + row * 2); const float ra = 1.0f / sqrtf((sa.x + sa.y) * (1.f / 512.f) + EPS);
#pragma unroll
                for (int bj = 0; bj < 2; ++bj) { const int col = col0 + bj * 128; float a2[8];
#pragma unroll
                    for (int n = 0; n < 2; ++n) { const int c4 = col + 4 * n;
                        const f32x4 xv = *(const f32x4*)(x + row * 1024 + c4); const f32x4 g1 = *(const f32x4*)(mod + 2048 + c4);
                        const f32x4 v = xv + g1 * (acc[ai][bj][m][n] * ra);
                        *(f32x4*)(x1 + row * 1024 + c4) = v; ss += (v.x * v.x + v.y * v.y) + (v.z * v.z + v.w * v.w);
                        const f32x4 sc2 = *(const f32x4*)(mod + 4096 + c4); const f32x4 gg = *(const f32x4*)(g2n + c4);
                        const f32x4 a = v * gg * (sc2 + 1.0f); a2[4 * n] = a.x; a2[4 * n + 1] = a.y; a2[4 * n + 2] = a.z; a2[4 * n + 3] = a.w; }
                    v4u wv; wv.x = cvt_pk_bf16(a2[0], a2[1]); wv.y = cvt_pk_bf16(a2[2], a2[3]); wv.z = cvt_pk_bf16(a2[4], a2[5]); wv.w = cvt_pk_bf16(a2[6], a2[7]);
                    *(v4u*)(A2 + row * 1024 + col) = wv; }
                ss += __shfl_xor(ss, 16); ss += __shfl_xor(ss, 32);
                if (fq == 0) SSQ2[row * 16 + u.pn * 4 + wc] = ss;
                asm volatile("" ::: "memory"); }
    }
};
struct EpiUp {
    static constexpr bool PERM = true, MID = false; int tmid;
    const float* SSQ2; const float* BIAS2; bf16* H;
    __device__ __forceinline__ void mid(f32x4 (&)[2][2][4][2], const Unit&, int, int, int, int) const {}
    __device__ __forceinline__ void operator()(const f32x4 (&acc)[2][2][4][2], const Unit& u, int wr, int wc, int fr, int fq) const {
        const int b = u.pm >> 3; const float* bias = BIAS2 + (size_t)b * DFF;
        const int row0 = u.pm * 256 + wr * 64 + fr, col0 = u.pn * 256 + wc * 32 + 8 * fq;
        f32x4 bv[2][2];
#pragma unroll
        for (int bj = 0; bj < 2; ++bj)
#pragma unroll
            for (int n = 0; n < 2; ++n) bv[bj][n] = *(const f32x4*)(bias + col0 + bj * 128 + 4 * n);
#pragma unroll
        for (int ai = 0; ai < 2; ++ai)
#pragma unroll
            for (int m = 0; m < 4; ++m) { const size_t row = (size_t)(row0 + ai * 128 + m * 16);
                const f32x4 p = *(const f32x4*)(SSQ2 + row * 16 + 4 * fq); float s = (p.x + p.y) + (p.z + p.w); s += __shfl_xor(s, 16); s += __shfl_xor(s, 32);
                const float rstd = 1.0f / sqrtf(s * (1.f / 1024.f) + EPS);
#pragma unroll
                for (int bj = 0; bj < 2; ++bj) { f32x4 v0 = acc[ai][bj][m][0] * rstd + bv[bj][0], v1 = acc[ai][bj][m][1] * rstd + bv[bj][1];
                    float h[8] = {v0[0], v0[1], v0[2], v0[3], v1[0], v1[1], v1[2], v1[3]};
#pragma unroll
                    for (int e = 0; e < 8; ++e) { const float r = fmaxf(h[e], 0.f); h[e] = r * r; }
                    v4u wv; wv.x = cvt_pk_bf16(h[0], h[1]); wv.y = cvt_pk_bf16(h[2], h[3]); wv.z = cvt_pk_bf16(h[4], h[5]); wv.w = cvt_pk_bf16(h[6], h[7]);
                    *(v4u*)(H + row * DFF + col0 + bj * 128) = wv; } }
    }
};
struct EpiDown {
    static constexpr bool PERM = false, MID = false; int tmid;
    float* out; const float* MOD;
    __device__ __forceinline__ void mid(f32x4 (&)[2][2][4][2], const Unit&, int, int, int, int) const {}
    __device__ __forceinline__ void operator()(const f32x4 (&acc)[2][2][4][2], const Unit& u, int wr, int wc, int fr, int fq) const {
        const int b = u.pm >> 3; const float* g2 = MOD + (size_t)b * 6144 + 5120;
        const int row0 = u.pm * 256 + wr * 64 + fr, col0 = u.pn * 256 + wc * 32 + 4 * fq;
        f32x4 gv[2][2];
#pragma unroll
        for (int bj = 0; bj < 2; ++bj)
#pragma unroll
            for (int n = 0; n < 2; ++n) gv[bj][n] = *(const f32x4*)(g2 + col0 + bj * 128 + n * 16);
#pragma unroll
        for (int ai = 0; ai < 2; ++ai)
#pragma unroll
            for (int m = 0; m < 4; ++m) { float* rowp = out + (size_t)(row0 + ai * 128 + m * 16) * 1024 + col0;
#pragma unroll
                for (int bj = 0; bj < 2; ++bj)
#pragma unroll
                    for (int n = 0; n < 2; ++n) { const f32x4 x1 = *(const f32x4*)(rowp + bj * 128 + n * 16); *(f32x4*)(rowp + bj * 128 + n * 16) = x1 + gv[bj][n] * acc[ai][bj][m][n]; } }
    }
};

__device__ __forceinline__ float gelu_tanh(float v) {
    const float a = 0.7978845608028654f * (v + 0.044715f * v * v * v);
    const float th = 1.f - 2.f / (__expf(2.f * a) + 1.f);
    return 0.5f * v * (1.f + th);
}
__device__ __forceinline__ void bias2_item(Frame& F, int item, LAS float* scr) {
    const int b = item >> 6, n = (item & 63) * 64 + F.lane;
    for (int e = F.lane; e < 1024; e += 64) scr[e] = F.MOD[(size_t)b * 6144 + 3072 + e];
    LDS_WAIT(); asm volatile("" ::: "memory");
    float acc = 0.f;
#pragma unroll 8
    for (int k = 0; k < 1024; ++k) acc += scr[k] * F.w_ff1[(size_t)k * DFF + n];
    F.BIAS2[(size_t)b * DFF + n] = acc;
    LDS_WAIT(); asm volatile("" ::: "memory");
}
typedef short bf16x8s __attribute__((ext_vector_type(8)));
__device__ __forceinline__ void ssm_unit(Frame& F, int g, int bp) {
    const int lane = F.lane, w = F.wave, n = lane & 15, rq = lane >> 4, tid = F.tid;
    LAS unsigned char* L = F.lds;
    __syncthreads();
    { const GAS v4u* src = (const GAS v4u*)(F.SSMF + (size_t)g * 144 * 512); LAS v4u* dst = (LAS v4u*)L;
      for (int i = tid; i < 144 * 64; i += NWAVES * 64) dst[i] = src[i]; }
    float dsk[4];
#pragma unroll
    for (int r = 0; r < 4; ++r) dsk[r] = F.d_skip[g * 16 + 4 * rq + r];
    __syncthreads();
#define SSM_A(blk) (*(const LAS bf16x8s*)(L + (blk) * 1024 + lane * 16))
#define SSM_A16(gg, i, r) ({ f32x2 q_ = F.LAMB[(gg) * 64 + 16 * (i) + 4 * rq + (r)]; q_ = cmul(q_, q_); q_ = cmul(q_, q_); q_ = cmul(q_, q_); cmul(q_, q_); })
#pragma unroll 1
    for (int bb = 0; bb < 2; ++bb) {
        const int b = 2 * bp + bb;
        int gop = g; asm volatile("" : "+s"(gop));
        LAS float* XCH = (LAS float*)(F.lds + XCH_OFF) + bb * 1024;
        const size_t tok0 = (size_t)b * SEQ + (size_t)(16 * w + n) * 16;
        float Sre[4][4], Sim[4][4];
        { bf16x8s Uf1[8];
#pragma unroll
          for (int kb = 0; kb < 8; ++kb) Uf1[kb] = *(const bf16x8s*)(F.U + (tok0 + 2 * kb + (rq >> 1)) * 512 + gop * 16 + 8 * (rq & 1));
#pragma unroll
          for (int i = 0; i < 8; ++i) { f32x4 d = {0.f, 0.f, 0.f, 0.f};
#pragma unroll
              for (int kb = 0; kb < 8; ++kb) d = __builtin_amdgcn_mfma_f32_16x16x32_bf16(SSM_A(16 + i * 8 + kb), Uf1[kb], d, 0, 0, 0);
#pragma unroll
              for (int r = 0; r < 4; ++r) { if (i < 4) Sre[i][r] = d[r]; else Sim[i - 4][r] = d[r]; }
              asm volatile("" ::: "memory"); } }
#pragma unroll
        for (int i = 0; i < 4; ++i)
#pragma unroll
            for (int r = 0; r < 4; ++r) { f32x2 ak = SSM_A16(gop, i, r);
#pragma unroll
                for (int k = 1; k < 16; k <<= 1) { float ur = __shfl_up(Sre[i][r], k, 16), ui = __shfl_up(Sim[i][r], k, 16); if (n < k) { ur = 0.f; ui = 0.f; }
                    Sre[i][r] += ak.x * ur - ak.y * ui; Sim[i][r] += ak.x * ui + ak.y * ur; ak = cmul(ak, ak); } }
        if (n == 15) {
#pragma unroll
            for (int i = 0; i < 4; ++i)
#pragma unroll
                for (int r = 0; r < 4; ++r) { const int p = 16 * i + 4 * rq + r; XCH[w * 128 + p] = Sre[i][r]; XCH[w * 128 + 64 + p] = Sim[i][r]; } }
        __syncthreads();
        int gop2 = gop; asm volatile("" : "+s"(gop2));
        bf16x8s Xfr[4];
        { float Cre[4][4], Cim[4][4]; f32x2 aw[4][4];
#pragma unroll
          for (int i = 0; i < 4; ++i)
#pragma unroll
              for (int r = 0; r < 4; ++r) { Cre[i][r] = 0.f; Cim[i][r] = 0.f; f32x2 q = SSM_A16(gop2, i, r); q = cmul(q, q); q = cmul(q, q); q = cmul(q, q); aw[i][r] = cmul(q, q); }
#pragma unroll 1
          for (int v = 0; v < w; ++v) {
#pragma unroll
              for (int i = 0; i < 4; ++i)
#pragma unroll
                  for (int r = 0; r < 4; ++r) { const int p = 16 * i + 4 * rq + r; const float tr = XCH[v * 128 + p], ti = XCH[v * 128 + 64 + p];
                      const float nr = aw[i][r].x * Cre[i][r] - aw[i][r].y * Cim[i][r] + tr, ni = aw[i][r].x * Cim[i][r] + aw[i][r].y * Cre[i][r] + ti; Cre[i][r] = nr; Cim[i][r] = ni; } }
          int gop3 = gop2; asm volatile("" : "+s"(gop3));
#pragma unroll
          for (int i = 0; i < 4; ++i)
#pragma unroll
              for (int r = 0; r < 4; ++r) { const f32x2 pn = cpow(SSM_A16(gop3, i, r), n);
                  float ur = __shfl_up(Sre[i][r], 1, 16), ui = __shfl_up(Sim[i][r], 1, 16); if (n == 0) { ur = 0.f; ui = 0.f; }
                  Sre[i][r] = ur + pn.x * Cre[i][r] - pn.y * Cim[i][r]; Sim[i][r] = ui + pn.x * Cim[i][r] + pn.y * Cre[i][r]; }
          v4u t_;
          t_.x = cvtpk(Sre[0][0], Sre[0][1]); t_.y = cvtpk(Sre[0][2], Sre[0][3]); t_.z = cvtpk(Sre[1][0], Sre[1][1]); t_.w = cvtpk(Sre[1][2], Sre[1][3]); Xfr[0] = __builtin_bit_cast(bf16x8s, t_);
          t_.x = cvtpk(Sre[2][0], Sre[2][1]); t_.y = cvtpk(Sre[2][2], Sre[2][3]); t_.z = cvtpk(Sre[3][0], Sre[3][1]); t_.w = cvtpk(Sre[3][2], Sre[3][3]); Xfr[1] = __builtin_bit_cast(bf16x8s, t_);
          t_.x = cvtpk(Sim[0][0], Sim[0][1]); t_.y = cvtpk(Sim[0][2], Sim[0][3]); t_.z = cvtpk(Sim[1][0], Sim[1][1]); t_.w = cvtpk(Sim[1][2], Sim[1][3]); Xfr[2] = __builtin_bit_cast(bf16x8s, t_);
          t_.x = cvtpk(Sim[2][0], Sim[2][1]); t_.y = cvtpk(Sim[2][2], Sim[2][3]); t_.z = cvtpk(Sim[3][0], Sim[3][1]); t_.w = cvtpk(Sim[3][2], Sim[3][3]); Xfr[3] = __builtin_bit_cast(bf16x8s, t_); }
        int gop4 = gop2; asm volatile("" : "+s"(gop4) : "v"(Xfr[0]), "v"(Xfr[1]), "v"(Xfr[2]), "v"(Xfr[3]) : "memory");
        bf16x8s Ufr[8];
#pragma unroll
        for (int kb = 0; kb < 8; ++kb) Ufr[kb] = *(const bf16x8s*)(F.U + (tok0 + 2 * kb + (rq >> 1)) * 512 + gop4 * 16 + 8 * (rq & 1));
#pragma unroll
        for (int t = 0; t < 16; ++t) { f32x4 y = {0.f, 0.f, 0.f, 0.f};
#pragma unroll
            for (int kb = 0; kb <= t / 2; ++kb) y = __builtin_amdgcn_mfma_f32_16x16x32_bf16(SSM_A(t - 2 * kb), Ufr[kb], y, 0, 0, 0);
#pragma unroll
            for (int ks = 0; ks < 4; ++ks) y = __builtin_amdgcn_mfma_f32_16x16x32_bf16(SSM_A(80 + t * 4 + ks), Xfr[ks], y, 0, 0, 0);
            const size_t off = (tok0 + t) * 512 + g * 16 + 4 * rq;
            const v2u uu = *(const v2u*)(F.U + off);
            const float uf[4] = {bflo(uu.x), bfhi(uu.x), bflo(uu.y), bfhi(uu.y)};
            float z[4];
#pragma unroll
            for (int r = 0; r < 4; ++r) z[r] = gelu_tanh(y[r] + dsk[r] * uf[r]);
            *(v2u*)(F.Z + off) = (v2u){cvtpk(z[0], z[1]), cvtpk(z[2], z[3])};
            asm volatile("" ::: "memory"); }
    }
#undef SSM_A
#undef SSM_A16
}

__device__ __forceinline__ unsigned fkey(float f) { const unsigned u = __float_as_uint(f); return (u & 0x80000000u) ? ~u : (u | 0x80000000u); }

typedef short bf16x8 __attribute__((ext_vector_type(8)));
typedef float f32x16 __attribute__((ext_vector_type(16)));
__device__ __forceinline__ int crow(int r, int hi) { return (r & 3) + 8 * (r >> 2) + 4 * hi; }

__device__ __forceinline__ void select_query(const LAS unsigned* SCq, int t, int nvalid, LAS unsigned long long* BMq, int lane) {
    unsigned kreg[32];
#pragma unroll
    for (int j = 0; j < 32; ++j) kreg[j] = (64 * j + lane < nvalid) ? SCq[64 * j + lane] : 0u;
    const int n = t + 1; unsigned tau = 0u; int need = 0;
    if (n > TOPK) {
#pragma unroll 1
        for (int bit = 31; bit >= 0; --bit) { const unsigned cand = tau | (1u << bit); int c = 0;
#pragma unroll
            for (int j = 0; j < 32; ++j) c += __popcll(__ballot(kreg[j] >= cand));
            if (c >= TOPK) tau = cand; }
        int cg = 0;
#pragma unroll
        for (int j = 0; j < 32; ++j) cg += __popcll(__ballot(kreg[j] > tau));
        need = TOPK - cg;
    }
    const unsigned long long lt = (1ull << lane) - 1ull;
    int eqb = 0;
#pragma unroll
    for (int j = 0; j < 32; ++j) {
        const int s = lane + 64 * j; bool sf;
        if (n > TOPK) { const bool gt = kreg[j] > tau, eq = kreg[j] == tau; const unsigned long long em = __ballot(eq);
            const int rank = eqb + __popcll(em & lt); sf = gt || (eq && rank < need); eqb += __popcll(em); }
        else sf = (s <= t);
        const unsigned long long sm = __ballot(sf);
        if (lane == 0) BMq[j] = sm;
    }
}

__device__ __forceinline__ void idx_subunit(Frame& F, int b, int t0, int qoff) {
    const int lane = F.lane, w = F.wave, rt = w & 3, kp = w >> 2, r32 = lane & 31, hh = lane >> 5;
    LAS unsigned* SC = (LAS unsigned*)(F.lds);
    LAS unsigned long long* BM = (LAS unsigned long long*)(F.lds + BM_OFF);
    const int nk = t0 + 16, nkt = (nk + 31) >> 5;
    const bf16* qp = F.QI2 + (size_t)(b * SEQ + t0 + 4 * rt + (r32 >> 3)) * 1024 + (r32 & 7) * 64 + 8 * hh;
    bf16x8 qh[4], ql[4];
#pragma unroll
    for (int d0 = 0; d0 < 4; ++d0) { qh[d0] = *(const bf16x8*)(qp + 16 * d0); ql[d0] = *(const bf16x8*)(qp + 512 + 16 * d0); }
    f32x4 wq[4];
#pragma unroll
    for (int tq = 0; tq < 4; ++tq) wq[tq] = *(const f32x4*)(F.WI + (size_t)(b * SEQ + t0 + 4 * rt + tq) * 8 + 4 * hh);
#ifndef DUP_IDX
#define DUP_IDX 1
#endif
#ifndef DUP_SEL
#define DUP_SEL 1
#endif
#ifndef DUP_FLASH
#define DUP_FLASH 1
#endif
    __syncthreads();
    for (int rep_ = 0; rep_ < DUP_IDX; ++rep_)
    for (int kt = kp; kt < nkt; kt += 2) {
        const int key = 32 * kt + r32;
        const bf16* kptr = F.KI2 + (size_t)(b * SEQ + key) * 128 + 8 * hh;
        bf16x8 kh[4], kl[4];
#pragma unroll
        for (int d0 = 0; d0 < 4; ++d0) { kh[d0] = *(const bf16x8*)(kptr + 16 * d0); kl[d0] = *(const bf16x8*)(kptr + 64 + 16 * d0); }
        f32x16 acc;
#pragma unroll
        for (int r = 0; r < 16; ++r) acc[r] = 0.f;
#pragma unroll
        for (int d0 = 0; d0 < 4; ++d0) {
            acc = __builtin_amdgcn_mfma_f32_32x32x16_bf16(ql[d0], kh[d0], acc, 0, 0, 0);
            acc = __builtin_amdgcn_mfma_f32_32x32x16_bf16(qh[d0], kl[d0], acc, 0, 0, 0);
            acc = __builtin_amdgcn_mfma_f32_32x32x16_bf16(qh[d0], kh[d0], acc, 0, 0, 0);
        }
        float part[4];
#pragma unroll
        for (int tq = 0; tq < 4; ++tq) { float p = 0.f;
#pragma unroll
            for (int i = 0; i < 4; ++i) p += fmaxf(acc[4 * tq + i], 0.f) * wq[tq][i];
            part[tq] = p + __shfl_xor(p, 32); }
#pragma unroll
        for (int e = 0; e < 2; ++e) { const float v = hh ? part[2 + e] : part[e]; const int ql_ = 4 * rt + 2 * hh + e, t = t0 + ql_;
            SC[ql_ * 2048 + key] = (key <= t) ? fkey(v * IDX_SCALE + 0.0f) : 0u; }
    }
    __syncthreads();
    for (int rep_ = 0; rep_ < DUP_SEL; ++rep_)
#pragma unroll 1
    for (int e = 0; e < 2; ++e) { const int ql_ = 2 * w + e; select_query(SC + ql_ * 2048, t0 + ql_, nkt * 32, BM + (qoff + ql_) * 32, lane); }
}

__device__ __forceinline__ void attn_subunit(Frame& F, int b, int kvh, int t0) {
    const int lane = F.lane, w = F.wave, r32 = lane & 31, hi = lane >> 5, tid = F.tid;
    LAS unsigned char* Kt = F.lds;
    LAS unsigned char* Vt = F.lds + 8192;
    LAS float* rkL = (LAS float*)(F.lds + 16384);
    LAS float* wsf = (LAS float*)(F.lds + 16640) + w * 64;
    const LAS unsigned long long* BM = (const LAS unsigned long long*)(F.lds + BM_OFF);
    const int ntile = (t0 + 64) >> 6;
    const int tl = 8 * w + (r32 >> 2), g = r32 & 3;
    bf16x8 qr[4];
    { const bf16* qp = F.Q + (size_t)(b * SEQ + t0 + tl) * 512 + (4 * kvh + g) * 64 + 8 * hi;
      float qf[32]; float ss = 0.f;
#pragma unroll
      for (int d0 = 0; d0 < 4; ++d0) { const v4u qv = *(const v4u*)(qp + 16 * d0);
          qf[8 * d0 + 0] = bflo(qv.x); qf[8 * d0 + 1] = bfhi(qv.x); qf[8 * d0 + 2] = bflo(qv.y); qf[8 * d0 + 3] = bfhi(qv.y);
          qf[8 * d0 + 4] = bflo(qv.z); qf[8 * d0 + 5] = bfhi(qv.z); qf[8 * d0 + 6] = bflo(qv.w); qf[8 * d0 + 7] = bfhi(qv.w); }
#pragma unroll
      for (int i = 0; i < 32; ++i) ss += qf[i] * qf[i];
      ss += __shfl_xor(ss, 32);
      const float rstd = (1.0f / sqrtf(ss * (1.f / 64.f) + EPS)) * (0.125f * 1.4426950408889634f);
#pragma unroll
      for (int d0 = 0; d0 < 4; ++d0) { float v[8];
#pragma unroll
          for (int j = 0; j < 8; ++j) { const int d = 16 * d0 + 8 * hi + j; v[j] = qf[8 * d0 + j] * rstd * F.q_gain[d] * F.k_gain[d]; }
          v4u pk; pk.x = cvtpk(v[0], v[1]); pk.y = cvtpk(v[2], v[3]); pk.z = cvtpk(v[4], v[5]); pk.w = cvtpk(v[6], v[7]);
          qr[d0] = __builtin_bit_cast(bf16x8, pk); } }
    const int skey = tid >> 3, sc = tid & 7;
    const bf16* kvp = F.KV + (size_t)(b * SEQ + skey) * 256 + kvh * 64 + 8 * sc;
    const int spos = (skey & ~15) + 8 * ((skey >> 2) & 1) + 4 * ((skey >> 3) & 1) + (skey & 3);
    float m = -INFINITY, l = 0.f;
    f32x16 o[2];
#pragma unroll
    for (int r = 0; r < 16; ++r) { o[0][r] = 0.f; o[1][r] = 0.f; }
    v4u kreg = *(const v4u*)(kvp), vreg = *(const v4u*)(kvp + 128);
    for (int tile = 0; tile < ntile; ++tile) {
        __syncthreads();
        { *(LAS v4u*)(Kt + skey * 128 + ((sc ^ (skey & 7)) * 16)) = kreg;
          const float kf[8] = {bflo(kreg.x), bfhi(kreg.x), bflo(kreg.y), bfhi(kreg.y), bflo(kreg.z), bfhi(kreg.z), bflo(kreg.w), bfhi(kreg.w)};
          float ss = 0.f;
#pragma unroll
          for (int j = 0; j < 8; ++j) ss += kf[j] * kf[j];
          ss += __shfl_xor(ss, 1); ss += __shfl_xor(ss, 2); ss += __shfl_xor(ss, 4);
          if (sc == 0) rkL[skey] = 1.0f / sqrtf(ss * (1.f / 64.f) + EPS);
          const unsigned short ve[8] = {(unsigned short)(vreg.x & 0xffffu), (unsigned short)(vreg.x >> 16), (unsigned short)(vreg.y & 0xffffu), (unsigned short)(vreg.y >> 16),
                                        (unsigned short)(vreg.z & 0xffffu), (unsigned short)(vreg.z >> 16), (unsigned short)(vreg.w & 0xffffu), (unsigned short)(vreg.w >> 16)};
#pragma unroll
          for (int e = 0; e < 8; ++e) { const int d = 8 * sc + e; *(LAS unsigned short*)(Vt + d * 128 + (((spos >> 3) ^ (d & 7)) * 16) + (spos & 7) * 2) = ve[e]; } }
        if (tile + 1 < ntile) { const bf16* np = kvp + (size_t)(tile + 1) * 64 * 256; kreg = *(const v4u*)(np); vreg = *(const v4u*)(np + 128); }
        __syncthreads();
        f32x16 p0, p1;
#pragma unroll
        for (int r = 0; r < 16; ++r) { p0[r] = 0.f; p1[r] = 0.f; }
#pragma unroll
        for (int d0 = 0; d0 < 4; ++d0) {
            const bf16x8 a0 = *(const LAS bf16x8*)(Kt + r32 * 128 + (((2 * d0 + hi) ^ (r32 & 7)) * 16));
            const bf16x8 a1 = *(const LAS bf16x8*)(Kt + (32 + r32) * 128 + (((2 * d0 + hi) ^ (r32 & 7)) * 16));
            p0 = __builtin_amdgcn_mfma_f32_32x32x16_bf16(a0, qr[d0], p0, 0, 0, 0);
            p1 = __builtin_amdgcn_mfma_f32_32x32x16_bf16(a1, qr[d0], p1, 0, 0, 0);
        }
        const unsigned long long mw = BM[tl * 32 + tile];
        const unsigned mlo = (unsigned)mw >> (4 * hi), mhi = (unsigned)(mw >> 32) >> (4 * hi);
        float mt = -INFINITY;
#pragma unroll
        for (int q4 = 0; q4 < 4; ++q4) { const f32x4 k0 = *(const LAS f32x4*)(rkL + 8 * q4 + 4 * hi), k1 = *(const LAS f32x4*)(rkL + 32 + 8 * q4 + 4 * hi);
#pragma unroll
            for (int i = 0; i < 4; ++i) { const int r = 4 * q4 + i, cb = 8 * q4 + i;
                p0[r] = ((mlo >> cb) & 1u) ? p0[r] * k0[i] : -INFINITY; p1[r] = ((mhi >> cb) & 1u) ? p1[r] * k1[i] : -INFINITY;
                mt = fmaxf(mt, fmaxf(p0[r], p1[r])); } }
        mt = fmaxf(mt, __shfl_xor(mt, 32));
        const float mn = fmaxf(m, mt), mref = (mn == -INFINITY) ? 0.f : mn;
        const float alpha = __builtin_amdgcn_exp2f(m - mref);
        m = mn;
        float ps = 0.f;
#pragma unroll
        for (int r = 0; r < 16; ++r) { p0[r] = __builtin_amdgcn_exp2f(p0[r] - mref); p1[r] = __builtin_amdgcn_exp2f(p1[r] - mref); ps += p0[r] + p1[r]; }
        l = l * alpha + ps;
        if (!__all(alpha == 1.0f)) {
            if (hi == 0) wsf[r32] = alpha;
            LDS_WAIT(); asm volatile("" ::: "memory");
#pragma unroll
            for (int q4 = 0; q4 < 4; ++q4) { const f32x4 av = *(const LAS f32x4*)(wsf + 8 * q4 + 4 * hi);
#pragma unroll
                for (int i = 0; i < 4; ++i) { o[0][4 * q4 + i] *= av[i]; o[1][4 * q4 + i] *= av[i]; } }
            LDS_WAIT(); asm volatile("" ::: "memory");
        }
        bf16x8 pa[4];
        { v4u t_;
          t_.x = cvtpk(p0[0], p0[1]); t_.y = cvtpk(p0[2], p0[3]); t_.z = cvtpk(p0[4], p0[5]); t_.w = cvtpk(p0[6], p0[7]); pa[0] = __builtin_bit_cast(bf16x8, t_);
          t_.x = cvtpk(p0[8], p0[9]); t_.y = cvtpk(p0[10], p0[11]); t_.z = cvtpk(p0[12], p0[13]); t_.w = cvtpk(p0[14], p0[15]); pa[1] = __builtin_bit_cast(bf16x8, t_);
          t_.x = cvtpk(p1[0], p1[1]); t_.y = cvtpk(p1[2], p1[3]); t_.z = cvtpk(p1[4], p1[5]); t_.w = cvtpk(p1[6], p1[7]); pa[2] = __builtin_bit_cast(bf16x8, t_);
          t_.x = cvtpk(p1[8], p1[9]); t_.y = cvtpk(p1[10], p1[11]); t_.z = cvtpk(p1[12], p1[13]); t_.w = cvtpk(p1[14], p1[15]); pa[3] = __builtin_bit_cast(bf16x8, t_); }
#pragma unroll
        for (int dh = 0; dh < 2; ++dh) { const int d = 32 * dh + r32;
#pragma unroll
            for (int s_ = 0; s_ < 4; ++s_) { const bf16x8 vb = *(const LAS bf16x8*)(Vt + d * 128 + (((2 * s_ + hi) ^ (d & 7)) * 16));
                o[dh] = __builtin_amdgcn_mfma_f32_32x32x16_bf16(pa[s_], vb, o[dh], 0, 0, 0); } }
    }
    l += __shfl_xor(l, 32);
    if (hi == 0) wsf[r32] = 1.0f / l;
    LDS_WAIT(); asm volatile("" ::: "memory");
    float ssq[4];
#pragma unroll
    for (int q4 = 0; q4 < 4; ++q4) { const f32x4 av = *(const LAS f32x4*)(wsf + 8 * q4 + 4 * hi); float s2 = 0.f;
        const size_t row = (size_t)(b * SEQ + t0 + 8 * w + 2 * q4 + hi);
#pragma unroll
        for (int i = 0; i < 4; ++i) { const float v0 = o[0][4 * q4 + i] * av[i], v1 = o[1][4 * q4 + i] * av[i]; s2 += v0 * v0 + v1 * v1;
            bf16* op = F.MIX + row * 1024 + 512 + (4 * kvh + i) * 64 + r32;
            op[0] = (bf16)f2bf(v0); op[32] = (bf16)f2bf(v1); }
        ssq[q4] = s2; }
#pragma unroll
    for (int q4 = 0; q4 < 4; ++q4) { float s2 = ssq[q4];
        s2 += __shfl_xor(s2, 1); s2 += __shfl_xor(s2, 2); s2 += __shfl_xor(s2, 4); s2 += __shfl_xor(s2, 8); s2 += __shfl_xor(s2, 16);
        if (r32 == 0) F.SSQA[(size_t)(b * SEQ + t0 + 8 * w + 2 * q4 + hi) * 2 + kvh] = s2; }
    LDS_WAIT(); asm volatile("" ::: "memory");
}

__device__ __forceinline__ void p3_phase(Frame& F) {
    LAS unsigned char* wl = F.lds + RING_OFF + F.wave * WAVE_LDS;
    const int gw = F.vcu * NWAVES + F.wave, NGW = F.G * NWAVES;
    for (int it = gw; it < 1024; it += NGW) bias2_item(F, it, (LAS float*)wl);
#ifndef DUP_SSM
#define DUP_SSM 1
#endif
#ifndef DUP_ATTN
#define DUP_ATTN 1
#endif
#ifndef NO_SSM
    for (int rep = 0; rep < DUP_SSM; ++rep)
    for (int u = F.vcu; u < NG * 8; u += F.G) ssm_unit(F, u & 31, u >> 5);
#endif
#ifndef NO_ATTN
    for (int rep = 0; rep < DUP_ATTN; ++rep)
    for (int u = F.vcu; u < BATCH * 16; u += F.G) {
        const int b = u >> 4, p = u & 15;
#pragma unroll 1
        for (int side = 0; side < 2; ++side) { const int t0 = 64 * (side ? 31 - p : p);
#pragma unroll 1
            for (int sub = 0; sub < 4; ++sub) idx_subunit(F, b, t0 + 16 * sub, 16 * sub);
#pragma unroll 1
            for (int kvh = 0; kvh < 2 * DUP_FLASH; ++kvh) attn_subunit(F, b, kvh & 1, t0); }
    }
#endif
    __syncthreads();
}

struct Args { const float* in[24]; float* out; unsigned char* ws; int ph_lo, ph_hi, li, pad; };
__global__ void __launch_bounds__(NWAVES * 64, 2) fwd_kernel(Args args) {
    extern __shared__ __attribute__((aligned(16))) unsigned char lds[];
    Frame F;
    F.lds = (LAS unsigned char*)lds;
    F.MISC = (volatile LAS unsigned*)(F.lds + MISC_OFF);
    F.tid = threadIdx.x; F.lane = F.tid & 63; F.wave = __builtin_amdgcn_readfirstlane(F.tid >> 6);
    F.G = gridDim.x; { const int bx = blockIdx.x; F.vcu = (F.G % 8 == 0) ? (bx % 8) * (F.G / 8) + bx / 8 : bx; }
    unsigned char* ws = args.ws;
    F.ctl = (gu32*)(ws + WS_CTL);
    F.x = args.in[0]; F.c = args.in[1]; F.norm1_g = args.in[2]; F.norm2_g = args.in[3]; F.w_ada = args.in[4]; F.b_ada = args.in[5]; F.w_in = args.in[6];
    F.lam_re = args.in[7]; F.lam_im = args.in[8]; F.log_dt = args.in[9]; F.b_re = args.in[10]; F.b_im = args.in[11]; F.c_re = args.in[12]; F.c_im = args.in[13];
    F.d_skip = args.in[14]; F.w_glu = args.in[15]; F.b_glu = args.in[16]; F.q_gain = args.in[17]; F.k_gain = args.in[18]; F.gn_ssm = args.in[19]; F.gn_attn = args.in[20];
    F.w_out = args.in[21]; F.w_ff1 = args.in[22]; F.w_ff2 = args.in[23]; F.out = args.out;
    F.MODP = (float*)(ws + WS_MODP); F.MOD = (float*)(ws + WS_MOD); F.BIAS2 = (float*)(ws + WS_BIAS2); F.SSQS = (float*)(ws + WS_SSQS); F.SSQ2 = (float*)(ws + WS_SSQ2);
    F.KI2 = (bf16*)(ws + WS_KI); F.WI = (float*)(ws + WS_WI); F.QI2 = (bf16*)(ws + WS_QI); F.SSQA = (float*)(ws + WS_SSQA); F.SSMF = (bf16*)(ws + WS_SSMF);
    F.LAMB = (f32x2*)(ws + WS_SSMP); F.BBAR = (f32x2*)(ws + WS_SSMP + 16384);
    F.WINP = (bf16*)(ws + WS_WINP); F.WINI = (bf16*)(ws + WS_WINI); F.WGLU = (bf16*)(ws + WS_WGLU); F.WOUT = (bf16*)(ws + WS_WOUT); F.W1 = (bf16*)(ws + WS_W1); F.W2 = (bf16*)(ws + WS_W2);
    F.U = (bf16*)(ws + WS_U); F.Q = (bf16*)(ws + WS_Q); F.A2 = (bf16*)(ws + WS_A2); F.XN = (bf16*)(ws + WS_XN); F.KV = (bf16*)(ws + WS_KV); F.Z = (bf16*)(ws + WS_Z); F.MIX = (bf16*)(ws + WS_MIX); F.H = (bf16*)(ws + WS_H);
    for (int u = F.tid; u < (LDS_BYTES - LDSCTL_OFF) / 4; u += NWAVES * 64) ((LAS unsigned*)(F.lds + LDSCTL_OFF))[u] = 0u;
    __syncthreads();
    XcdBarrier bar; bar.bar = (unsigned*)(F.ctl + CW_BAR); bar.x = 0; bar.st = nullptr;
    if (N_LAUNCHES == 1) bar = xcd_barrier_post((unsigned*)(F.ctl + CW_BAR), F.MISC + 8);
#define GRID_BAR() do { if (N_LAUNCHES == 1) xcd_barrier(bar); } while (0)
    const int lo = args.ph_lo, hi = args.ph_hi;
#ifndef PHASE_MASK
#define PHASE_MASK 0xFF
#endif
#define IN(k) (((PHASE_MASK >> (k)) & 1) && lo <= (k) && (k) < hi)
#define BOTH(k) (IN(k) && IN((k) + 1))

    if (IN(0)) { p0a_phase(F); if (BOTH(0)) GRID_BAR(); }
    if (IN(1)) { p0b_phase(F); if (BOTH(1)) GRID_BAR(); }
    if (IN(2)) {
        { pg8::Gemm g{F.XN, F.WINP, M, N_PLAIN, 1024, 2048, 1 << 30}; pg8::StaticOrder S; S.init(M, N_PLAIN, F.G, (int)blockIdx.x);
          EpiInPlain E{0, F.U, F.Q, F.KV};
          pg8::gemm_phase<EpiInPlain, pg8::StaticOrder, true>(F.lds + RING_OFF, g, S, E); }
        { pg8::Gemm g{F.XN, F.WINI, M, N_IDX_PAD, K3, 2048, 32}; pg8::StaticOrder S; S.init(M, N_IDX_PAD, F.G, F.G - 1 - (int)blockIdx.x);
          EpiInIdx E{0, F.QI2, F.KI2, F.WI};
          pg8::gemm_phase<EpiInIdx, pg8::StaticOrder, true>(F.lds + RING_OFF, g, S, E); }
        if (BOTH(2)) GRID_BAR();
    }
    if (IN(3)) { p3_phase(F); if (BOTH(3)) GRID_BAR(); }
    if (IN(4)) {
        pg8::Gemm g{F.Z, F.WGLU, M, 512, 512, 512, 1 << 30}; pg8::StaticOrder S; S.init(M, 512, F.G, (int)blockIdx.x);
        EpiGlu E{0, F.Z, F.MIX, F.b_glu, F.SSQS};
        pg8::gemm_phase<EpiGlu, pg8::StaticOrder, true>(F.lds + RING_OFF, g, S, E);
        if (BOTH(4)) GRID_BAR();
    }
    if (IN(5)) {
        pg8::Gemm g{F.MIX, F.WOUT, M, 1024, 1024, 1024, 1 << 30}; pg8::StaticOrder S; S.init(M, 1024, F.G, (int)blockIdx.x);
        EpiOut E{8, F.x, F.out, F.A2, F.MOD, F.norm2_g, F.SSQS, F.SSQ2, F.SSQA};
        pg8::gemm_phase<EpiOut, pg8::StaticOrder, true>(F.lds + RING_OFF, g, S, E);
        if (BOTH(5)) GRID_BAR();
    }
    if (IN(6)) {
        pg8::Gemm g{F.A2, F.W1, M, DFF, 1024, 1024, 1 << 30}; pg8::StaticOrder S; S.init(M, DFF, F.G, (int)blockIdx.x);
        EpiUp E{0, F.SSQ2, F.BIAS2, F.H};
        pg8::gemm_phase<EpiUp, pg8::StaticOrder, true>(F.lds + RING_OFF, g, S, E);
        if (BOTH(6)) GRID_BAR();
    }
    if (IN(7)) {
        pg8::Gemm g{F.H, F.W2, M, 1024, DFF, DFF, 1 << 30}; pg8::StaticOrder S; S.init(M, 1024, F.G, (int)blockIdx.x);
        EpiDown E{0, F.out, F.MOD};
        pg8::gemm_phase<EpiDown, pg8::StaticOrder, true>(F.lds + RING_OFF, g, S, E);
    }
#undef IN
#undef BOTH
}

extern "C" void kernel_launch(void* const* d_in, const int* in_sizes, int n_in, void* d_out, int out_size, void* d_ws, size_t ws_size, hipStream_t stream) {
    static int grid = 0;
    if (grid == 0) {
        if (n_in != 24 || in_sizes[0] != M * DM || out_size != M * DM || ws_size < WS_END) { fprintf(stderr, "kernel_launch: unexpected shapes (n_in %d, in0 %d, out %d, ws %zu); nothing launched\n", n_in, n_in > 0 ? in_sizes[0] : -1, out_size, ws_size); grid = -1; return; }
        int dev = 0, cus = 0, per_cu = 0;
        if (hipGetDevice(&dev) != hipSuccess || hipDeviceGetAttribute(&cus, hipDeviceAttributeMultiprocessorCount, dev) != hipSuccess) { fprintf(stderr, "kernel_launch: device query failed\n"); grid = -1; return; }
        if (hipFuncSetAttribute((const void*)fwd_kernel, hipFuncAttributeMaxDynamicSharedMemorySize, LDS_BYTES) != hipSuccess) { fprintf(stderr, "kernel_launch: hipFuncSetAttribute failed\n"); grid = -1; return; }
        if (hipOccupancyMaxActiveBlocksPerMultiprocessor(&per_cu, (const void*)fwd_kernel, NWAVES * 64, LDS_BYTES) != hipSuccess || per_cu < 1)
            fprintf(stderr, "kernel_launch: note: occupancy query reports %d workgroups per CU\n", per_cu);
        (void)hipGetLastError();
        grid = cus;
    }
    if (grid < 0) return;
    if (hipMemsetAsync((char*)d_ws + WS_CTL, 0, CTL_ZERO_BYTES, stream) != hipSuccess) { fprintf(stderr, "kernel_launch: memset failed\n"); return; }
    Args a{};
    for (int i = 0; i < 24; ++i) a.in[i] = (const float*)d_in[i];
    a.out = (float*)d_out; a.ws = (unsigned char*)d_ws;
    for (int li = 0; li < N_LAUNCHES; ++li) {
        a.ph_lo = (N_LAUNCHES == 1) ? 0 : li; a.ph_hi = (N_LAUNCHES == 1) ? NPHASE : li + 1; a.li = li;
        hipLaunchKernelGGL(fwd_kernel, dim3(grid), dim3(NWAVES * 64), LDS_BYTES, stream, a);
        const hipError_t le = hipPeekAtLastError();
        if (le != hipSuccess) { fprintf(stderr, "kernel_launch: launch %d failed: %s\n", li, hipGetErrorName(le)); break; }
    }
}
```

```cpp
#include <hip/hip_runtime.h>
#include <cstdio>
#include <cstdint>

#ifndef MK_N_LAUNCHES
#define MK_N_LAUNCHES 1
#endif

namespace pg8 {
#define PG8_LAS __attribute__((address_space(3)))
typedef unsigned short bf16_t;
typedef short bf16x8 __attribute__((ext_vector_type(8)));
typedef float f32x4 __attribute__((ext_vector_type(4)));
typedef unsigned u32x4 __attribute__((ext_vector_type(4)));
typedef unsigned u32x2 __attribute__((ext_vector_type(2)));
constexpr int BM = 256, BK = 64, HALF = 128, HTB = HALF * BK * 2, STAGE_BYTES = 8 * HTB, NXCD = 8, WGM = 8;

__host__ __device__ __forceinline__ int lds_byte(int r, int c) { const int st = (r >> 4) * 2 + (c >> 5), rr = r & 15, cc = c & 31, ob = rr * 64 + cc * 2; return st * 1024 + (ob ^ (((ob >> 9) & 1) << 5)); }
__host__ __device__ __forceinline__ void stage_rc(int b, int& R, int& C) { const int st = b / 1024, sb = b % 1024, swz = sb ^ (((sb >> 9) & 1) << 5); R = (st >> 1) * 16 + swz / 64; C = (st & 1) * 32 + (swz % 64) / 2; }
__host__ __device__ __forceinline__ int perm32(int rho) { const int n = rho >> 4, i = rho & 15; return 8 * (i >> 2) + 4 * n + (i & 3); }

struct Unit { int pm, pn; };
struct Gemm { const bf16_t* A; const bf16_t* Bt; int M, N, K, lda, wrapA; };

struct StaticOrder {
    int nM, nN, nwg, G, c;
    __host__ __device__ void init(int M, int N, int G_, int c_) { nM = M / BM; nN = N / BM; nwg = nM * nN; G = G_; c = c_; }
    __host__ __device__ bool next(int i, Unit& u) const {
        const long L = (long)i * G + c; if (L >= nwg) return false;
        int wgid = (int)L; { const int q = nwg / NXCD, r = nwg % NXCD, xcd = wgid % NXCD, off = wgid / NXCD; wgid = (xcd < r ? xcd * (q + 1) : r * (q + 1) + (xcd - r) * q) + off; }
        const int nig = WGM * nN, gid = wgid / nig, fm = gid * WGM, gsz = (nM - fm) < WGM ? (nM - fm) : WGM;
        u.pm = fm + ((wgid % nig) % gsz); u.pn = (wgid % nig) / gsz; return true;
    }
};

__device__ __forceinline__ unsigned cvt_pk_bf16(float lo, float hi) { unsigned r; asm volatile("v_cvt_pk_bf16_f32 %0, %1, %2" : "=v"(r) : "v"(lo), "v"(hi)); return r; }

template <class Epi, class Sched, bool ALIGN_EPI>
__device__ __forceinline__ void gemm_phase(PG8_LAS unsigned char* lds, const Gemm g, const Sched& S, const Epi& E) {
    const int tid = threadIdx.x, wid = __builtin_amdgcn_readfirstlane(tid >> 6), lane = tid & 63, wr = wid >> 2, wc = wid & 3, fr = lane & 15, fq = lane >> 4;
    const int K = g.K, nt = K / BK, lda = g.lda, wrapA = g.wrapA;
    unsigned voffA[2], voffB[2];
#pragma unroll
    for (int i = 0; i < 2; ++i) { int R, C; stage_rc(tid * 16 + i * 8192, R, C); const int Rb = Epi::PERM ? ((R & ~31) + perm32(R & 31)) : R;
        voffA[i] = (unsigned)(R * lda + C) * 2u; voffB[i] = (unsigned)(Rb * K + C) * 2u; }
    const size_t kstep = (size_t)(BK * 2);
    const size_t hsA = (size_t)HALF * lda * 2, hsB = (size_t)HALF * K * 2;
    const size_t tsA = 2 * hsA, tsB = 2 * hsB;
    const unsigned ldsw = (unsigned)wid * 1024u;
    const int aoff = lds_byte(wr * 64 + fr, fq * 8), boff = lds_byte(wc * 32 + fr, fq * 8);
#define PG8_SA(b, h) (((b) * 2 + (h)) * HTB)
#define PG8_SB(b, h) ((4 + (b) * 2 + (h)) * HTB)
#define PG8_STAGE(bufoff, gbase, voff) do { _Pragma("unroll") for (int _i = 0; _i < 2; ++_i) \
        __builtin_amdgcn_global_load_lds((const unsigned*)((const char*)(gbase) + (voff)[_i]), (PG8_LAS unsigned*)(lds + (bufoff) + ldsw + _i * 8192), 16, 0, 0); } while (0)
#define PG8_LDA(dst, b, h) do { _Pragma("unroll") for (int m = 0; m < 4; ++m) _Pragma("unroll") for (int k = 0; k < 2; ++k) dst[m][k] = *(const PG8_LAS bf16x8*)(lds + PG8_SA(b, h) + aoff + m * 2048 + k * 1024); } while (0)
#define PG8_LDB(dst, b, h) do { _Pragma("unroll") for (int n = 0; n < 2; ++n) _Pragma("unroll") for (int k = 0; k < 2; ++k) dst[n][k] = *(const PG8_LAS bf16x8*)(lds + PG8_SB(b, h) + boff + n * 2048 + k * 1024); } while (0)
#define PG8_MMA(ai, bj, At, Bt) do { __builtin_amdgcn_s_setprio(1); _Pragma("unroll") for (int m = 0; m < 4; ++m) _Pragma("unroll") for (int n = 0; n < 2; ++n) _Pragma("unroll") for (int k = 0; k < 2; ++k) \
        acc[ai][bj][m][n] = __builtin_amdgcn_mfma_f32_16x16x32_bf16(Bt[n][k], At[m][k], acc[ai][bj][m][n], 0, 0, 0); __builtin_amdgcn_s_setprio(0); } while (0)
#define PG8_WAIT_V(n) asm volatile("s_waitcnt vmcnt(" #n ")" ::: "memory")
#define PG8_WAIT_L(n) asm volatile("s_waitcnt lgkmcnt(" #n ")" ::: "memory")
#define PG8_BAR __builtin_amdgcn_s_barrier()
#define PG8_SCHED __builtin_amdgcn_sched_barrier(0)
#define PG8_AT(t) ((t) >= wrapA ? (t) - wrapA : (t))
    Unit cur, nxt; int ui = 0;
    if (!S.next(0, cur)) return;
    f32x4 acc[2][2][4][2];
#pragma unroll
    for (int a = 0; a < 2; ++a)
#pragma unroll
        for (int b = 0; b < 2; ++b)
#pragma unroll
            for (int m = 0; m < 4; ++m)
#pragma unroll
                for (int n = 0; n < 2; ++n) acc[a][b][m][n] = (f32x4){0.f, 0.f, 0.f, 0.f};
    bf16x8 At[4][2], B0[2][2], B1[2][2];
    const char* cA = (const char*)g.A + (size_t)cur.pm * tsA; const char* cB = (const char*)g.Bt + (size_t)cur.pn * tsB;
    PG8_STAGE(PG8_SB(0, 0), cB, voffB); PG8_STAGE(PG8_SB(0, 1), cB + hsB, voffB); PG8_STAGE(PG8_SA(0, 0), cA, voffA); PG8_STAGE(PG8_SA(0, 1), cA + hsA, voffA);
    if (wr == 1) PG8_BAR;
    PG8_WAIT_V(2); PG8_BAR;
    PG8_STAGE(PG8_SB(1, 0), cB + kstep, voffB); PG8_STAGE(PG8_SA(1, 0), cA + kstep, voffA); PG8_STAGE(PG8_SB(1, 1), cB + hsB + kstep, voffB);
    PG8_WAIT_V(6); PG8_BAR;
    for (;;) {
        const bool has_next = S.next(ui + 1, nxt);
        const char* nA = has_next ? (const char*)g.A + (size_t)nxt.pm * tsA : cA; const char* nB = has_next ? (const char*)g.Bt + (size_t)nxt.pn * tsB : cB;
        for (int t = 0; t < nt; t += 2) {
            const bool last = (t == nt - 2);
            const char* a1 = cA + (size_t)PG8_AT(t + 1) * kstep;
            const char* a2 = last ? nA : cA + (size_t)PG8_AT(t + 2) * kstep; const char* b2 = last ? nB : cB + (size_t)(t + 2) * kstep;
            const char* a3 = a2 + kstep; const char* b3 = b2 + kstep;
            if constexpr (Epi::MID) { if (t == E.tmid) E.mid(acc, cur, wr, wc, fr, fq); }
            PG8_LDB(B0, 0, 0); PG8_LDB(B1, 0, 1); PG8_SCHED; PG8_LDA(At, 0, 0); PG8_STAGE(PG8_SA(1, 1), a1 + hsA, voffA);
            PG8_WAIT_V(8); PG8_WAIT_L(0); PG8_BAR; PG8_MMA(0, 0, At, B0); PG8_MMA(0, 1, At, B1); PG8_BAR; PG8_SCHED;
            PG8_LDA(At, 0, 1); PG8_STAGE(PG8_SB(0, 0), b2, voffB); PG8_STAGE(PG8_SB(0, 1), b2 + hsB, voffB); PG8_STAGE(PG8_SA(0, 0), a2, voffA);
            PG8_WAIT_V(8); PG8_WAIT_L(0); PG8_BAR; PG8_MMA(1, 0, At, B0); PG8_MMA(1, 1, At, B1); PG8_BAR; PG8_SCHED;
            PG8_LDB(B0, 1, 0); PG8_LDB(B1, 1, 1); PG8_SCHED; PG8_LDA(At, 1, 0); PG8_STAGE(PG8_SA(0, 1), a2 + hsA, voffA);
            PG8_WAIT_V(8); PG8_WAIT_L(0); PG8_BAR; PG8_MMA(0, 0, At, B0); PG8_MMA(0, 1, At, B1); PG8_BAR; PG8_SCHED;
            PG8_LDA(At, 1, 1); PG8_STAGE(PG8_SB(1, 0), b3, voffB); PG8_STAGE(PG8_SB(1, 1), b3 + hsB, voffB); PG8_STAGE(PG8_SA(1, 0), a3, voffA);
            PG8_WAIT_V(8); PG8_WAIT_L(0); PG8_BAR; PG8_MMA(1, 0, At, B0); PG8_MMA(1, 1, At, B1); PG8_BAR; PG8_SCHED;
        }
        if constexpr (ALIGN_EPI) { if (wr == 0) PG8_BAR; }
        E(acc, cur, wr, wc, fr, fq);
        if (!has_next) break;
#pragma unroll
        for (int a = 0; a < 2; ++a)
#pragma unroll
            for (int b = 0; b < 2; ++b)
#pragma unroll
                for (int m = 0; m < 4; ++m)
#pragma unroll
                    for (int n = 0; n < 2; ++n) acc[a][b][m][n] = (f32x4){0.f, 0.f, 0.f, 0.f};
        cur = nxt; cA = nA; cB = nB; ++ui;
        if constexpr (ALIGN_EPI) { if (wr == 1) PG8_BAR; }
    }
    PG8_WAIT_V(0);
    if constexpr (!ALIGN_EPI) { if (wr == 0) PG8_BAR; }
    PG8_BAR;
#undef PG8_SA
#undef PG8_SB
#undef PG8_STAGE
#undef PG8_LDA
#undef PG8_LDB
#undef PG8_MMA
#undef PG8_WAIT_V
#undef PG8_WAIT_L
#undef PG8_BAR
#undef PG8_SCHED
#undef PG8_AT
}
}

constexpr int NWAVES = 8;
constexpr int NPHASE = 8;
constexpr int N_LAUNCHES = MK_N_LAUNCHES;
constexpr int BATCH = 16, SEQ = 2048, DM = 1024, M = BATCH * SEQ;
constexpr int D_SSM = 512, NG = 32, GC = 16, NP = 64, D_ATT = 512, HD = 64, NH = 8, IH = 8, ID = 64, TOPK = 256, DFF = 4096, D_IN = 1864;
constexpr int N_PLAIN = 1280, N_IDX_PAD = 768, K3 = 3072;
constexpr float EPS = 1e-6f;
constexpr float IDX_SCALE = 0.125f * 0.35355339059327373f;

constexpr size_t MiB = 1u << 20;
constexpr size_t WS_CTL = 0, CTL_ZERO_BYTES = 1 * MiB;
constexpr size_t WS_MODP = 1 * MiB;
constexpr size_t WS_MOD = 4 * MiB;
constexpr size_t WS_BIAS2 = 4 * MiB + 512 * 1024;
constexpr size_t WS_SSQS = 5 * MiB;
constexpr size_t WS_SSQ2 = 6 * MiB;
constexpr size_t WS_SSQA = 35 * MiB + 512 * 1024;
constexpr size_t WS_WINP = 8 * MiB;
constexpr size_t WS_WINI = 11 * MiB;
constexpr size_t WS_WGLU = 16 * MiB;
constexpr size_t WS_WOUT = 17 * MiB;
constexpr size_t WS_W1 = 19 * MiB;
constexpr size_t WS_W2 = 27 * MiB;
constexpr size_t WS_SSMP = 35 * MiB;
constexpr size_t WS_U = 36 * MiB;
constexpr size_t WS_Q = 68 * MiB;
constexpr size_t WS_A2 = 36 * MiB;
constexpr size_t WS_XN = 100 * MiB;
constexpr size_t WS_KV = 228 * MiB;
constexpr size_t WS_KI = 244 * MiB;
constexpr size_t WS_WI = 252 * MiB;
constexpr size_t WS_QI = 256 * MiB;
constexpr size_t WS_Z = 320 * MiB;
constexpr size_t WS_MIX = 352 * MiB;
constexpr size_t WS_H = 256 * MiB;
constexpr size_t WS_SSMF = 416 * MiB;
constexpr size_t WS_END = 512 * MiB;
constexpr int CW_BAR = 4096;

constexpr int RING_OFF = 0;
constexpr int WAVE_LDS = 17920;
constexpr int BM_OFF = 131072;
constexpr int XCH_OFF = 147456;
constexpr int LDSCTL_OFF = 155648, MISC_OFF = LDSCTL_OFF + 320;
constexpr int LDS_BYTES = 159744;

#define GAS __attribute__((address_space(1)))
#define LAS __attribute__((address_space(3)))
typedef unsigned short bf16;
typedef unsigned v4u __attribute__((ext_vector_type(4)));
typedef unsigned v2u __attribute__((ext_vector_type(2)));
typedef float f32x4 __attribute__((ext_vector_type(4)));
typedef float f32x2 __attribute__((ext_vector_type(2)));
typedef GAS unsigned gu32;
#define RLX_AGENT __ATOMIC_RELAXED, __HIP_MEMORY_SCOPE_AGENT
#define LDS_WAIT() asm volatile("s_waitcnt lgkmcnt(0)" ::: "memory")
#define VM_WAIT() asm volatile("s_waitcnt vmcnt(0)" ::: "memory")
__device__ __forceinline__ unsigned f2bf(float f) { unsigned u = __builtin_bit_cast(unsigned, f); return (u + 0x7fffu + ((u >> 16) & 1u)) >> 16; }
__device__ __forceinline__ unsigned pk2(float lo, float hi) { return f2bf(lo) | (f2bf(hi) << 16); }
typedef __bf16 bf16x2_t __attribute__((ext_vector_type(2)));
__device__ __forceinline__ unsigned cvtpk(float lo, float hi) { const f32x2 v = {lo, hi}; return __builtin_bit_cast(unsigned, __builtin_convertvector(v, bf16x2_t)); }
__device__ __forceinline__ float bf2f(unsigned h) { return __builtin_bit_cast(float, h << 16); }
__device__ __forceinline__ float bflo(unsigned w) { return __builtin_bit_cast(float, w << 16); }
__device__ __forceinline__ float bfhi(unsigned w) { return __builtin_bit_cast(float, w & 0xffff0000u); }

#define XB_TMO      128
#define XB_XCNT(j)  (256  + 64 * (j))
#define XB_XSUB(j)  (1280 + 64 * (j))
#define XB_XGEN(j)  (2304 + 64 * (j))
#define XB_TOP      3328
#define XB_TOPGEN   3392
#define XCD_BAR_WORDS 3456
#define XB_SPIN_CAP (1u << 18)
__device__ __forceinline__ unsigned xb_ld(unsigned* p)              { return __hip_atomic_load(p, __ATOMIC_RELAXED, __HIP_MEMORY_SCOPE_AGENT); }
__device__ __forceinline__ unsigned xb_add(unsigned* p, unsigned v) { return __hip_atomic_fetch_add(p, v, __ATOMIC_RELAXED, __HIP_MEMORY_SCOPE_AGENT); }
__device__ __forceinline__ unsigned xb_xcc_id() { return (unsigned)__builtin_amdgcn_s_getreg((3 << 11) | 20) & 0xFu; }
#define XB_SPIN(cond, bar) do { unsigned _sp = 0; while (cond) { __builtin_amdgcn_s_sleep(1); \
    if ((++_sp & 255u) == 0u) { if (xb_ld(&(bar)[XB_TMO])) break; if (_sp > XB_SPIN_CAP) { atomicAdd(&(bar)[XB_TMO], 1u); break; } } } } while (0)
struct XcdBarrier { unsigned* bar; unsigned x; volatile LAS unsigned* st; };
__device__ __forceinline__ XcdBarrier xcd_barrier_post(unsigned* bar, volatile LAS unsigned* st) {
    XcdBarrier b; b.bar = bar; b.x = xb_xcc_id(); b.st = st;
    if (threadIdx.x == 0) (void)xb_add(&bar[XB_XCNT(b.x)], 1u);
    return b;
}
__device__ __forceinline__ void xcd_barrier_complete(unsigned* bar, unsigned x, unsigned& nloc, unsigned& nx) {
    const unsigned G = gridDim.x * gridDim.y * gridDim.z;
    unsigned sum, cnt, mine, sp = 0u;
    for (;;) {
        sum = 0u; cnt = 0u; mine = 0u;
#pragma unroll
        for (unsigned j = 0; j < 16; ++j) { const unsigned c = xb_ld(&bar[XB_XCNT(j)]); sum += c; cnt += (c > 0u) ? 1u : 0u; mine = (j == x) ? c : mine; }
        if (sum == G) break;
        __builtin_amdgcn_s_sleep(1);
        if ((++sp & 255u) == 0u) { if (xb_ld(&bar[XB_TMO])) break; if (sp > XB_SPIN_CAP) { atomicAdd(&bar[XB_TMO], 1u); break; } }
    }
    nloc = mine > 0u ? mine : 1u; nx = cnt > 0u ? cnt : 1u;
}
__device__ __forceinline__ void xcd_barrier(const XcdBarrier& b) {
    asm volatile("s_waitcnt vmcnt(0)" ::: "memory");
    __syncthreads();
    if (threadIdx.x == 0) {
        unsigned* bar = b.bar;
        __builtin_amdgcn_s_waitcnt(0);
        unsigned nloc = b.st[0], nx = b.st[1];
        if (nloc == 0u) { xcd_barrier_complete(bar, b.x, nloc, nx); b.st[0] = nloc; b.st[1] = nx; }
        const unsigned old = xb_add(&bar[XB_XSUB(b.x)], 1u);
        const unsigned gen = old / nloc;
        if (old + 1u == (gen + 1u) * nloc) {
            __builtin_amdgcn_fence(__ATOMIC_RELEASE, "agent");
            asm volatile("s_waitcnt vmcnt(0)" ::: "memory");
            const unsigned og = xb_add(&bar[XB_TOP], 1u);
            const unsigned tg = og / nx;
            if (og + 1u == (tg + 1u) * nx) xb_add(&bar[XB_TOPGEN], 1u);
            else XB_SPIN(xb_ld(&bar[XB_TOPGEN]) == tg, bar);
            __builtin_amdgcn_fence(__ATOMIC_ACQUIRE, "agent");
            xb_add(&bar[XB_XGEN(b.x)], 1u);
            asm volatile("s_waitcnt vmcnt(0)" ::: "memory");
        } else {
            XB_SPIN(xb_ld(&bar[XB_XGEN(b.x)]) == gen, bar);
            __builtin_amdgcn_fence(__ATOMIC_ACQUIRE, "agent");
            asm volatile("s_waitcnt vmcnt(0)" ::: "memory");
        }
    }
    __syncthreads();
}

struct Frame {
    LAS unsigned char* lds;
    volatile LAS unsigned* MISC;
    gu32* ctl;
    int tid, lane, wave;
    int vcu, G;
    const float *x, *c, *norm1_g, *norm2_g, *w_ada, *b_ada, *w_in, *lam_re, *lam_im, *log_dt, *b_re, *b_im, *c_re, *c_im, *d_skip, *w_glu, *b_glu, *q_gain, *k_gain, *gn_ssm, *gn_attn, *w_out, *w_ff1, *w_ff2;
    float* out;
    float *MODP, *MOD, *BIAS2, *SSQS, *SSQ2, *SSQA, *WI;
    bf16 *KI2, *QI2, *SSMF;
    f32x2 *LAMB, *BBAR;
    bf16 *WINP, *WINI, *WGLU, *WOUT, *W1, *W2, *U, *Q, *A2, *XN, *KV, *Z, *MIX, *H;
};

__device__ __forceinline__ float wave_sum(float v) {
#pragma unroll
    for (int o = 1; o < 64; o <<= 1) v += __shfl_xor(v, o);
    return v;
}
__device__ __forceinline__ float wave_max(float v) {
#pragma unroll
    for (int o = 1; o < 64; o <<= 1) v = fmaxf(v, __shfl_xor(v, o));
    return v;
}
__device__ __forceinline__ int wave_sum_i(int v) {
#pragma unroll
    for (int o = 1; o < 64; o <<= 1) v += __shfl_xor(v, o);
    return v;
}

__device__ __forceinline__ double exp_d(double x) {
    const double n = __builtin_rint(x * 1.4426950408889634);
    const double r = (x - n * 0.693147180369123816490e+00) - n * 1.90821492927058770002e-10;
    double p = 1.0 / 87178291200.0;
    p = p * r + 1.0 / 6227020800.0; p = p * r + 1.0 / 479001600.0; p = p * r + 1.0 / 39916800.0; p = p * r + 1.0 / 3628800.0; p = p * r + 1.0 / 362880.0;
    p = p * r + 1.0 / 40320.0; p = p * r + 1.0 / 5040.0; p = p * r + 1.0 / 720.0; p = p * r + 1.0 / 120.0; p = p * r + 1.0 / 24.0; p = p * r + 1.0 / 6.0; p = p * r + 0.5; p = p * r + 1.0; p = p * r + 1.0;
    const long long e = (long long)n + 1023;
    return p * __builtin_bit_cast(double, (unsigned long long)e << 52);
}
__device__ __forceinline__ void sincos_d(double x, double& s, double& c) {
    const double n = __builtin_rint(x * 0.63661977236758134308);
    double r = (x - n * 1.57079632673412561417e+00) - n * 6.07710050650619224932e-11;
    r = r - n * 2.02226624879595063154e-21;
    const double r2 = r * r;
    double sp = -1.0 / 1307674368000.0;
    sp = sp * r2 + 1.0 / 6227020800.0; sp = sp * r2 - 1.0 / 39916800.0; sp = sp * r2 + 1.0 / 362880.0; sp = sp * r2 - 1.0 / 5040.0; sp = sp * r2 + 1.0 / 120.0; sp = sp * r2 - 1.0 / 6.0; sp = sp * r2 + 1.0;
    const double sr = sp * r;
    double cp = 1.0 / 20922789888000.0;
    cp = cp * r2 - 1.0 / 87178291200.0; cp = cp * r2 + 1.0 / 479001600.0; cp = cp * r2 - 1.0 / 3628800.0; cp = cp * r2 + 1.0 / 40320.0; cp = cp * r2 - 1.0 / 720.0; cp = cp * r2 + 1.0 / 24.0; cp = cp * r2 - 0.5; cp = cp * r2 + 1.0;
    const long long q = (long long)n & 3;
    s = (q == 0) ? sr : (q == 1) ? cp : (q == 2) ? -sr : -cp;
    c = (q == 0) ? cp : (q == 1) ? -sr : (q == 2) ? -cp : sr;
}

template <int MODE>
__device__ __forceinline__ void p0_transpose_item(Frame& F, const float* W, int K, int N, bf16* WT, LAS float* scr, int item, int lane) {
    const int nblk = (N + 31) / 32, kb = item / nblk, nb = item % nblk, k0 = 64 * kb, n0 = 32 * nb;
#pragma unroll 8
    for (int i = 0; i < 32; ++i) { const int kk = 2 * i + (lane >> 5); const int n = n0 + (lane & 31);
        float v = (MODE != 1 || n < N) ? W[(size_t)(k0 + kk) * N + n] : 0.f;
        if (MODE == 2) { const int k = k0 + kk; v *= (k < D_SSM) ? F.gn_ssm[k] : F.gn_attn[k - D_SSM]; }
        scr[kk * 33 + (lane & 31)] = v; }
    LDS_WAIT(); asm volatile("" ::: "memory");
    const int c = lane & 7;
#pragma unroll
    for (int j = 0; j < 4; ++j) { const int n = (lane >> 3) + 8 * j; const LAS float* s = scr + (8 * c) * 33 + n;
        float v[8];
#pragma unroll
        for (int e = 0; e < 8; ++e) v[e] = s[e * 33];
        v4u o; o.x = pk2(v[0], v[1]); o.y = pk2(v[2], v[3]); o.z = pk2(v[4], v[5]); o.w = pk2(v[6], v[7]);
        if (MODE != 1) { *(GAS v4u*)(WT + (size_t)(n0 + n) * K + k0 + 8 * c) = o; }
        else {
            const int ng = n0 + n;
            if (ng < N_PLAIN) { *(GAS v4u*)(F.WINP + (size_t)ng * 1024 + k0 + 8 * c) = o; }
            else {
                float l[8];
#pragma unroll
                for (int e = 0; e < 8; ++e) l[e] = v[e] - bf2f(f2bf(v[e]));
                v4u ol; ol.x = pk2(l[0], l[1]); ol.y = pk2(l[2], l[3]); ol.z = pk2(l[4], l[5]); ol.w = pk2(l[6], l[7]);
                bf16* d = F.WINI + (size_t)(ng - N_PLAIN) * K3 + k0 + 8 * c;
                *(GAS v4u*)(d) = o; *(GAS v4u*)(d + 1024) = o; *(GAS v4u*)(d + 2048) = ol;
            }
        } }
    LDS_WAIT(); asm volatile("" ::: "memory");
}

__device__ __forceinline__ void p0_mod_item(Frame& F, int item, LAS float* scr) {
    const int cg = item >> 3, ks = item & 7, j = cg * 64 + F.lane, k0 = ks * 128;
    for (int e = F.lane; e < 2048; e += 64) { const int b = e >> 7, i = e & 127; const float cv = F.c[b * 1024 + k0 + i]; scr[e] = cv / (1.f + __expf(-cv)); }
    LDS_WAIT(); asm volatile("" ::: "memory");
    float acc[16];
#pragma unroll
    for (int b = 0; b < 16; ++b) acc[b] = 0.f;
    for (int i4 = 0; i4 < 32; ++i4) {
        const float* wp = F.w_ada + (size_t)(k0 + 4 * i4) * 6144 + j;
        const float w0 = wp[0], w1 = wp[6144], w2 = wp[2 * 6144], w3 = wp[3 * 6144];
#pragma unroll
        for (int b = 0; b < 16; ++b) { const f32x4 s = *(const LAS f32x4*)(scr + b * 128 + 4 * i4); acc[b] += s.x * w0 + s.y * w1 + s.z * w2 + s.w * w3; }
    }
#pragma unroll
    for (int b = 0; b < 16; ++b) F.MODP[(size_t)(ks * 16 + b) * 6144 + j] = acc[b];
    LDS_WAIT(); asm volatile("" ::: "memory");
}

__device__ __forceinline__ void p0_ssm_item(Frame& F, int g) {
    const int p = F.lane, gp = g * 64 + p;
    const double lre = (double)F.lam_re[gp], lim = (double)F.lam_im[gp], dt = exp_d((double)F.log_dt[g]);
    double s, c; sincos_d(lim * dt, s, c);
    const double mag = exp_d(lre * dt), lbr = mag * c, lbi = mag * s;
    const double a = lbr - 1.0, b = lbi, den = lre * lre + lim * lim;
    const double cr = (a * lre + b * lim) / den, ci = (b * lre - a * lim) / den;
    F.LAMB[gp] = (f32x2){(float)lbr, (float)lbi};
#pragma unroll
    for (int cc = 0; cc < 16; ++cc) { const double br = (double)F.b_re[gp * 16 + cc], bi = (double)F.b_im[gp * 16 + cc];
        F.BBAR[gp * 16 + cc] = (f32x2){(float)(cr * br - ci * bi), (float)(cr * bi + ci * br)}; }
}

__device__ __forceinline__ void p0a_phase(Frame& F) {
    LAS float* scr = (LAS float*)(F.lds + RING_OFF + F.wave * WAVE_LDS);
    const int gw = F.vcu * NWAVES + F.wave, NGW = F.G * NWAVES;
    constexpr int I_MOD = 96 * 8, I_SSM = 32;
    constexpr int I_IN = 16 * 59, I_GLU = 8 * 16, I_OUT = 16 * 32, I_1 = 16 * 128, I_2 = 64 * 32;
    constexpr int NITEMS = I_MOD + I_SSM + I_IN + I_GLU + I_OUT + I_1 + I_2;
    for (int it = gw; it < NITEMS; it += NGW) {
        int r = it;
        if (r < I_MOD) { p0_mod_item(F, r, scr); continue; } r -= I_MOD;
        if (r < I_SSM) { p0_ssm_item(F, r); continue; } r -= I_SSM;
        if (r < I_IN) { p0_transpose_item<1>(F, F.w_in, 1024, D_IN, nullptr, scr, r, F.lane); continue; } r -= I_IN;
        if (r < I_GLU) { p0_transpose_item<0>(F, F.w_glu, 512, 512, F.WGLU, scr, r, F.lane); continue; } r -= I_GLU;
        if (r < I_OUT) { p0_transpose_item<2>(F, F.w_out, 1024, 1024, F.WOUT, scr, r, F.lane); continue; } r -= I_OUT;
        if (r < I_1) { p0_transpose_item<0>(F, F.w_ff1, 1024, DFF, F.W1, scr, r, F.lane); continue; } r -= I_1;
        p0_transpose_item<0>(F, F.w_ff2, DFF, 1024, F.W2, scr, r, F.lane);
    }
    { const int gt = (F.vcu * NWAVES + F.wave) * 64 + F.lane, NT = F.G * NWAVES * 64; GAS v4u* z = (GAS v4u*)(F.WINI + (size_t)608 * K3);
      for (int i = gt; i < 160 * K3 / 8; i += NT) z[i] = (v4u){0u, 0u, 0u, 0u}; }
}

__device__ __forceinline__ f32x2 cmul(f32x2 a, f32x2 b) { return (f32x2){a.x * b.x - a.y * b.y, a.x * b.y + a.y * b.x}; }
__device__ __forceinline__ f32x2 cpow(f32x2 a, int e) { f32x2 r = {1.f, 0.f}; f32x2 bq = a;
#pragma unroll
    for (int k = 0; k < 5; ++k) { if (e & (1 << k)) r = cmul(r, bq); bq = cmul(bq, bq); }
    return r; }
__device__ __forceinline__ void ssm_frag_item(Frame& F, int item) {
    const int g = item / 144, bi = item % 144, lane = F.lane, il = lane & 15, kq = lane >> 4;
    float v[8];
#pragma unroll
    for (int j = 0; j < 8; ++j) v[j] = 0.f;
    if (bi < 16) {
        const int d = bi - (kq >> 1);
        if (d >= 0) {
            for (int p = 0; p < 64; ++p) {
                const f32x2 pw = cpow(F.LAMB[g * 64 + p], d);
                const f32x2 cw = cmul((f32x2){F.c_re[(g * 16 + il) * 64 + p], F.c_im[(g * 16 + il) * 64 + p]}, pw);
                const f32x2* bb = F.BBAR + (g * 64 + p) * 16 + 8 * (kq & 1);
#pragma unroll
                for (int j = 0; j < 8; ++j) { const f32x2 bv = bb[j]; v[j] += cw.x * bv.x - cw.y * bv.y; }
            }
        }
    } else if (bi < 80) {
        const int e = bi - 16, i = e >> 3, kb = e & 7, R = 16 * i + il, p = R & 63, s_ = 2 * kb + (kq >> 1);
        const f32x2 pw = cpow(F.LAMB[g * 64 + p], 15 - s_);
        const f32x2* bb = F.BBAR + (g * 64 + p) * 16 + 8 * (kq & 1);
#pragma unroll
        for (int j = 0; j < 8; ++j) { const f32x2 wv = cmul(pw, bb[j]); v[j] = (R >= 64) ? wv.y : wv.x; }
    } else {
        const int e = bi - 80, t = e >> 2, ks = e & 3;
#pragma unroll
        for (int j = 0; j < 8; ++j) { const int sg = 16 * (2 * ks + (j >> 2)) + 4 * kq + (j & 3), p = sg & 63;
            const f32x2 pw = cpow(F.LAMB[g * 64 + p], t + 1);
            const f32x2 cw = cmul((f32x2){F.c_re[(g * 16 + il) * 64 + p], F.c_im[(g * 16 + il) * 64 + p]}, pw);
            v[j] = (sg >= 64) ? -cw.y : cw.x; }
    }
    v4u o; o.x = pk2(v[0], v[1]); o.y = pk2(v[2], v[3]); o.z = pk2(v[4], v[5]); o.w = pk2(v[6], v[7]);
    *(GAS v4u*)(F.SSMF + (size_t)item * 512 + lane * 8) = o;
}

__device__ __forceinline__ void p0b_phase(Frame& F) {
    const int w = F.vcu;
    { const int idx = w * 384 + F.tid;
      if (F.tid < 384 && idx < 16 * 6144) { const int j = idx % 6144; float s = F.b_ada[j];
#pragma unroll
          for (int ks = 0; ks < 8; ++ks) s += F.MODP[(size_t)ks * 16 * 6144 + idx];
          F.MOD[idx] = s; } }
    for (int it = F.vcu * NWAVES + F.wave; it < NG * 144; it += F.G * NWAVES) ssm_frag_item(F, it);
    LAS float* sh = (LAS float*)(F.lds + RING_OFF);
    for (int rb = w; rb < M / 128; rb += F.G) {
        const int b = rb / 16;
        __syncthreads();
        for (int e = F.tid; e < 2048; e += NWAVES * 64) { float s = F.b_ada[e];
#pragma unroll
            for (int ks = 0; ks < 8; ++ks) s += F.MODP[(size_t)(ks * 16 + b) * 6144 + e];
            sh[e] = s; }
        __syncthreads();
        for (int r4 = 0; r4 < 16; r4 += 4) {
            f32x4 v[4][4];
#pragma unroll
            for (int q = 0; q < 4; ++q) { const GAS f32x4* xr = (const GAS f32x4*)(F.x + ((size_t)rb * 128 + F.wave * 16 + r4 + q) * DM) + F.lane;
#pragma unroll
                for (int j = 0; j < 4; ++j) v[q][j] = xr[64 * j]; }
#pragma unroll
            for (int q = 0; q < 4; ++q) {
                const size_t m = (size_t)rb * 128 + F.wave * 16 + r4 + q; float ss = 0.f;
#pragma unroll
                for (int j = 0; j < 4; ++j) ss += (v[q][j].x * v[q][j].x + v[q][j].y * v[q][j].y) + (v[q][j].z * v[q][j].z + v[q][j].w * v[q][j].w);
                const float rstd = 1.0f / sqrtf(wave_sum(ss) * (1.f / DM) + EPS);
                GAS v2u* oh = (GAS v2u*)(F.XN + m * 2048) + F.lane;
#pragma unroll
                for (int j = 0; j < 4; ++j) { const int col = 4 * F.lane + 256 * j;
                    const f32x4 g = *(const f32x4*)(F.norm1_g + col); const f32x4 s1 = *(const LAS f32x4*)(sh + col); const f32x4 c1 = *(const LAS f32x4*)(sh + 1024 + col);
                    f32x4 h = v[q][j] * rstd * g * (c1 + 1.0f) + s1;
                    float hh_[4] = {h.x, h.y, h.z, h.w}, hl[4];
#pragma unroll
                    for (int e = 0; e < 4; ++e) hl[e] = hh_[e] - bf2f(f2bf(hh_[e]));
                    oh[64 * j] = (v2u){pk2(hh_[0], hh_[1]), pk2(hh_[2], hh_[3])};
                    oh[256 + 64 * j] = (v2u){pk2(hl[0], hl[1]), pk2(hl[2], hl[3])}; }
            }
        }
    }
}

using pg8::Unit; using pg8::cvt_pk_bf16;
struct EpiInPlain {
    static constexpr bool PERM = true, MID = false; int tmid;
    bf16 *U, *Q, *KV;
    __device__ __forceinline__ void mid(f32x4 (&)[2][2][4][2], const Unit&, int, int, int, int) const {}
    __device__ __forceinline__ void operator()(const f32x4 (&acc)[2][2][4][2], const Unit& u, int wr, int wc, int fr, int fq) const {
        bf16* base; int ldc, colt;
        if (u.pn < 2) { base = U; ldc = 512; colt = u.pn * 256; } else if (u.pn < 4) { base = Q; ldc = 512; colt = (u.pn - 2) * 256; } else { base = KV; ldc = 256; colt = 0; }
        const int row0 = u.pm * 256 + wr * 64 + fr, col0 = colt + wc * 32 + 8 * fq;
#pragma unroll
        for (int ai = 0; ai < 2; ++ai)
#pragma unroll
            for (int m = 0; m < 4; ++m) { bf16* rowp = base + (size_t)(row0 + ai * 128 + m * 16) * ldc + col0;
#pragma unroll
                for (int bj = 0; bj < 2; ++bj) { const f32x4 v0 = acc[ai][bj][m][0], v1 = acc[ai][bj][m][1];
                    v4u wv; wv.x = cvt_pk_bf16(v0[0], v0[1]); wv.y = cvt_pk_bf16(v0[2], v0[3]); wv.z = cvt_pk_bf16(v1[0], v1[1]); wv.w = cvt_pk_bf16(v1[2], v1[3]);
                    *(v4u*)(rowp + bj * 128) = wv; } }
    }
};
struct EpiInIdx {
    static constexpr bool PERM = false, MID = false; int tmid;
    bf16 *QI2, *KI2; float* WI;
    __device__ __forceinline__ void mid(f32x4 (&)[2][2][4][2], const Unit&, int, int, int, int) const {}
    __device__ __forceinline__ static void st_hilo(bf16* hp, bf16* lp, const f32x4 v) {
        const float l0 = v[0] - bf2f(f2bf(v[0])), l1 = v[1] - bf2f(f2bf(v[1])), l2 = v[2] - bf2f(f2bf(v[2])), l3 = v[3] - bf2f(f2bf(v[3]));
        *(v2u*)hp = (v2u){pk2(v[0], v[1]), pk2(v[2], v[3])}; *(v2u*)lp = (v2u){pk2(l0, l1), pk2(l2, l3)};
    }
    __device__ __forceinline__ void operator()(const f32x4 (&acc)[2][2][4][2], const Unit& u, int wr, int wc, int fr, int fq) const {
        const int row0 = u.pm * 256 + wr * 64 + fr;
        if (u.pn < 2) {
            const int col0 = u.pn * 256 + wc * 32 + 4 * fq;
#pragma unroll
            for (int ai = 0; ai < 2; ++ai)
#pragma unroll
                for (int m = 0; m < 4; ++m) { bf16* rowp = QI2 + (size_t)(row0 + ai * 128 + m * 16) * 1024 + col0;
#pragma unroll
                    for (int bj = 0; bj < 2; ++bj)
#pragma unroll
                        for (int n = 0; n < 2; ++n) st_hilo(rowp + bj * 128 + n * 16, rowp + 512 + bj * 128 + n * 16, acc[ai][bj][m][n]); }
        } else {
#pragma unroll
            for (int ai = 0; ai < 2; ++ai)
#pragma unroll
                for (int m = 0; m < 4; ++m) { const size_t row = (size_t)(row0 + ai * 128 + m * 16);
#pragma unroll
                    for (int n = 0; n < 2; ++n) { const int col = wc * 32 + 16 * n + 4 * fq;
                        if (col < 64) st_hilo(KI2 + row * 128 + col, KI2 + row * 128 + 64 + col, acc[ai][0][m][n]);
                        else if (col < 72) *(f32x4*)(WI + row * 8 + (col - 64)) = acc[ai][0][m][n]; } }
        }
    }
};
struct EpiGlu {
    static constexpr bool PERM = true, MID = false; int tmid;
    const bf16* Z; bf16* MIX; const float* bglu; float* SSQS;
    __device__ __forceinline__ void mid(f32x4 (&)[2][2][4][2], const Unit&, int, int, int, int) const {}
    __device__ __forceinline__ void operator()(const f32x4 (&acc)[2][2][4][2], const Unit& u, int wr, int wc, int fr, int fq) const {
        const int row0 = u.pm * 256 + wr * 64 + fr, col0 = u.pn * 256 + wc * 32 + 8 * fq;
#pragma unroll
        for (int ai = 0; ai < 2; ++ai)
#pragma unroll
            for (int m = 0; m < 4; ++m) { const size_t row = (size_t)(row0 + ai * 128 + m * 16); float ss = 0.f;
#pragma unroll
                for (int bj = 0; bj < 2; ++bj) { const int col = col0 + bj * 128;
                    const v4u zz = *(const v4u*)(Z + row * 512 + col);
                    const f32x4 b0 = *(const f32x4*)(bglu + col), b1 = *(const f32x4*)(bglu + col + 4);
                    const f32x4 a0 = acc[ai][bj][m][0] + b0, a1 = acc[ai][bj][m][1] + b1;
                    float zf[8] = {bflo(zz.x), bfhi(zz.x), bflo(zz.y), bfhi(zz.y), bflo(zz.z), bfhi(zz.z), bflo(zz.w), bfhi(zz.w)};
                    float av[8] = {a0[0], a0[1], a0[2], a0[3], a1[0], a1[1], a1[2], a1[3]}, y[8];
#pragma unroll
                    for (int e = 0; e < 8; ++e) { y[e] = zf[e] / (1.f + __expf(-av[e])); ss += y[e] * y[e]; }
                    v4u wv; wv.x = cvt_pk_bf16(y[0], y[1]); wv.y = cvt_pk_bf16(y[2], y[3]); wv.z = cvt_pk_bf16(y[4], y[5]); wv.w = cvt_pk_bf16(y[6], y[7]);
                    *(v4u*)(MIX + row * 1024 + col) = wv; }
                ss += __shfl_xor(ss, 16); ss += __shfl_xor(ss, 32);
                if (fq == 0) SSQS[row * 8 + u.pn * 4 + wc] = ss; }
    }
};
struct EpiOut {
    static constexpr bool PERM = true, MID = true; int tmid;
    const float* x; float* x1; bf16* A2; const float* MOD; const float* g2n; const float* SSQS; float* SSQ2; const float* SSQA;
    __device__ __forceinline__ void mid(f32x4 (&acc)[2][2][4][2], const Unit& u, int wr, int wc, int fr_, int fq_) const {
        int fr = fr_, fq = fq_; asm volatile("" : "+v"(fr), "+v"(fq));
#pragma unroll
        for (int ai = 0; ai < 2; ++ai)
#pragma unroll
            for (int m = 0; m < 4; ++m) { const size_t row = (size_t)(u.pm * 256 + ai * 128 + wr * 64 + m * 16 + fr);
                const f32x4 p = *(const f32x4*)(SSQS + row * 8 + 4 * (fq & 1)); float s = (p.x + p.y) + (p.z + p.w); s += __shfl_xor(s, 16);
                const f32x2 sa = *(const f32x2*)(SSQA + row * 2);
                const float rstd = sqrtf((sa.x + sa.y) * (1.f / 512.f) + EPS) / sqrtf(s * (1.f / 512.f) + EPS);
#pragma unroll
                for (int bj = 0; bj < 2; ++bj)
#pragma unroll
                    for (int n = 0; n < 2; ++n) acc[ai][bj][m][n] *= rstd; }
    }
    __device__ __forceinline__ void operator()(const f32x4 (&acc)[2][2][4][2], const Unit& u, int wr, int wc, int fr, int fq) const {
        const int b = u.pm >> 3; const float* mod = MOD + (size_t)b * 6144;
        const int row0 = u.pm * 256 + wr * 64 + fr, col0 = u.pn * 256 + wc * 32 + 8 * fq;
#pragma unroll
        for (int ai = 0; ai < 2; ++ai)
#pragma unroll
            for (int m = 0; m < 4; ++m) { const size_t row = (size_t)(row0 + ai * 128 + m * 16); float ss = 0.f;
                const f32x2 sa = *(const f32x2*)(SSQA + row * 2); const float ra = 1.0f / sqrtf((sa.x + sa.y) * (1.f / 512.f) + EPS);
#pragma unroll
                for (int bj = 0; bj < 2; ++bj) { const int col = col0 + bj * 128; float a2[8];
#pragma unroll
                    for (int n = 0; n < 2; ++n) { const int c4 = col + 4 * n;
                        const f32x4 xv = *(const f32x4*)(x + row * 1024 + c4); const f32x4 g1 = *(const f32x4*)(mod + 2048 + c4);
                        const f32x4 v = xv + g1 * (acc[ai][bj][m][n] * ra);
                        *(f32x4*)(x1 + row * 1024 + c4) = v; ss += (v.x * v.x + v.y * v.y) + (v.z * v.z + v.w * v.w);
                        const f32x4 sc2 = *(const f32x4*)(mod + 4096 + c4); const f32x4 gg = *(const f32x4*)(g2n + c4);
                        const f32x4 a = v * gg * (sc2 + 1.0f); a2[4 * n] = a.x; a2[4 * n + 1] = a.y; a2[4 * n + 2] = a.z; a2[4 * n + 3] = a.w; }
                    v4u wv; wv.x = cvt_pk_bf16(a2[0], a2[1]); wv.y = cvt_pk_bf16(a2[2], a2[3]); wv.z = cvt_pk_bf16(a2[4], a2[5]); wv.w = cvt_pk_bf16(a2[6], a2[7]);
                    *(v4u*)(A2 + row * 1024 + col) = wv; }
                ss += __shfl_xor(ss, 16); ss += __shfl_xor(ss, 32);
                if (fq == 0) SSQ2[row * 16 + u.pn * 4 + wc] = ss;
                asm volatile("" ::: "memory"); }
    }
};
struct EpiUp {
    static constexpr bool PERM = true, MID = false; int tmid;
    const float* SSQ2; const float* BIAS2; bf16* H;
    __device__ __forceinline__ void mid(f32x4 (&)[2][2][4][2], const Unit&, int, int, int, int) const {}
    __device__ __forceinline__ void operator()(const f32x4 (&acc)[2][2][4][2], const Unit& u, int wr, int wc, int fr, int fq) const {
        const int b = u.pm >> 3; const float* bias = BIAS2 + (size_t)b * DFF;
        const int row0 = u.pm * 256 + wr * 64 + fr, col0 = u.pn * 256 + wc * 32 + 8 * fq;
        f32x4 bv[2][2];
#pragma unroll
        for (int bj = 0; bj < 2; ++bj)
#pragma unroll
            for (int n = 0; n < 2; ++n) bv[bj][n] = *(const f32x4*)(bias + col0 + bj * 128 + 4 * n);
#pragma unroll
        for (int ai = 0; ai < 2; ++ai)
#pragma unroll
            for (int m = 0; m < 4; ++m) { const size_t row = (size_t)(row0 + ai * 128 + m * 16);
                const f32x4 p = *(const f32x4*)(SSQ2 + row * 16 + 4 * fq); float s = (p.x + p.y) + (p.z + p.w); s += __shfl_xor(s, 16); s += __shfl_xor(s, 32);
                const float rstd = 1.0f / sqrtf(s * (1.f / 1024.f) + EPS);
#pragma unroll
                for (int bj = 0; bj < 2; ++bj) { f32x4 v0 = acc[ai][bj][m][0] * rstd + bv[bj][0], v1 = acc[ai][bj][m][1] * rstd + bv[bj][1];
                    float h[8] = {v0[0], v0[1], v0[2], v0[3], v1[0], v1[1], v1[2], v1[3]};
#pragma unroll
                    for (int e = 0; e < 8; ++e) { const float r = fmaxf(h[e], 0.f); h[e] = r * r; }
                    v4u wv; wv.x = cvt_pk_bf16(h[0], h[1]); wv.y = cvt_pk_bf16(h[2], h[3]); wv.z = cvt_pk_bf16(h[4], h[5]); wv.w = cvt_pk_bf16(h[6], h[7]);
                    *(v4u*)(H + row * DFF + col0 + bj * 128) = wv; } }
    }
};
struct EpiDown {
    static constexpr bool PERM = false, MID = false; int tmid;
    float* out; const float* MOD;
    __device__ __forceinline__ void mid(f32x4 (&)[2][2][4][2], const Unit&, int, int, int, int) const {}
    __device__ __forceinline__ void operator()(const f32x4 (&acc)[2][2][4][2], const Unit& u, int wr, int wc, int fr, int fq) const {
        const int b = u.pm >> 3; const float* g2 = MOD + (size_t)b * 6144 + 5120;
        const int row0 = u.pm * 256 + wr * 64 + fr, col0 = u.pn * 256 + wc * 32 + 4 * fq;
        f32x4 gv[2][2];
#pragma unroll
        for (int bj = 0; bj < 2; ++bj)
#pragma unroll
            for (int n = 0; n < 2; ++n) gv[bj][n] = *(const f32x4*)(g2 + col0 + bj * 128 + n * 16);
#pragma unroll
        for (int ai = 0; ai < 2; ++ai)
#pragma unroll
            for (int m = 0; m < 4; ++m) { float* rowp = out + (size_t)(row0 + ai * 128 + m * 16) * 1024 + col0;
#pragma unroll
                for (int bj = 0; bj < 2; ++bj)
#pragma unroll
                    for (int n = 0; n < 2; ++n) { const f32x4 x1 = *(const f32x4*)(rowp + bj * 128 + n * 16); *(f32x4*)(rowp + bj * 128 + n * 16) = x1 + gv[bj][n] * acc[ai][bj][m][n]; } }
    }
};

__device__ __forceinline__ float gelu_tanh(float v) {
    const float a = 0.7978845608028654f * (v + 0.044715f * v * v * v);
    const float th = 1.f - 2.f / (__expf(2.f * a) + 1.f);
    return 0.5f * v * (1.f + th);
}
__device__ __forceinline__ void bias2_item(Frame& F, int item, LAS float* scr) {
    const int b = item >> 6, n = (item & 63) * 64 + F.lane;
    for (int e = F.lane; e < 1024; e += 64) scr[e] = F.MOD[(size_t)b * 6144 + 3072 + e];
    LDS_WAIT(); asm volatile("" ::: "memory");
    float acc = 0.f;
#pragma unroll 8
    for (int k = 0; k < 1024; ++k) acc += scr[k] * F.w_ff1[(size_t)k * DFF + n];
    F.BIAS2[(size_t)b * DFF + n] = acc;
    LDS_WAIT(); asm volatile("" ::: "memory");
}
typedef short bf16x8s __attribute__((ext_vector_type(8)));
__device__ __forceinline__ void ssm_unit(Frame& F, int g, int bp) {
    const int lane = F.lane, w = F.wave, n = lane & 15, rq = lane >> 4, tid = F.tid;
    LAS unsigned char* L = F.lds;
    __syncthreads();
    { const GAS v4u* src = (const GAS v4u*)(F.SSMF + (size_t)g * 144 * 512); LAS v4u* dst = (LAS v4u*)L;
      for (int i = tid; i < 144 * 64; i += NWAVES * 64) dst[i] = src[i]; }
    float dsk[4];
#pragma unroll
    for (int r = 0; r < 4; ++r) dsk[r] = F.d_skip[g * 16 + 4 * rq + r];
    __syncthreads();
#define SSM_A(blk) (*(const LAS bf16x8s*)(L + (blk) * 1024 + lane * 16))
#define SSM_A16(gg, i, r) ({ f32x2 q_ = F.LAMB[(gg) * 64 + 16 * (i) + 4 * rq + (r)]; q_ = cmul(q_, q_); q_ = cmul(q_, q_); q_ = cmul(q_, q_); cmul(q_, q_); })
#pragma unroll 1
    for (int bb = 0; bb < 2; ++bb) {
        const int b = 2 * bp + bb;
        int gop = g; asm volatile("" : "+s"(gop));
        LAS float* XCH = (LAS float*)(F.lds + XCH_OFF) + bb * 1024;
        const size_t tok0 = (size_t)b * SEQ + (size_t)(16 * w + n) * 16;
        float Sre[4][4], Sim[4][4];
        { bf16x8s Uf1[8];
#pragma unroll
          for (int kb = 0; kb < 8; ++kb) Uf1[kb] = *(const bf16x8s*)(F.U + (tok0 + 2 * kb + (rq >> 1)) * 512 + gop * 16 + 8 * (rq & 1));
#pragma unroll
          for (int i = 0; i < 8; ++i) { f32x4 d = {0.f, 0.f, 0.f, 0.f};
#pragma unroll
              for (int kb = 0; kb < 8; ++kb) d = __builtin_amdgcn_mfma_f32_16x16x32_bf16(SSM_A(16 + i * 8 + kb), Uf1[kb], d, 0, 0, 0);
#pragma unroll
              for (int r = 0; r < 4; ++r) { if (i < 4) Sre[i][r] = d[r]; else Sim[i - 4][r] = d[r]; }
              asm volatile("" ::: "memory"); } }
#pragma unroll
        for (int i = 0; i < 4; ++i)
#pragma unroll
            for (int r = 0; r < 4; ++r) { f32x2 ak = SSM_A16(gop, i, r);
#pragma unroll
                for (int k = 1; k < 16; k <<= 1) { float ur = __shfl_up(Sre[i][r], k, 16), ui = __shfl_up(Sim[i][r], k, 16); if (n < k) { ur = 0.f; ui = 0.f; }
                    Sre[i][r] += ak.x * ur - ak.y * ui; Sim[i][r] += ak.x * ui + ak.y * ur; ak = cmul(ak, ak); } }
        if (n == 15) {
#pragma unroll
            for (int i = 0; i < 4; ++i)
#pragma unroll
                for (int r = 0; r < 4; ++r) { const int p = 16 * i + 4 * rq + r; XCH[w * 128 + p] = Sre[i][r]; XCH[w * 128 + 64 + p] = Sim[i][r]; } }
        __syncthreads();
        int gop2 = gop; asm volatile("" : "+s"(gop2));
        bf16x8s Xfr[4];
        { float Cre[4][4], Cim[4][4]; f32x2 aw[4][4];
#pragma unroll
          for (int i = 0; i < 4; ++i)
#pragma unroll
              for (int r = 0; r < 4; ++r) { Cre[i][r] = 0.f; Cim[i][r] = 0.f; f32x2 q = SSM_A16(gop2, i, r); q = cmul(q, q); q = cmul(q, q); q = cmul(q, q); aw[i][r] = cmul(q, q); }
#pragma unroll 1
          for (int v = 0; v < w; ++v) {
#pragma unroll
              for (int i = 0; i < 4; ++i)
#pragma unroll
                  for (int r = 0; r < 4; ++r) { const int p = 16 * i + 4 * rq + r; const float tr = XCH[v * 128 + p], ti = XCH[v * 128 + 64 + p];
                      const float nr = aw[i][r].x * Cre[i][r] - aw[i][r].y * Cim[i][r] + tr, ni = aw[i][r].x * Cim[i][r] + aw[i][r].y * Cre[i][r] + ti; Cre[i][r] = nr; Cim[i][r] = ni; } }
          int gop3 = gop2; asm volatile("" : "+s"(gop3));
#pragma unroll
          for (int i = 0; i < 4; ++i)
#pragma unroll
              for (int r = 0; r < 4; ++r) { const f32x2 pn = cpow(SSM_A16(gop3, i, r), n);
                  float ur = __shfl_up(Sre[i][r], 1, 16), ui = __shfl_up(Sim[i][r], 1, 16); if (n == 0) { ur = 0.f; ui = 0.f; }
                  Sre[i][r] = ur + pn.x * Cre[i][r] - pn.y * Cim[i][r]; Sim[i][r] = ui + pn.x * Cim[i][r] + pn.y * Cre[i][r]; }
          v4u t_;
          t_.x = cvtpk(Sre[0][0], Sre[0][1]); t_.y = cvtpk(Sre[0][2], Sre[0][3]); t_.z = cvtpk(Sre[1][0], Sre[1][1]); t_.w = cvtpk(Sre[1][2], Sre[1][3]); Xfr[0] = __builtin_bit_cast(bf16x8s, t_);
          t_.x = cvtpk(Sre[2][0], Sre[2][1]); t_.y = cvtpk(Sre[2][2], Sre[2][3]); t_.z = cvtpk(Sre[3][0], Sre[3][1]); t_.w = cvtpk(Sre[3][2], Sre[3][3]); Xfr[1] = __builtin_bit_cast(bf16x8s, t_);
          t_.x = cvtpk(Sim[0][0], Sim[0][1]); t_.y = cvtpk(Sim[0][2], Sim[0][3]); t_.z = cvtpk(Sim[1][0], Sim[1][1]); t_.w = cvtpk(Sim[1][2], Sim[1][3]); Xfr[2] = __builtin_bit_cast(bf16x8s, t_);
          t_.x = cvtpk(Sim[2][0], Sim[2][1]); t_.y = cvtpk(Sim[2][2], Sim[2][3]); t_.z = cvtpk(Sim[3][0], Sim[3][1]); t_.w = cvtpk(Sim[3][2], Sim[3][3]); Xfr[3] = __builtin_bit_cast(bf16x8s, t_); }
        int gop4 = gop2; asm volatile("" : "+s"(gop4) : "v"(Xfr[0]), "v"(Xfr[1]), "v"(Xfr[2]), "v"(Xfr[3]) : "memory");
        bf16x8s Ufr[8];
#pragma unroll
        for (int kb = 0; kb < 8; ++kb) Ufr[kb] = *(const bf16x8s*)(F.U + (tok0 + 2 * kb + (rq >> 1)) * 512 + gop4 * 16 + 8 * (rq & 1));
#pragma unroll
        for (int t = 0; t < 16; ++t) { f32x4 y = {0.f, 0.f, 0.f, 0.f};
#pragma unroll
            for (int kb = 0; kb <= t / 2; ++kb) y = __builtin_amdgcn_mfma_f32_16x16x32_bf16(SSM_A(t - 2 * kb), Ufr[kb], y, 0, 0, 0);
#pragma unroll
            for (int ks = 0; ks < 4; ++ks) y = __builtin_amdgcn_mfma_f32_16x16x32_bf16(SSM_A(80 + t * 4 + ks), Xfr[ks], y, 0, 0, 0);
            const size_t off = (tok0 + t) * 512 + g * 16 + 4 * rq;
            const v2u uu = *(const v2u*)(F.U + off);
            const float uf[4] = {bflo(uu.x), bfhi(uu.x), bflo(uu.y), bfhi(uu.y)};
            float z[4];
#pragma unroll
            for (int r = 0; r < 4; ++r) z[r] = gelu_tanh(y[r] + dsk[r] * uf[r]);
            *(v2u*)(F.Z + off) = (v2u){cvtpk(z[0], z[1]), cvtpk(z[2], z[3])};
            asm volatile("" ::: "memory"); }
    }
#undef SSM_A
#undef SSM_A16
}

__device__ __forceinline__ unsigned fkey(float f) { const unsigned u = __float_as_uint(f); return (u & 0x80000000u) ? ~u : (u | 0x80000000u); }

typedef short bf16x8 __attribute__((ext_vector_type(8)));
typedef float f32x16 __attribute__((ext_vector_type(16)));
__device__ __forceinline__ int crow(int r, int hi) { return (r & 3) + 8 * (r >> 2) + 4 * hi; }

#define DPP_I(x, ctrl) __builtin_amdgcn_update_dpp(0, (x), (ctrl), 0xf, 0xf, false)
__device__ __forceinline__ unsigned wave_umax(unsigned v) {
    v = max(v, (unsigned)DPP_I((int)v, 0xB1)); v = max(v, (unsigned)DPP_I((int)v, 0x4E)); v = max(v, (unsigned)DPP_I((int)v, 0x141)); v = max(v, (unsigned)DPP_I((int)v, 0x140));
    const unsigned a = __builtin_amdgcn_readlane((int)v, 0), b = __builtin_amdgcn_readlane((int)v, 16), c = __builtin_amdgcn_readlane((int)v, 32), d = __builtin_amdgcn_readlane((int)v, 48);
    return max(max(a, b), max(c, d));
}
__device__ __forceinline__ unsigned wave_umin(unsigned v) {
    v = min(v, (unsigned)DPP_I((int)v, 0xB1)); v = min(v, (unsigned)DPP_I((int)v, 0x4E)); v = min(v, (unsigned)DPP_I((int)v, 0x141)); v = min(v, (unsigned)DPP_I((int)v, 0x140));
    const unsigned a = __builtin_amdgcn_readlane((int)v, 0), b = __builtin_amdgcn_readlane((int)v, 16), c = __builtin_amdgcn_readlane((int)v, 32), d = __builtin_amdgcn_readlane((int)v, 48);
    return min(min(a, b), min(c, d));
}
__device__ __forceinline__ float fkey_inv(unsigned k) { return __uint_as_float((k & 0x80000000u) ? (k & 0x7fffffffu) : ~k); }
__device__ __forceinline__ void select_query(const LAS float* SCq, int t, int nvalid, LAS unsigned long long* BMq, LAS unsigned* H, int lane) {
    float v[32];
#pragma unroll
    for (int j = 0; j < 32; ++j) v[j] = (64 * j + lane < nvalid) ? SCq[64 * j + lane] : -INFINITY;
    const int n = t + 1;
    if (n <= TOPK) {
#pragma unroll
        for (int j = 0; j < 32; ++j) { const unsigned long long sm = __ballot(64 * j + lane <= t); if (lane == 0) BMq[j] = sm; asm volatile("" ::: "memory"); }
        return;
    }
    float hi, lo;
    { float h = -INFINITY, l = INFINITY;
#pragma unroll
      for (int j = 0; j < 32; ++j) { h = fmaxf(h, v[j]); l = fminf(l, (v[j] == -INFINITY) ? INFINITY : v[j]); }
      hi = fkey_inv(wave_umax(fkey(h))); lo = fkey_inv(wave_umin(fkey(l))); }
    const float scale = (hi > lo) ? 255.0f / (hi - lo) : 0.f;
    *(LAS v4u*)(H + 4 * lane) = (v4u){0u, 0u, 0u, 0u};
    LDS_WAIT(); asm volatile("" ::: "memory");
    unsigned pk[8];
#pragma unroll
    for (int j = 0; j < 32; ++j) { const int bin = (v[j] != -INFINITY) ? min(255, (int)((v[j] - lo) * scale)) : 0;
        if (v[j] != -INFINITY) __hip_atomic_fetch_add(H + bin, 1u, __ATOMIC_RELAXED, __HIP_MEMORY_SCOPE_WORKGROUP);
        if ((j & 3) == 0) pk[j >> 2] = (unsigned)bin; else pk[j >> 2] |= (unsigned)bin << (8 * (j & 3)); }
    LDS_WAIT(); asm volatile("" ::: "memory");
    const v4u c = *(const LAS v4u*)(H + 4 * lane);
    const int lsum = (int)(c.x + c.y + c.z + c.w);
    int x = lsum;
    x += __builtin_amdgcn_update_dpp(0, x, 0x101, 0xf, 0xf, true); x += __builtin_amdgcn_update_dpp(0, x, 0x102, 0xf, 0xf, true);
    x += __builtin_amdgcn_update_dpp(0, x, 0x104, 0xf, 0xf, true); x += __builtin_amdgcn_update_dpp(0, x, 0x108, 0xf, 0xf, true);
    { const int r1 = __builtin_amdgcn_readlane(x, 16), r2 = __builtin_amdgcn_readlane(x, 32), r3 = __builtin_amdgcn_readlane(x, 48); const int row = lane >> 4;
      x += (row == 0) ? (r1 + r2 + r3) : (row == 1) ? (r2 + r3) : (row == 2) ? r3 : 0; }
    int run = x - lsum, B = -1, ca = 0, mB = 0;
    { const int ck[4] = {(int)c.x, (int)c.y, (int)c.z, (int)c.w};
#pragma unroll
      for (int k = 3; k >= 0; --k) { if (B < 0 && run < TOPK && run + ck[k] >= TOPK) { B = 4 * lane + k; ca = run; mB = ck[k]; } run += ck[k]; } }
    { const unsigned long long fm = __ballot(B >= 0); const int src = __ffsll((long long)fm) - 1; B = __builtin_amdgcn_readlane(B, src); ca = __builtin_amdgcn_readlane(ca, src); mB = __builtin_amdgcn_readlane(mB, src); }
    const int need = TOPK - ca;
    float tv; int ts;
    if (mB <= 64) {
        const unsigned long long lt = (1ull << lane) - 1ull; int base = 0;
#pragma unroll
        for (int j = 0; j < 32; ++j) { const bool inb = (v[j] != -INFINITY) && (int)((pk[j >> 2] >> (8 * (j & 3))) & 255u) == B; const unsigned long long bm = __ballot(inb);
            if (bm != 0ull) { if (inb) { const int pos = base + __popcll(bm & lt); H[2 * pos] = __float_as_uint(v[j]); H[2 * pos + 1] = (unsigned)(64 * j + lane); } base += __popcll(bm); } }
        LDS_WAIT(); asm volatile("" ::: "memory");
        float cv = -INFINITY; int cs = 0x7fffffff;
        if (lane < mB) { const v2u e = *(const LAS v2u*)(H + 2 * lane); cv = __uint_as_float(e.x); cs = (int)e.y; }
        int rank = 0;
        for (int k = 0; k < mB; ++k) { const float ov = __uint_as_float(__builtin_amdgcn_readlane(__float_as_uint(cv), k)); const int os = __builtin_amdgcn_readlane(cs, k); rank += (ov > cv || (ov == cv && os < cs)) ? 1 : 0; }
        const unsigned long long fm = __ballot(lane < mB && rank == need - 1); const int src = __ffsll((long long)fm) - 1;
        tv = __uint_as_float(__builtin_amdgcn_readlane(__float_as_uint(cv), src)); ts = __builtin_amdgcn_readlane(cs, src);
    } else {
        unsigned tau = 0u;
#pragma unroll 1
        for (int bit = 31; bit >= 0; --bit) { const unsigned cand = tau | (1u << bit); int cnt = 0;
#pragma unroll
            for (int j = 0; j < 32; ++j) { cnt += __popcll(__ballot(fkey(v[j]) >= cand)); asm volatile("" : "+s"(cnt)); }
            if (cnt >= TOPK) tau = cand; }
        int cg = 0;
#pragma unroll
        for (int j = 0; j < 32; ++j) { cg += __popcll(__ballot(fkey(v[j]) > tau)); asm volatile("" : "+s"(cg)); }
        const int need2 = TOPK - cg; const unsigned long long lt = (1ull << lane) - 1ull;
        tv = fkey_inv(tau); ts = -1; int eqb = 0;
#pragma unroll
        for (int j = 0; j < 32; ++j) { const bool eq = fkey(v[j]) == tau; const unsigned long long em = __ballot(eq);
            const unsigned long long hit = __ballot(eq && (eqb + __popcll(em & lt) + 1 == need2));
            if (hit != 0ull && ts < 0) ts = 64 * j + (__ffsll((long long)hit) - 1);
            eqb += __popcll(em); asm volatile("" : "+s"(eqb)); }
    }
#pragma unroll
    for (int j = 0; j < 32; ++j) { const int s_ = 64 * j + lane; const unsigned long long sm = __ballot(v[j] > tv || (v[j] == tv && s_ <= ts)); if (lane == 0) BMq[j] = sm; asm volatile("" ::: "memory"); }
    LDS_WAIT(); asm volatile("" ::: "memory");
}

constexpr int KBUF_BYTES = 65536;
__device__ __forceinline__ void idx_subunit(Frame& F, int b, int t0, int qoff) {
    int lane_ = F.lane; asm volatile("" : "+v"(lane_));
    const int lane = lane_, w = F.wave, rt = w & 3, kq = w >> 2, r32 = lane & 31, hh = lane >> 5;
    LAS float* SC = (LAS float*)(F.lds);
    LAS unsigned long long* BM = (LAS unsigned long long*)(F.lds + BM_OFF);
    LAS unsigned* HW = (LAS unsigned*)(F.lds + XCH_OFF) + w * 256;
    const int nk = t0 + 16, nkt = (nk + 31) >> 5, nstep = (nkt + 7) >> 3;
    const bf16* qp = F.QI2 + (size_t)(b * SEQ + t0 + 4 * rt + (r32 >> 3)) * 1024 + (r32 & 7) * 64 + 8 * hh;
    bf16x8 qh[4], ql[4];
#pragma unroll
    for (int d0 = 0; d0 < 4; ++d0) { qh[d0] = *(const bf16x8*)(qp + 16 * d0); ql[d0] = *(const bf16x8*)(qp + 512 + 16 * d0); }
    f32x4 wq[4];
#pragma unroll
    for (int tq = 0; tq < 4; ++tq) wq[tq] = *(const f32x4*)(F.WI + (size_t)(b * SEQ + t0 + 4 * rt + tq) * 8 + 4 * hh);
    const int P = w * 64 + lane, skey = P >> 4;
    const char* ksrc = (const char*)(F.KI2 + (size_t)b * SEQ * 128) + skey * 256 + (((P & 15) ^ (skey & 15)) * 16);
#define IDX_DMA(step) do { _Pragma("unroll") for (int i_ = 0; i_ < 8; ++i_) { const int tl_ = 8 * (step) + i_; \
        if (tl_ < nkt) __builtin_amdgcn_global_load_lds((const unsigned*)(ksrc + (size_t)tl_ * 8192), (LAS unsigned*)(F.lds + ((step) & 1) * KBUF_BYTES + i_ * 8192 + w * 1024), 16, 0, 0); } } while (0)
    __syncthreads();
    IDX_DMA(0);
    float scr[8][4][2];
#pragma unroll
    for (int s_ = 0; s_ < 8; ++s_) {
        if (s_ < nstep) {
            asm volatile("s_waitcnt vmcnt(0)" ::: "memory");
            __builtin_amdgcn_s_barrier();
            asm volatile("" ::: "memory");
            if (s_ + 1 < nstep) IDX_DMA(s_ + 1);
            const LAS unsigned char* kb = F.lds + (s_ & 1) * KBUF_BYTES;
#pragma unroll
            for (int i4 = 0; i4 < 4; ++i4) {
                const int ti = 2 * i4 + kq, kt = 8 * s_ + ti;
                float v0 = -INFINITY, v1 = -INFINITY;
                if (kt < nkt) {
                    const LAS unsigned char* kr = kb + ti * 8192 + r32 * 256;
                    const int sw = r32 & 15;
                    f32x16 acc;
#pragma unroll
                    for (int r = 0; r < 16; ++r) acc[r] = 0.f;
#pragma unroll
                    for (int d0 = 0; d0 < 4; ++d0) {
                        const bf16x8 kh = *(const LAS bf16x8*)(kr + (((2 * d0 + hh) ^ sw) * 16)), kl = *(const LAS bf16x8*)(kr + (((8 + 2 * d0 + hh) ^ sw) * 16));
                        acc = __builtin_amdgcn_mfma_f32_32x32x16_bf16(ql[d0], kh, acc, 0, 0, 0);
                        acc = __builtin_amdgcn_mfma_f32_32x32x16_bf16(qh[d0], kl, acc, 0, 0, 0);
                        acc = __builtin_amdgcn_mfma_f32_32x32x16_bf16(qh[d0], kh, acc, 0, 0, 0);
                    }
                    const int key = 32 * kt + r32;
                    float part[4];
#pragma unroll
                    for (int tq = 0; tq < 4; ++tq) { float p = 0.f;
#pragma unroll
                        for (int i = 0; i < 4; ++i) p += fmaxf(acc[4 * tq + i], 0.f) * wq[tq][i];
                        const auto rr = __builtin_amdgcn_permlane32_swap(__float_as_uint(p), __float_as_uint(p), false, false); part[tq] = __uint_as_float(rr[0]) + __uint_as_float(rr[1]); }
                    const float a0 = hh ? part[2] : part[0], a1 = hh ? part[3] : part[1]; const int tq0 = t0 + 4 * rt + 2 * hh;
                    v0 = (key <= tq0) ? (a0 * IDX_SCALE + 0.0f) : -INFINITY; v1 = (key <= tq0 + 1) ? (a1 * IDX_SCALE + 0.0f) : -INFINITY;
                }
                scr[s_][i4][0] = v0; scr[s_][i4][1] = v1;
            }
        }
    }
#undef IDX_DMA
    __syncthreads();
#pragma unroll
    for (int s_ = 0; s_ < 8; ++s_)
#pragma unroll
        for (int i4 = 0; i4 < 4; ++i4) { const int kt = 8 * s_ + 2 * i4 + kq;
            if (s_ < nstep && kt < nkt) { SC[(4 * rt + 2 * hh) * 2048 + 32 * kt + r32] = scr[s_][i4][0]; SC[(4 * rt + 2 * hh + 1) * 2048 + 32 * kt + r32] = scr[s_][i4][1]; } }
    __syncthreads();
#ifndef DUP_SEL
#define DUP_SEL 1
#endif
#ifndef DUP_FLASH
#define DUP_FLASH 1
#endif
    for (int rep_ = 0; rep_ < DUP_SEL; ++rep_)
#pragma unroll 1
        for (int e = 0; e < 2; ++e) select_query(SC + (2 * w + e) * 2048, t0 + 2 * w + e, nkt * 32, BM + (qoff + 2 * w + e) * 32, HW, lane);
}

typedef short v4i16_t __attribute__((ext_vector_type(4)));
__device__ __forceinline__ v4i16_t vtr(const LAS unsigned char* p) { return __builtin_amdgcn_ds_read_tr16_b64_v4i16((LAS v4i16_t*)p); }
__device__ __forceinline__ void attn_subunit(Frame& F, int b, int kvh, int t0) {
    int lane_ = F.lane; asm volatile("" : "+v"(lane_));
    const int lane = lane_, w = F.wave, r32 = lane & 31, hi = lane >> 5, tid = w * 64 + lane;
    LAS float* wsf = (LAS float*)(F.lds + 32768) + w * 64;
    const LAS unsigned long long* BM = (const LAS unsigned long long*)(F.lds + BM_OFF);
    const int ntile = (t0 + 64) >> 6;
    const int tl = 8 * w + (r32 >> 2), g = r32 & 3;
    constexpr float C2 = 0.125f * 1.4426950408889634f;
    float negS;
    { const float gv = fabsf(F.q_gain[lane] * F.k_gain[lane]); negS = -64.0f * C2 * fkey_inv(wave_umax(fkey(gv))) * 1.0005f; }
    bf16x8 qr[4];
    { const bf16* qp = F.Q + (size_t)(b * SEQ + t0 + tl) * 512 + (4 * kvh + g) * 64 + 8 * hi;
      float qf[32]; float ss = 0.f;
#pragma unroll
      for (int d0 = 0; d0 < 4; ++d0) { const v4u qv = *(const v4u*)(qp + 16 * d0);
          qf[8 * d0 + 0] = bflo(qv.x); qf[8 * d0 + 1] = bfhi(qv.x); qf[8 * d0 + 2] = bflo(qv.y); qf[8 * d0 + 3] = bfhi(qv.y);
          qf[8 * d0 + 4] = bflo(qv.z); qf[8 * d0 + 5] = bfhi(qv.z); qf[8 * d0 + 6] = bflo(qv.w); qf[8 * d0 + 7] = bfhi(qv.w); }
#pragma unroll
      for (int i = 0; i < 32; ++i) ss += qf[i] * qf[i];
      { const auto rr = __builtin_amdgcn_permlane32_swap(__float_as_uint(ss), __float_as_uint(ss), false, false); ss = __uint_as_float(rr[0]) + __uint_as_float(rr[1]); }
      const float rstd = (1.0f / sqrtf(ss * (1.f / 64.f) + EPS)) * C2;
      int dop = 8 * hi; asm volatile("" : "+v"(dop));
#pragma unroll
      for (int d0 = 0; d0 < 4; ++d0) { float v[8];
#pragma unroll
          for (int j = 0; j < 8; ++j) { const int d = 16 * d0 + dop + j; v[j] = qf[8 * d0 + j] * rstd * F.q_gain[d] * F.k_gain[d]; }
          v4u pk; pk.x = cvtpk(v[0], v[1]); pk.y = cvtpk(v[2], v[3]); pk.z = cvtpk(v[4], v[5]); pk.w = cvtpk(v[6], v[7]);
          qr[d0] = __builtin_bit_cast(bf16x8, pk); } }
    const int skey = tid >> 3, sc = tid & 7;
    const bf16* kvp = F.KV + (size_t)(b * SEQ + skey) * 256 + kvh * 64 + 8 * sc;
    const int kwoff = skey * 128 + ((sc ^ (skey & 7)) * 16), vwoff = 8192 + (sc >> 2) * 4096 + skey * 64 + (sc & 3) * 16;
#define ATT_STAGE(bufbase) do { LAS unsigned char* bb_ = F.lds + (bufbase); \
        float kf_[8] = {bflo(kreg.x), bfhi(kreg.x), bflo(kreg.y), bfhi(kreg.y), bflo(kreg.z), bfhi(kreg.z), bflo(kreg.w), bfhi(kreg.w)}; float ss_ = 0.f; \
        _Pragma("unroll") for (int j_ = 0; j_ < 8; ++j_) ss_ += kf_[j_] * kf_[j_]; \
        ss_ += __builtin_bit_cast(float, DPP_I(__builtin_bit_cast(int, ss_), 0xB1)); ss_ += __builtin_bit_cast(float, DPP_I(__builtin_bit_cast(int, ss_), 0x4E)); ss_ += __builtin_bit_cast(float, DPP_I(__builtin_bit_cast(int, ss_), 0x141)); \
        const float rk_ = 1.0f / sqrtf(ss_ * (1.f / 64.f) + EPS); \
        v4u ko_; ko_.x = cvtpk(kf_[0] * rk_, kf_[1] * rk_); ko_.y = cvtpk(kf_[2] * rk_, kf_[3] * rk_); ko_.z = cvtpk(kf_[4] * rk_, kf_[5] * rk_); ko_.w = cvtpk(kf_[6] * rk_, kf_[7] * rk_); \
        *(LAS v4u*)(bb_ + kwoff) = ko_; *(LAS v4u*)(bb_ + vwoff) = vreg; } while (0)
    float l = 0.f;
    f32x16 o[2];
#pragma unroll
    for (int r = 0; r < 16; ++r) { o[0][r] = 0.f; o[1][r] = 0.f; }
    v4u kreg = *(const v4u*)(kvp), vreg = *(const v4u*)(kvp + 128);
    __syncthreads();
    ATT_STAGE(0);
    if (ntile > 1) { kreg = *(const v4u*)(kvp + (size_t)64 * 256); vreg = *(const v4u*)(kvp + (size_t)64 * 256 + 128); }
    __syncthreads();
    const LAS unsigned char* vp0 = F.lds + 8192 + ((lane >> 4) & 1) * 32 + (lane & 3) * 8 + (4 * hi + ((lane & 15) >> 2)) * 64;
    for (int tile = 0; tile < ntile; ++tile) {
        const int cb_ = (tile & 1) * 16384;
        if (tile + 1 < ntile) { ATT_STAGE(16384 - cb_);
            if (tile + 2 < ntile) { const bf16* np = kvp + (size_t)(tile + 2) * 64 * 256; kreg = *(const v4u*)(np); vreg = *(const v4u*)(np + 128); } }
        const LAS unsigned char* Kt = F.lds + cb_;
        f32x16 p0, p1;
#pragma unroll
        for (int r = 0; r < 16; ++r) { p0[r] = negS; p1[r] = negS; }
#pragma unroll
        for (int d0 = 0; d0 < 4; ++d0) {
            const bf16x8 a0 = *(const LAS bf16x8*)(Kt + r32 * 128 + (((2 * d0 + hi) ^ (r32 & 7)) * 16));
            const bf16x8 a1 = *(const LAS bf16x8*)(Kt + (32 + r32) * 128 + (((2 * d0 + hi) ^ (r32 & 7)) * 16));
            p0 = __builtin_amdgcn_mfma_f32_32x32x16_bf16(a0, qr[d0], p0, 0, 0, 0);
            p1 = __builtin_amdgcn_mfma_f32_32x32x16_bf16(a1, qr[d0], p1, 0, 0, 0);
        }
        const unsigned long long mw = BM[tl * 32 + tile];
        const int mlo = (int)((unsigned)mw >> (4 * hi)), mhi = (int)((unsigned)(mw >> 32) >> (4 * hi));
        float ps = 0.f;
#pragma unroll
        for (int r = 0; r < 16; ++r) { const unsigned cbit = 8u * (r >> 2) + (r & 3);
            const float e0 = __builtin_amdgcn_exp2f(p0[r]), e1 = __builtin_amdgcn_exp2f(p1[r]);
            p0[r] = __int_as_float(__float_as_int(e0) & __builtin_amdgcn_sbfe(mlo, cbit, 1u)); p1[r] = __int_as_float(__float_as_int(e1) & __builtin_amdgcn_sbfe(mhi, cbit, 1u));
            ps += p0[r] + p1[r]; }
        l += ps;
        bf16x8 pa[4];
        { v4u t_;
          t_.x = cvtpk(p0[0], p0[1]); t_.y = cvtpk(p0[2], p0[3]); t_.z = cvtpk(p0[4], p0[5]); t_.w = cvtpk(p0[6], p0[7]); pa[0] = __builtin_bit_cast(bf16x8, t_);
          t_.x = cvtpk(p0[8], p0[9]); t_.y = cvtpk(p0[10], p0[11]); t_.z = cvtpk(p0[12], p0[13]); t_.w = cvtpk(p0[14], p0[15]); pa[1] = __builtin_bit_cast(bf16x8, t_);
          t_.x = cvtpk(p1[0], p1[1]); t_.y = cvtpk(p1[2], p1[3]); t_.z = cvtpk(p1[4], p1[5]); t_.w = cvtpk(p1[6], p1[7]); pa[2] = __builtin_bit_cast(bf16x8, t_);
          t_.x = cvtpk(p1[8], p1[9]); t_.y = cvtpk(p1[10], p1[11]); t_.z = cvtpk(p1[12], p1[13]); t_.w = cvtpk(p1[14], p1[15]); pa[3] = __builtin_bit_cast(bf16x8, t_); }
#pragma unroll
        for (int dh = 0; dh < 2; ++dh)
#pragma unroll
            for (int ks = 0; ks < 4; ++ks) { const v4i16_t lo_ = vtr(vp0 + cb_ + dh * 4096 + ks * 1024), hi_ = vtr(vp0 + cb_ + dh * 4096 + ks * 1024 + 512);
                const bf16x8 vb = (bf16x8){lo_[0], lo_[1], lo_[2], lo_[3], hi_[0], hi_[1], hi_[2], hi_[3]};
                o[dh] = __builtin_amdgcn_mfma_f32_32x32x16_bf16(pa[ks], vb, o[dh], 0, 0, 0); }
        __syncthreads();
    }
#undef ATT_STAGE
    { const auto rr = __builtin_amdgcn_permlane32_swap(__float_as_uint(l), __float_as_uint(l), false, false); l = __uint_as_float(rr[0]) + __uint_as_float(rr[1]); }
    if (hi == 0) wsf[r32] = 1.0f / l;
    LDS_WAIT(); asm volatile("" ::: "memory");
    float ssq[4];
#pragma unroll
    for (int q4 = 0; q4 < 4; ++q4) { const f32x4 av = *(const LAS f32x4*)(wsf + 8 * q4 + 4 * hi); float s2 = 0.f;
        const size_t row = (size_t)(b * SEQ + t0 + 8 * w + 2 * q4 + hi);
#pragma unroll
        for (int i = 0; i < 4; ++i) { const float v0 = o[0][4 * q4 + i] * av[i], v1 = o[1][4 * q4 + i] * av[i]; s2 += v0 * v0 + v1 * v1;
            bf16* op = F.MIX + row * 1024 + 512 + (4 * kvh + i) * 64 + r32;
            op[0] = (bf16)f2bf(v0); op[32] = (bf16)f2bf(v1); }
        ssq[q4] = s2; }
#pragma unroll
    for (int q4 = 0; q4 < 4; ++q4) { float s2 = ssq[q4];
        s2 += __shfl_xor(s2, 1); s2 += __shfl_xor(s2, 2); s2 += __shfl_xor(s2, 4); s2 += __shfl_xor(s2, 8); s2 += __shfl_xor(s2, 16);
        if (r32 == 0) F.SSQA[(size_t)(b * SEQ + t0 + 8 * w + 2 * q4 + hi) * 2 + kvh] = s2; }
    LDS_WAIT(); asm volatile("" ::: "memory");
}

__device__ __forceinline__ void p3_phase(Frame& F) {
    LAS unsigned char* wl = F.lds + RING_OFF + F.wave * WAVE_LDS;
    const int gw = F.vcu * NWAVES + F.wave, NGW = F.G * NWAVES;
    for (int it = gw; it < 1024; it += NGW) bias2_item(F, it, (LAS float*)wl);
#ifndef DUP_SSM
#define DUP_SSM 1
#endif
#ifndef DUP_ATTN
#define DUP_ATTN 1
#endif
#ifndef NO_SSM
    for (int rep = 0; rep < DUP_SSM; ++rep)
    for (int u = F.vcu; u < NG * 8; u += F.G) ssm_unit(F, u & 31, u >> 5);
#endif
#ifndef NO_ATTN
    for (int rep = 0; rep < DUP_ATTN; ++rep)
    for (int u = F.vcu; u < BATCH * 16; u += F.G) {
        const int b = u >> 4, p = u & 15;
#pragma unroll 1
        for (int side = 0; side < 2; ++side) { const int t0 = 64 * (side ? 31 - p : p);
#pragma unroll 1
#ifndef DUP_IS
#define DUP_IS 1
#endif
            for (int sub = 0; sub < 4 * DUP_IS; ++sub) idx_subunit(F, b, t0 + 16 * (sub & 3), 16 * (sub & 3));
#pragma unroll 1
            for (int kvh = 0; kvh < 2 * DUP_FLASH; ++kvh) {
#ifndef T_NOFLASH
                attn_subunit(F, b, kvh & 1, t0);
#endif
            } }
    }
#endif
    __syncthreads();
}

struct Args { const float* in[24]; float* out; unsigned char* ws; int ph_lo, ph_hi, li, pad; };
__global__ void __launch_bounds__(NWAVES * 64, 2) fwd_kernel(Args args) {
    extern __shared__ __attribute__((aligned(16))) unsigned char lds[];
    Frame F;
    F.lds = (LAS unsigned char*)lds;
    F.MISC = (volatile LAS unsigned*)(F.lds + MISC_OFF);
    F.tid = threadIdx.x; F.lane = F.tid & 63; F.wave = __builtin_amdgcn_readfirstlane(F.tid >> 6);
    F.G = gridDim.x; { const int bx = blockIdx.x; F.vcu = (F.G % 8 == 0) ? (bx % 8) * (F.G / 8) + bx / 8 : bx; }
    unsigned char* ws = args.ws;
    F.ctl = (gu32*)(ws + WS_CTL);
    F.x = args.in[0]; F.c = args.in[1]; F.norm1_g = args.in[2]; F.norm2_g = args.in[3]; F.w_ada = args.in[4]; F.b_ada = args.in[5]; F.w_in = args.in[6];
    F.lam_re = args.in[7]; F.lam_im = args.in[8]; F.log_dt = args.in[9]; F.b_re = args.in[10]; F.b_im = args.in[11]; F.c_re = args.in[12]; F.c_im = args.in[13];
    F.d_skip = args.in[14]; F.w_glu = args.in[15]; F.b_glu = args.in[16]; F.q_gain = args.in[17]; F.k_gain = args.in[18]; F.gn_ssm = args.in[19]; F.gn_attn = args.in[20];
    F.w_out = args.in[21]; F.w_ff1 = args.in[22]; F.w_ff2 = args.in[23]; F.out = args.out;
    F.MODP = (float*)(ws + WS_MODP); F.MOD = (float*)(ws + WS_MOD); F.BIAS2 = (float*)(ws + WS_BIAS2); F.SSQS = (float*)(ws + WS_SSQS); F.SSQ2 = (float*)(ws + WS_SSQ2);
    F.KI2 = (bf16*)(ws + WS_KI); F.WI = (float*)(ws + WS_WI); F.QI2 = (bf16*)(ws + WS_QI); F.SSQA = (float*)(ws + WS_SSQA); F.SSMF = (bf16*)(ws + WS_SSMF);
    F.LAMB = (f32x2*)(ws + WS_SSMP); F.BBAR = (f32x2*)(ws + WS_SSMP + 16384);
    F.WINP = (bf16*)(ws + WS_WINP); F.WINI = (bf16*)(ws + WS_WINI); F.WGLU = (bf16*)(ws + WS_WGLU); F.WOUT = (bf16*)(ws + WS_WOUT); F.W1 = (bf16*)(ws + WS_W1); F.W2 = (bf16*)(ws + WS_W2);
    F.U = (bf16*)(ws + WS_U); F.Q = (bf16*)(ws + WS_Q); F.A2 = (bf16*)(ws + WS_A2); F.XN = (bf16*)(ws + WS_XN); F.KV = (bf16*)(ws + WS_KV); F.Z = (bf16*)(ws + WS_Z); F.MIX = (bf16*)(ws + WS_MIX); F.H = (bf16*)(ws + WS_H);
    for (int u = F.tid; u < (LDS_BYTES - LDSCTL_OFF) / 4; u += NWAVES * 64) ((LAS unsigned*)(F.lds + LDSCTL_OFF))[u] = 0u;
    __syncthreads();
    XcdBarrier bar; bar.bar = (unsigned*)(F.ctl + CW_BAR) + args.li * XCD_BAR_WORDS; bar.x = 0; bar.st = nullptr;
    if (N_LAUNCHES == 1) bar = xcd_barrier_post((unsigned*)(F.ctl + CW_BAR) + args.li * XCD_BAR_WORDS, F.MISC + 8);
#define GRID_BAR() do { if (N_LAUNCHES == 1) xcd_barrier(bar); } while (0)
    const int lo = args.ph_lo, hi = args.ph_hi;
#ifndef PHASE_MASK
#define PHASE_MASK 0xFF
#endif
#define IN(k) (((PHASE_MASK >> (k)) & 1) && lo <= (k) && (k) < hi)
#define BOTH(k) (IN(k) && IN((k) + 1))

#ifndef DUP_PH
#define DUP_PH -1
#endif
#define PH_REP(k) for (int rep_ = 0; rep_ < ((DUP_PH == (k)) ? 2 : 1); ++rep_)
    if (IN(0)) { PH_REP(0) p0a_phase(F); if (BOTH(0)) GRID_BAR(); }
    if (IN(1)) { PH_REP(1) p0b_phase(F); if (BOTH(1)) GRID_BAR(); }
    if (IN(2)) { PH_REP(2) {
        { pg8::Gemm g{F.XN, F.WINP, M, N_PLAIN, 1024, 2048, 1 << 30}; pg8::StaticOrder S; S.init(M, N_PLAIN, F.G, (int)blockIdx.x);
          EpiInPlain E{0, F.U, F.Q, F.KV};
          pg8::gemm_phase<EpiInPlain, pg8::StaticOrder, true>(F.lds + RING_OFF, g, S, E); }
        { pg8::Gemm g{F.XN, F.WINI, M, N_IDX_PAD, K3, 2048, 32}; pg8::StaticOrder S; S.init(M, N_IDX_PAD, F.G, F.G - 1 - (int)blockIdx.x);
          EpiInIdx E{0, F.QI2, F.KI2, F.WI};
          pg8::gemm_phase<EpiInIdx, pg8::StaticOrder, true>(F.lds + RING_OFF, g, S, E); } }
        if (BOTH(2)) GRID_BAR();
    }
    if (IN(3)) { p3_phase(F); if (BOTH(3)) GRID_BAR(); }
    if (IN(4)) { PH_REP(4) {
        pg8::Gemm g{F.Z, F.WGLU, M, 512, 512, 512, 1 << 30}; pg8::StaticOrder S; S.init(M, 512, F.G, (int)blockIdx.x);
        EpiGlu E{0, F.Z, F.MIX, F.b_glu, F.SSQS};
        pg8::gemm_phase<EpiGlu, pg8::StaticOrder, true>(F.lds + RING_OFF, g, S, E); }
        if (BOTH(4)) GRID_BAR();
    }
    if (IN(5)) { PH_REP(5) {
        pg8::Gemm g{F.MIX, F.WOUT, M, 1024, 1024, 1024, 1 << 30}; pg8::StaticOrder S; S.init(M, 1024, F.G, (int)blockIdx.x);
        EpiOut E{8, F.x, F.out, F.A2, F.MOD, F.norm2_g, F.SSQS, F.SSQ2, F.SSQA};
        pg8::gemm_phase<EpiOut, pg8::StaticOrder, true>(F.lds + RING_OFF, g, S, E); }
        if (BOTH(5)) GRID_BAR();
    }
    if (IN(6)) { PH_REP(6) {
        pg8::Gemm g{F.A2, F.W1, M, DFF, 1024, 1024, 1 << 30}; pg8::StaticOrder S; S.init(M, DFF, F.G, (int)blockIdx.x);
        EpiUp E{0, F.SSQ2, F.BIAS2, F.H};
        pg8::gemm_phase<EpiUp, pg8::StaticOrder, true>(F.lds + RING_OFF, g, S, E); }
        if (BOTH(6)) GRID_BAR();
    }
#ifdef PROBE_BARS
    if (N_LAUNCHES == 1 && hi == NPHASE) { for (int i_ = 0; i_ < PROBE_BARS; ++i_) GRID_BAR(); }
#endif
    if (IN(7)) {
        pg8::Gemm g{F.H, F.W2, M, 1024, DFF, DFF, 1 << 30}; pg8::StaticOrder S; S.init(M, 1024, F.G, (int)blockIdx.x);
        EpiDown E{0, F.out, F.MOD};
        pg8::gemm_phase<EpiDown, pg8::StaticOrder, true>(F.lds + RING_OFF, g, S, E);
    }
#undef IN
#undef BOTH
}

extern "C" void kernel_launch(void* const* d_in, const int* in_sizes, int n_in, void* d_out, int out_size, void* d_ws, size_t ws_size, hipStream_t stream) {
    static int grid = 0;
    if (grid == 0) {
        if (n_in != 24 || in_sizes[0] != M * DM || out_size != M * DM || ws_size < WS_END) { fprintf(stderr, "kernel_launch: unexpected shapes (n_in %d, in0 %d, out %d, ws %zu); nothing launched\n", n_in, n_in > 0 ? in_sizes[0] : -1, out_size, ws_size); grid = -1; return; }
        int dev = 0, cus = 0, per_cu = 0;
        if (hipGetDevice(&dev) != hipSuccess || hipDeviceGetAttribute(&cus, hipDeviceAttributeMultiprocessorCount, dev) != hipSuccess) { fprintf(stderr, "kernel_launch: device query failed\n"); grid = -1; return; }
        if (hipFuncSetAttribute((const void*)fwd_kernel, hipFuncAttributeMaxDynamicSharedMemorySize, LDS_BYTES) != hipSuccess) { fprintf(stderr, "kernel_launch: hipFuncSetAttribute failed\n"); grid = -1; return; }
        if (hipOccupancyMaxActiveBlocksPerMultiprocessor(&per_cu, (const void*)fwd_kernel, NWAVES * 64, LDS_BYTES) != hipSuccess || per_cu < 1)
            fprintf(stderr, "kernel_launch: note: occupancy query reports %d workgroups per CU\n", per_cu);
        (void)hipGetLastError();
        grid = cus;
    }
    if (grid < 0) return;
    if (hipMemsetAsync((char*)d_ws + WS_CTL, 0, CTL_ZERO_BYTES, stream) != hipSuccess) { fprintf(stderr, "kernel_launch: memset failed\n"); return; }
    Args a{};
    for (int i = 0; i < 24; ++i) a.in[i] = (const float*)d_in[i];
    a.out = (float*)d_out; a.ws = (unsigned char*)d_ws;
#ifdef PROBE_SPLIT
    { const int lo_[3] = {0, PROBE_SPLIT, PROBE_SPLIT + 1}, hi_[3] = {PROBE_SPLIT + 1, PROBE_SPLIT + 1, NPHASE};
      for (int li = 0; li < 3; ++li) { a.ph_lo = lo_[li]; a.ph_hi = hi_[li]; a.li = li; hipLaunchKernelGGL(fwd_kernel, dim3(grid), dim3(NWAVES * 64), LDS_BYTES, stream, a); } }
#else
    for (int li = 0; li < N_LAUNCHES; ++li) {
        a.ph_lo = (N_LAUNCHES == 1) ? 0 : li; a.ph_hi = (N_LAUNCHES == 1) ? NPHASE : li + 1; a.li = li;
        hipLaunchKernelGGL(fwd_kernel, dim3(grid), dim3(NWAVES * 64), LDS_BYTES, stream, a);
        const hipError_t le = hipPeekAtLastError();
        if (le != hipSuccess) { fprintf(stderr, "kernel_launch: launch %d failed: %s\n", li, hipGetErrorName(le)); break; }
    }
#endif
#ifdef PROBE_PHASE
    a.ph_lo = PROBE_PHASE; a.ph_hi = PROBE_PHASE + 1; a.li = 1;
    hipLaunchKernelGGL(fwd_kernel, dim3(grid), dim3(NWAVES * 64), LDS_BYTES, stream, a);
#endif
}
```

```cpp
#include <hip/hip_runtime.h>
#include <cstdio>
#include <cstdint>

#ifndef MK_N_LAUNCHES
#define MK_N_LAUNCHES 1
#endif

namespace pg8 {
#define PG8_LAS __attribute__((address_space(3)))
typedef unsigned short bf16_t;
typedef short bf16x8 __attribute__((ext_vector_type(8)));
typedef float f32x4 __attribute__((ext_vector_type(4)));
typedef unsigned u32x4 __attribute__((ext_vector_type(4)));
typedef unsigned u32x2 __attribute__((ext_vector_type(2)));
constexpr int BM = 256, BK = 64, HALF = 128, HTB = HALF * BK * 2, STAGE_BYTES = 8 * HTB, NXCD = 8, WGM = 8;

__host__ __device__ __forceinline__ int lds_byte(int r, int c) { const int st = (r >> 4) * 2 + (c >> 5), rr = r & 15, cc = c & 31, ob = rr * 64 + cc * 2; return st * 1024 + (ob ^ (((ob >> 9) & 1) << 5)); }
__host__ __device__ __forceinline__ void stage_rc(int b, int& R, int& C) { const int st = b / 1024, sb = b % 1024, swz = sb ^ (((sb >> 9) & 1) << 5); R = (st >> 1) * 16 + swz / 64; C = (st & 1) * 32 + (swz % 64) / 2; }
__host__ __device__ __forceinline__ int perm32(int rho) { const int n = rho >> 4, i = rho & 15; return 8 * (i >> 2) + 4 * n + (i & 3); }

struct Unit { int pm, pn, idx; };
struct Gemm { const bf16_t* A; const bf16_t* Bt; int M, N, K, lda, wrapA; size_t kstepA, tstepA; };

struct StaticOrder {
    int nM, nN, nwg, G, c;
    __host__ __device__ __forceinline__ void init(int M, int N, int G_, int c_) { nM = M / BM; nN = N / BM; nwg = nM * nN; G = G_; c = c_; }
    __host__ __device__ __forceinline__ bool next(int i, Unit& u) const {
        const long L = (long)i * G + c; if (L >= nwg) return false;
        int wgid = (int)L; { const int q = nwg / NXCD, r = nwg % NXCD, xcd = wgid % NXCD, off = wgid / NXCD; wgid = (xcd < r ? xcd * (q + 1) : r * (q + 1) + (xcd - r) * q) + off; }
        const int nig = WGM * nN, gid = wgid / nig, fm = gid * WGM, gsz = (nM - fm) < WGM ? (nM - fm) : WGM;
        u.pm = fm + ((wgid % nig) % gsz); u.pn = (wgid % nig) / gsz; u.idx = i;
#if defined(__HIP_DEVICE_COMPILE__)
        u.pm = __builtin_amdgcn_readfirstlane(u.pm); u.pn = __builtin_amdgcn_readfirstlane(u.pn);
#endif
        return true;
    }
};

struct ListOrder {
    int nM, nN, nwg, cnt, first, stride;
    __host__ __device__ __forceinline__ void init(int M, int N, int cnt_, int first_, int stride_) { nM = M / BM; nN = N / BM; nwg = nM * nN; cnt = cnt_; first = first_; stride = stride_; }
    __host__ __device__ __forceinline__ bool next(int i, Unit& u) const {
        if (i >= cnt) return false;
        int wgid = first + i * stride;
        { const int q = nwg / NXCD, r = nwg % NXCD, xcd = wgid % NXCD, off = wgid / NXCD; wgid = (xcd < r ? xcd * (q + 1) : r * (q + 1) + (xcd - r) * q) + off; }
        const int nig = WGM * nN, gid = wgid / nig, fm = gid * WGM, gsz = (nM - fm) < WGM ? (nM - fm) : WGM;
        u.pm = fm + ((wgid % nig) % gsz); u.pn = (wgid % nig) / gsz; u.idx = i; return true;
    }
};

__device__ __forceinline__ unsigned cvt_pk_bf16(float lo, float hi) { unsigned r; asm volatile("v_cvt_pk_bf16_f32 %0, %1, %2" : "=v"(r) : "v"(lo), "v"(hi)); return r; }

typedef _Float16 f16x8 __attribute__((ext_vector_type(8)));
template <class Epi, class Sched, bool ALIGN_EPI, bool F16 = false>
__device__ __forceinline__ void gemm_phase(PG8_LAS unsigned char* lds, const Gemm g, const Sched& S, const Epi& E) {
    const int tid = threadIdx.x, wid = __builtin_amdgcn_readfirstlane(tid >> 6), lane = tid & 63, wr = wid >> 2, wc = wid & 3, fr = lane & 15, fq = lane >> 4;
    const int K = g.K, nt = K / BK, lda = g.lda, wrapA = g.wrapA;
    unsigned voffA[2], voffB[2];
#pragma unroll
    for (int i = 0; i < 2; ++i) { int R, C; stage_rc(tid * 16 + i * 8192, R, C); const int Rb = Epi::PERM ? ((R & ~31) + perm32(R & 31)) : R;
        voffA[i] = (unsigned)(R * lda + C) * 2u; voffB[i] = (unsigned)(Rb * K + C) * 2u; }
    const size_t kstep = (size_t)(BK * 2), kstepA = g.kstepA;
    const size_t hsA = (size_t)HALF * lda * 2, hsB = (size_t)HALF * K * 2;
    const size_t tsA = g.tstepA, tsB = 2 * hsB;
    const unsigned ldsw = (unsigned)wid * 1024u;
    const int aoff = lds_byte(wr * 64 + fr, fq * 8), boff = lds_byte(wc * 32 + fr, fq * 8);
#define PG8_SA(b, h) (((b) * 2 + (h)) * HTB)
#define PG8_SB(b, h) ((4 + (b) * 2 + (h)) * HTB)
#define PG8_STAGE(bufoff, gbase, voff) do { _Pragma("unroll") for (int _i = 0; _i < 2; ++_i) \
        __builtin_amdgcn_global_load_lds((const unsigned*)((const char*)(gbase) + (voff)[_i]), (PG8_LAS unsigned*)(lds + (bufoff) + ldsw + _i * 8192), 16, 0, 0); } while (0)
#define PG8_LDA(dst, b, h) do { _Pragma("unroll") for (int m = 0; m < 4; ++m) _Pragma("unroll") for (int k = 0; k < 2; ++k) dst[m][k] = *(const PG8_LAS bf16x8*)(lds + PG8_SA(b, h) + aoff + m * 2048 + k * 1024); } while (0)
#define PG8_LDB(dst, b, h) do { _Pragma("unroll") for (int n = 0; n < 2; ++n) _Pragma("unroll") for (int k = 0; k < 2; ++k) dst[n][k] = *(const PG8_LAS bf16x8*)(lds + PG8_SB(b, h) + boff + n * 2048 + k * 1024); } while (0)
#define PG8_MMA(ai, bj, At, Bt) do { __builtin_amdgcn_s_setprio(1); _Pragma("unroll") for (int m = 0; m < 4; ++m) _Pragma("unroll") for (int n = 0; n < 2; ++n) _Pragma("unroll") for (int k = 0; k < 2; ++k) \
        { if constexpr (F16) acc[ai][bj][m][n] = __builtin_amdgcn_mfma_f32_16x16x32_f16(__builtin_bit_cast(f16x8, Bt[n][k]), __builtin_bit_cast(f16x8, At[m][k]), acc[ai][bj][m][n], 0, 0, 0); \
          else acc[ai][bj][m][n] = __builtin_amdgcn_mfma_f32_16x16x32_bf16(Bt[n][k], At[m][k], acc[ai][bj][m][n], 0, 0, 0); } __builtin_amdgcn_s_setprio(0); } while (0)
#define PG8_WAIT_V(n) asm volatile("s_waitcnt vmcnt(" #n ")" ::: "memory")
#define PG8_WAIT_L(n) asm volatile("s_waitcnt lgkmcnt(" #n ")" ::: "memory")
#define PG8_WAIT_VR do { if constexpr (Epi::NSTORE == 16) { const int rlx_ = __builtin_amdgcn_readfirstlane((int)(t == 0) & (int)(ui > 0)); \
        asm volatile("s_cmp_lg_u32 %0, 0\n\ts_cbranch_scc1 .Lrlx%=\n\ts_waitcnt vmcnt(8)\n.Lrlx%=:\n\ts_waitcnt vmcnt(24)" :: "s"(rlx_) : "scc", "memory"); } else PG8_WAIT_V(8); } while (0)
#define PG8_BAR __builtin_amdgcn_s_barrier()
#define PG8_SCHED __builtin_amdgcn_sched_barrier(0)
#define PG8_AT(t) ((t) >= wrapA ? (t) - wrapA : (t))
    Unit cur, nxt; int ui = 0;
    if (!S.next(0, cur)) return;
    f32x4 acc[2][2][4][2];
#pragma unroll
    for (int a = 0; a < 2; ++a)
#pragma unroll
        for (int b = 0; b < 2; ++b)
#pragma unroll
            for (int m = 0; m < 4; ++m)
#pragma unroll
                for (int n = 0; n < 2; ++n) acc[a][b][m][n] = (f32x4){0.f, 0.f, 0.f, 0.f};
    bf16x8 At[4][2], B0[2][2], B1[2][2];
    const char* cA = (const char*)g.A + (size_t)cur.pm * tsA; const char* cB = (const char*)g.Bt + (size_t)cur.pn * tsB;
    PG8_STAGE(PG8_SB(0, 0), cB, voffB); PG8_STAGE(PG8_SB(0, 1), cB + hsB, voffB); PG8_STAGE(PG8_SA(0, 0), cA, voffA); PG8_STAGE(PG8_SA(0, 1), cA + hsA, voffA);
    if (wr == 1) PG8_BAR;
    PG8_WAIT_V(2); PG8_BAR;
    PG8_STAGE(PG8_SB(1, 0), cB + kstep, voffB); PG8_STAGE(PG8_SA(1, 0), cA + kstepA, voffA); PG8_STAGE(PG8_SB(1, 1), cB + hsB + kstep, voffB);
    PG8_WAIT_V(6); PG8_BAR;
    for (;;) {
        asm volatile("" : "+v"(voffA[0]), "+v"(voffA[1]), "+v"(voffB[0]), "+v"(voffB[1]));
        const bool has_next = S.next(ui + 1, nxt);
        const char* nA = has_next ? (const char*)g.A + (size_t)nxt.pm * tsA : cA; const char* nB = has_next ? (const char*)g.Bt + (size_t)nxt.pn * tsB : cB;
        for (int t = 0; t < nt; t += 2) {
            const bool last = (t == nt - 2);
            const char* a1 = cA + (size_t)PG8_AT(t + 1) * kstepA;
            const char* a2 = last ? nA : cA + (size_t)PG8_AT(t + 2) * kstepA; const char* b2 = last ? nB : cB + (size_t)(t + 2) * kstep;
            const char* a3 = a2 + kstepA; const char* b3 = b2 + kstep;
            if constexpr (Epi::MID) { if (t == E.tmid) E.mid(acc, cur, wr, wc, fr, fq); }
            PG8_LDB(B0, 0, 0); PG8_LDB(B1, 0, 1); PG8_SCHED; PG8_LDA(At, 0, 0); PG8_STAGE(PG8_SA(1, 1), a1 + hsA, voffA);
            PG8_WAIT_VR; PG8_WAIT_L(0); PG8_BAR; PG8_MMA(0, 0, At, B0); PG8_MMA(0, 1, At, B1); PG8_BAR; PG8_SCHED;
            PG8_LDA(At, 0, 1); PG8_STAGE(PG8_SB(0, 0), b2, voffB); PG8_STAGE(PG8_SB(0, 1), b2 + hsB, voffB); PG8_STAGE(PG8_SA(0, 0), a2, voffA);
            PG8_WAIT_VR; PG8_WAIT_L(0); PG8_BAR; PG8_MMA(1, 0, At, B0); PG8_MMA(1, 1, At, B1); PG8_BAR; PG8_SCHED;
            PG8_LDB(B0, 1, 0); PG8_LDB(B1, 1, 1); PG8_SCHED; PG8_LDA(At, 1, 0); PG8_STAGE(PG8_SA(0, 1), a2 + hsA, voffA);
            PG8_WAIT_V(8); PG8_WAIT_L(0); PG8_BAR; PG8_MMA(0, 0, At, B0); PG8_MMA(0, 1, At, B1); PG8_BAR; PG8_SCHED;
            PG8_LDA(At, 1, 1); PG8_STAGE(PG8_SB(1, 0), b3, voffB); PG8_STAGE(PG8_SB(1, 1), b3 + hsB, voffB); PG8_STAGE(PG8_SA(1, 0), a3, voffA);
            PG8_WAIT_V(8); PG8_WAIT_L(0); PG8_BAR; PG8_MMA(1, 0, At, B0); PG8_MMA(1, 1, At, B1); PG8_BAR; PG8_SCHED;
        }
        if constexpr (ALIGN_EPI) { if (wr == 0) PG8_BAR; }
#ifdef TS_GEMM
        { const unsigned long long te0_ = __builtin_amdgcn_s_memtime(); E(acc, cur, wr, wc, fr, fq); asm volatile("s_waitcnt vmcnt(0)" ::: "memory"); if (E.tsp) *E.tsp += __builtin_amdgcn_s_memtime() - te0_; }
#else
        E(acc, cur, wr, wc, fr, fq);
#endif
        if (!has_next) break;
#pragma unroll
        for (int a = 0; a < 2; ++a)
#pragma unroll
            for (int b = 0; b < 2; ++b)
#pragma unroll
                for (int m = 0; m < 4; ++m)
#pragma unroll
                    for (int n = 0; n < 2; ++n) acc[a][b][m][n] = (f32x4){0.f, 0.f, 0.f, 0.f};
        cur = nxt; cA = nA; cB = nB; ++ui;
        if constexpr (ALIGN_EPI) { if (wr == 1) PG8_BAR; }
    }
    PG8_WAIT_V(0);
    if constexpr (!ALIGN_EPI) { if (wr == 0) PG8_BAR; }
    PG8_BAR;
#undef PG8_SA
#undef PG8_SB
#undef PG8_STAGE
#undef PG8_LDA
#undef PG8_LDB
#undef PG8_MMA
#undef PG8_WAIT_V
#undef PG8_WAIT_L
#undef PG8_WAIT_VR
#undef PG8_BAR
#undef PG8_SCHED
#undef PG8_AT
}
}

constexpr int NWAVES = 8;
constexpr int NPHASE = 8;
constexpr int N_LAUNCHES = MK_N_LAUNCHES;
constexpr int BATCH = 16, SEQ = 2048, DM = 1024, M = BATCH * SEQ;
constexpr int D_SSM = 512, NG = 32, GC = 16, NP = 64, D_ATT = 512, HD = 64, NH = 8, IH = 8, ID = 64, TOPK = 256, DFF = 4096, D_IN = 1864;
constexpr int N_PLAIN = 1280, N_IDX_PAD = 768;
constexpr float EPS = 1e-6f;
constexpr float IDX_SCALE = 0.125f * 0.35355339059327373f;

constexpr size_t MiB = 1u << 20;
constexpr size_t WS_CTL = 0, CTL_ZERO_BYTES = 64 * 1024;
constexpr size_t WS_MODP = 1 * MiB;
constexpr size_t WS_MOD = 4 * MiB;
constexpr size_t WS_BIAS2 = 4 * MiB + 512 * 1024;
constexpr size_t WS_SSQS = 5 * MiB;
constexpr size_t WS_SSQ2 = 6 * MiB;
constexpr size_t WS_SSQA = 35 * MiB + 512 * 1024;
constexpr size_t WS_WINP = 8 * MiB;
constexpr size_t WS_WINI = 11 * MiB;
constexpr size_t WS_WGLU = 16 * MiB;
constexpr size_t WS_WOUT = 17 * MiB;
constexpr size_t WS_W1 = 19 * MiB;
constexpr size_t WS_W2 = 27 * MiB;
constexpr size_t WS_SSMP = 35 * MiB;
constexpr size_t WS_U = 36 * MiB;
constexpr size_t WS_Q = 68 * MiB;
constexpr size_t WS_A2 = 36 * MiB;
constexpr size_t WS_XN = 100 * MiB;
constexpr size_t WS_X1 = 100 * MiB;
constexpr size_t WS_KV = 228 * MiB;
constexpr size_t WS_KI = 244 * MiB;
constexpr size_t WS_WI = 252 * MiB;
constexpr size_t WS_QI = 256 * MiB;
constexpr size_t WS_Z = 320 * MiB;
constexpr size_t WS_MIX = 352 * MiB;
constexpr size_t WS_H = 256 * MiB;
constexpr size_t WS_SSMF = 416 * MiB;
constexpr size_t WS_END = 512 * MiB;
constexpr int CW_BAR = 4096;

constexpr int RING_OFF = 0;
constexpr int WAVE_LDS = 17920;
constexpr int BM_OFF = 131072;
constexpr int XCH_OFF = 147456;
constexpr int LDSCTL_OFF = 155648, MISC_OFF = LDSCTL_OFF + 320;
constexpr int LDS_BYTES = 159744;

#define GAS __attribute__((address_space(1)))
#define LAS __attribute__((address_space(3)))
typedef unsigned short bf16;
typedef unsigned v4u __attribute__((ext_vector_type(4)));
typedef unsigned v2u __attribute__((ext_vector_type(2)));
typedef float f32x4 __attribute__((ext_vector_type(4)));
typedef float f32x2 __attribute__((ext_vector_type(2)));
typedef GAS unsigned gu32;
#define RLX_AGENT __ATOMIC_RELAXED, __HIP_MEMORY_SCOPE_AGENT
#define LDS_WAIT() asm volatile("s_waitcnt lgkmcnt(0)" ::: "memory")
#define VM_WAIT() asm volatile("s_waitcnt vmcnt(0)" ::: "memory")
__device__ __forceinline__ unsigned f2bf(float f) { unsigned u = __builtin_bit_cast(unsigned, f); return (u + 0x7fffu + ((u >> 16) & 1u)) >> 16; }
__device__ __forceinline__ unsigned pk2(float lo, float hi) { return f2bf(lo) | (f2bf(hi) << 16); }
typedef __bf16 bf16x2_t __attribute__((ext_vector_type(2)));
__device__ __forceinline__ unsigned cvtpk(float lo, float hi) { const f32x2 v = {lo, hi}; return __builtin_bit_cast(unsigned, __builtin_convertvector(v, bf16x2_t)); }
typedef _Float16 f16x2_t __attribute__((ext_vector_type(2)));
__device__ __forceinline__ unsigned pkh(float lo, float hi) { const f16x2_t v = {(_Float16)lo, (_Float16)hi}; return __builtin_bit_cast(unsigned, v); }
__device__ __forceinline__ float bf2f(unsigned h) { return __builtin_bit_cast(float, h << 16); }
__device__ __forceinline__ float bflo(unsigned w) { return __builtin_bit_cast(float, w << 16); }
__device__ __forceinline__ float bfhi(unsigned w) { return __builtin_bit_cast(float, w & 0xffff0000u); }

#define XB_TMO      128
#define XB_XCNT(j)  (256  + 64 * (j))
#define XB_XSUB(j)  (1280 + 64 * (j))
#define XB_XGEN(j)  (2304 + 64 * (j))
#define XB_TOP      3328
#define XB_TOPGEN   3392
#define XCD_BAR_WORDS 3456
#define XB_SPIN_CAP (1u << 18)
__device__ __forceinline__ unsigned xb_ld(unsigned* p)              { return __hip_atomic_load(p, __ATOMIC_RELAXED, __HIP_MEMORY_SCOPE_AGENT); }
__device__ __forceinline__ unsigned xb_add(unsigned* p, unsigned v) { return __hip_atomic_fetch_add(p, v, __ATOMIC_RELAXED, __HIP_MEMORY_SCOPE_AGENT); }
__device__ __forceinline__ unsigned xb_xcc_id() { return (unsigned)__builtin_amdgcn_s_getreg((3 << 11) | 20) & 0xFu; }
#define XB_SPIN(cond, bar) do { unsigned _sp = 0; while (cond) { __builtin_amdgcn_s_sleep(1); \
    if ((++_sp & 255u) == 0u) { if (xb_ld(&(bar)[XB_TMO])) break; if (_sp > XB_SPIN_CAP) { atomicAdd(&(bar)[XB_TMO], 1u); break; } } } } while (0)
struct XcdBarrier { unsigned* bar; unsigned x; volatile LAS unsigned* st; };
__device__ __forceinline__ XcdBarrier xcd_barrier_post(unsigned* bar, volatile LAS unsigned* st) {
    XcdBarrier b; b.bar = bar; b.x = xb_xcc_id(); b.st = st;
    if (threadIdx.x == 0) (void)xb_add(&bar[XB_XCNT(b.x)], 1u);
    return b;
}
__device__ __forceinline__ void xcd_barrier_complete(unsigned* bar, unsigned x, unsigned& nloc, unsigned& nx) {
    const unsigned G = gridDim.x * gridDim.y * gridDim.z;
    unsigned sum, cnt, mine, sp = 0u;
    for (;;) {
        sum = 0u; cnt = 0u; mine = 0u;
#pragma unroll
        for (unsigned j = 0; j < 16; ++j) { const unsigned c = xb_ld(&bar[XB_XCNT(j)]); sum += c; cnt += (c > 0u) ? 1u : 0u; mine = (j == x) ? c : mine; }
        if (sum == G) break;
        __builtin_amdgcn_s_sleep(1);
        if ((++sp & 255u) == 0u) { if (xb_ld(&bar[XB_TMO])) break; if (sp > XB_SPIN_CAP) { atomicAdd(&bar[XB_TMO], 1u); break; } }
    }
    nloc = mine > 0u ? mine : 1u; nx = cnt > 0u ? cnt : 1u;
}
__device__ __forceinline__ void xcd_barrier(const XcdBarrier& b) {
    asm volatile("s_waitcnt vmcnt(0)" ::: "memory");
    __syncthreads();
    if (threadIdx.x == 0) {
        unsigned* bar = b.bar;
        __builtin_amdgcn_s_waitcnt(0);
        unsigned nloc = b.st[0], nx = b.st[1];
        if (nloc == 0u) { xcd_barrier_complete(bar, b.x, nloc, nx); b.st[0] = nloc; b.st[1] = nx; }
        const unsigned old = xb_add(&bar[XB_XSUB(b.x)], 1u);
        const unsigned gen = old / nloc;
        if (old + 1u == (gen + 1u) * nloc) {
            __builtin_amdgcn_fence(__ATOMIC_RELEASE, "agent");
            asm volatile("s_waitcnt vmcnt(0)" ::: "memory");
            const unsigned og = xb_add(&bar[XB_TOP], 1u);
            const unsigned tg = og / nx;
            if (og + 1u == (tg + 1u) * nx) xb_add(&bar[XB_TOPGEN], 1u);
            else XB_SPIN(xb_ld(&bar[XB_TOPGEN]) == tg, bar);
            __builtin_amdgcn_fence(__ATOMIC_ACQUIRE, "agent");
            xb_add(&bar[XB_XGEN(b.x)], 1u);
            asm volatile("s_waitcnt vmcnt(0)" ::: "memory");
        } else {
            XB_SPIN(xb_ld(&bar[XB_XGEN(b.x)]) == gen, bar);
            __builtin_amdgcn_fence(__ATOMIC_ACQUIRE, "agent");
            asm volatile("s_waitcnt vmcnt(0)" ::: "memory");
        }
    }
    __syncthreads();
}

#ifdef TS_PROBE
#define TS_T0() const unsigned long long ts0_ = __builtin_amdgcn_s_memtime()
#define TS_ACC(k) do { if ((k) == TS_PROBE) F.tsacc += __builtin_amdgcn_s_memtime() - ts0_; } while (0)
#else
#define TS_T0() do {} while (0)
#define TS_ACC(k) do {} while (0)
#endif
struct Frame {
    unsigned long long tsacc;
    LAS unsigned char* lds;
    volatile LAS unsigned* MISC;
    gu32* ctl;
    int tid, lane, wave;
    int vcu, G;
    const float *x, *c, *norm1_g, *norm2_g, *w_ada, *b_ada, *w_in, *lam_re, *lam_im, *log_dt, *b_re, *b_im, *c_re, *c_im, *d_skip, *w_glu, *b_glu, *q_gain, *k_gain, *gn_ssm, *gn_attn, *w_out, *w_ff1, *w_ff2;
    float* out;
    float *MODP, *MOD, *BIAS2, *SSQS, *SSQ2, *SSQA, *WI; bf16* X1;
    bf16 *KI2, *QI2, *SSMF;
    f32x2 *LAMB, *BBAR;
    bf16 *WINP, *WINI, *WGLU, *WOUT, *W1, *W2, *U, *Q, *A2, *XN, *KV, *Z, *MIX, *H;
};

__device__ __forceinline__ float wave_sum(float v) {
#pragma unroll
    for (int o = 1; o < 64; o <<= 1) v += __shfl_xor(v, o);
    return v;
}
__device__ __forceinline__ float wave_max(float v) {
#pragma unroll
    for (int o = 1; o < 64; o <<= 1) v = fmaxf(v, __shfl_xor(v, o));
    return v;
}
__device__ __forceinline__ int wave_sum_i(int v) {
#pragma unroll
    for (int o = 1; o < 64; o <<= 1) v += __shfl_xor(v, o);
    return v;
}

__device__ __forceinline__ double exp_d(double x) {
    const double n = __builtin_rint(x * 1.4426950408889634);
    const double r = (x - n * 0.693147180369123816490e+00) - n * 1.90821492927058770002e-10;
    double p = 1.0 / 87178291200.0;
    p = p * r + 1.0 / 6227020800.0; p = p * r + 1.0 / 479001600.0; p = p * r + 1.0 / 39916800.0; p = p * r + 1.0 / 3628800.0; p = p * r + 1.0 / 362880.0;
    p = p * r + 1.0 / 40320.0; p = p * r + 1.0 / 5040.0; p = p * r + 1.0 / 720.0; p = p * r + 1.0 / 120.0; p = p * r + 1.0 / 24.0; p = p * r + 1.0 / 6.0; p = p * r + 0.5; p = p * r + 1.0; p = p * r + 1.0;
    const long long e = (long long)n + 1023;
    return p * __builtin_bit_cast(double, (unsigned long long)e << 52);
}
__device__ __forceinline__ void sincos_d(double x, double& s, double& c) {
    const double n = __builtin_rint(x * 0.63661977236758134308);
    double r = (x - n * 1.57079632673412561417e+00) - n * 6.07710050650619224932e-11;
    r = r - n * 2.02226624879595063154e-21;
    const double r2 = r * r;
    double sp = -1.0 / 1307674368000.0;
    sp = sp * r2 + 1.0 / 6227020800.0; sp = sp * r2 - 1.0 / 39916800.0; sp = sp * r2 + 1.0 / 362880.0; sp = sp * r2 - 1.0 / 5040.0; sp = sp * r2 + 1.0 / 120.0; sp = sp * r2 - 1.0 / 6.0; sp = sp * r2 + 1.0;
    const double sr = sp * r;
    double cp = 1.0 / 20922789888000.0;
    cp = cp * r2 - 1.0 / 87178291200.0; cp = cp * r2 + 1.0 / 479001600.0; cp = cp * r2 - 1.0 / 3628800.0; cp = cp * r2 + 1.0 / 40320.0; cp = cp * r2 - 1.0 / 720.0; cp = cp * r2 + 1.0 / 24.0; cp = cp * r2 - 0.5; cp = cp * r2 + 1.0;
    const long long q = (long long)n & 3;
    s = (q == 0) ? sr : (q == 1) ? cp : (q == 2) ? -sr : -cp;
    c = (q == 0) ? cp : (q == 1) ? -sr : (q == 2) ? -cp : sr;
}

template <int MODE>
__device__ __forceinline__ void p0_transpose_item(Frame& F, const float* W, int K, int N, bf16* WT, LAS float* scr, int item, int lane) {
    const int nblk = (N + 31) / 32, kb = item / nblk, nb = item % nblk, k0 = 64 * kb, n0 = 32 * nb;
    const int kr = lane >> 3, nq = 4 * (lane & 7);
    f32x4 ld[8];
#pragma unroll
    for (int i = 0; i < 8; ++i) { const int k = 8 * i + kr; ld[i] = (MODE != 1 || n0 + nq < N) ? *(const f32x4*)(W + (size_t)(k0 + k) * N + n0 + nq) : (f32x4){0.f, 0.f, 0.f, 0.f}; }
#pragma unroll
    for (int i = 0; i < 8; ++i) { const int k = 8 * i + kr; f32x4 v = ld[i];
        if (MODE == 2) { const int kk = k0 + k; v = v * ((kk < D_SSM) ? F.gn_ssm[kk] : F.gn_attn[kk - D_SSM]); }
        scr[k * 33 + nq] = v.x; scr[k * 33 + nq + 1] = v.y; scr[k * 33 + nq + 2] = v.z; scr[k * 33 + nq + 3] = v.w; }
    LDS_WAIT(); asm volatile("" ::: "memory");
    const int c = lane & 7;
#pragma unroll
    for (int j = 0; j < 4; ++j) { const int n = (lane >> 3) + 8 * j; const LAS float* sp = scr + (8 * c) * 33 + n;
        float v[8];
#pragma unroll
        for (int e = 0; e < 8; ++e) v[e] = sp[e * 33];
        v4u o;
        if (MODE == 1) { o.x = pkh(v[0], v[1]); o.y = pkh(v[2], v[3]); o.z = pkh(v[4], v[5]); o.w = pkh(v[6], v[7]); }
        else { o.x = pk2(v[0], v[1]); o.y = pk2(v[2], v[3]); o.z = pk2(v[4], v[5]); o.w = pk2(v[6], v[7]); }
        *(GAS v4u*)(WT + (size_t)(n0 + n) * K + k0 + 8 * c) = o; }
    LDS_WAIT(); asm volatile("" ::: "memory");
}

__device__ __forceinline__ void p0_mod_item(Frame& F, int item, LAS float* scr) {
    const int cg = item >> 3, ks = item & 7, j = cg * 64 + F.lane, k0 = ks * 128;
#pragma unroll 1
    for (int hq = 0; hq < 4; ++hq) { float cvv[8];
#pragma unroll
      for (int q8 = 0; q8 < 8; ++q8) { const int q = 8 * hq + q8; const float* cb_ = F.c + (q >> 1) * 1024 + k0 + 64 * (q & 1); cvv[q8] = cb_[F.lane]; }
#pragma unroll
      for (int q8 = 0; q8 < 8; ++q8) scr[F.lane + 64 * (8 * hq + q8)] = cvv[q8] * __builtin_amdgcn_rcpf(1.f + __expf(-cvv[q8])); }
    LDS_WAIT(); asm volatile("" ::: "memory");
    float acc[16];
#pragma unroll
    for (int b = 0; b < 16; ++b) acc[b] = 0.f;
#pragma unroll 1
    for (int hf = 0; hf < 4; ++hf) {
        float wv[32];
#pragma unroll
        for (int i = 0; i < 32; ++i) { const float* rowb = F.w_ada + (size_t)(k0 + 32 * hf + i) * 6144; wv[i] = rowb[j]; }
#pragma unroll
        for (int i4 = 0; i4 < 8; ++i4) {
#pragma unroll
            for (int b = 0; b < 16; ++b) { const f32x4 sv = *(const LAS f32x4*)(scr + b * 128 + 32 * hf + 4 * i4); acc[b] += sv.x * wv[4 * i4] + sv.y * wv[4 * i4 + 1] + sv.z * wv[4 * i4 + 2] + sv.w * wv[4 * i4 + 3]; }
            asm volatile("" ::: "memory"); }
    }
#pragma unroll
    for (int b = 0; b < 16; ++b) F.MODP[(size_t)(ks * 16 + b) * 6144 + j] = acc[b];
    LDS_WAIT(); asm volatile("" ::: "memory");
}

__device__ __forceinline__ void p0_ssm_item(Frame& F, int g) {
    const int p = F.lane, gp = g * 64 + p;
    const double lre = (double)F.lam_re[gp], lim = (double)F.lam_im[gp], dt = exp_d((double)F.log_dt[g]);
    double s, c; sincos_d(lim * dt, s, c);
    const double mag = exp_d(lre * dt), lbr = mag * c, lbi = mag * s;
    const double a = lbr - 1.0, b = lbi, den = lre * lre + lim * lim;
    const double cr = (a * lre + b * lim) / den, ci = (b * lre - a * lim) / den;
    F.LAMB[gp] = (f32x2){(float)lbr, (float)lbi};
#pragma unroll
    for (int cc = 0; cc < 16; ++cc) { const double br = (double)F.b_re[gp * 16 + cc], bi = (double)F.b_im[gp * 16 + cc];
        F.BBAR[gp * 16 + cc] = (f32x2){(float)(cr * br - ci * bi), (float)(cr * bi + ci * br)}; }
}

constexpr int I_IN = 16 * 59, I_GLU = 8 * 16, I_OUT = 16 * 32, I_1 = 16 * 128, I_2 = 64 * 32, N_TR_ITEMS = I_IN + I_GLU + I_OUT + I_1 + I_2;
__device__ __forceinline__ void tr_item(Frame& F, int it, LAS float* scr) {
    int r = it;
    if (r < I_IN) { p0_transpose_item<1>(F, F.w_in, 1024, D_IN, F.WINP, scr, r, F.lane); return; } r -= I_IN;
    if (r < I_GLU) { p0_transpose_item<0>(F, F.w_glu, 512, 512, F.WGLU, scr, r, F.lane); return; } r -= I_GLU;
    if (r < I_OUT) { p0_transpose_item<2>(F, F.w_out, 1024, 1024, F.WOUT, scr, r, F.lane); return; } r -= I_OUT;
    if (r < I_1) { p0_transpose_item<0>(F, F.w_ff1, 1024, DFF, F.W1, scr, r, F.lane); return; } r -= I_1;
    p0_transpose_item<0>(F, F.w_ff2, DFF, 1024, F.W2, scr, r, F.lane);
}
__device__ __forceinline__ void p0a_phase(Frame& F) {
    LAS float* scr = (LAS float*)(F.lds + RING_OFF + F.wave * WAVE_LDS);
    const int gw = F.vcu * NWAVES + F.wave, NGW = F.G * NWAVES;
    constexpr int I_MOD = 96 * 8, I_SSM = 32;
    for (int it = gw; it < I_MOD + I_SSM; it += NGW) { if (it < I_MOD) p0_mod_item(F, it, scr); else p0_ssm_item(F, it - I_MOD); }
    if (gw >= I_MOD + I_SSM) { const int NW_ = NGW - (I_MOD + I_SSM);
        for (int it = gw - (I_MOD + I_SSM); it < N_TR_ITEMS; it += NW_) tr_item(F, it, scr);
        { const int gt = (gw - (I_MOD + I_SSM)) * 64 + F.lane, NT = NW_ * 64; GAS v4u* z = (GAS v4u*)(F.WINP + (size_t)1888 * 1024);
          for (int i = gt; i < 160 * 1024 / 8; i += NT) z[i] = (v4u){0u, 0u, 0u, 0u}; } }
}

__device__ __forceinline__ f32x2 cmul(f32x2 a, f32x2 b) { return (f32x2){a.x * b.x - a.y * b.y, a.x * b.y + a.y * b.x}; }
template <int NBITS = 5>
__device__ __forceinline__ f32x2 cpow(f32x2 a, int e) { f32x2 r = {1.f, 0.f}; f32x2 bq = a;
#pragma unroll
    for (int k = 0; k < NBITS; ++k) { if (e & (1 << k)) r = cmul(r, bq); if (k + 1 < NBITS) bq = cmul(bq, bq); }
    return r; }
__device__ __forceinline__ void ssm_frag_item(Frame& F, int item, LAS float* scr) {
    const int g = item / 144, bi = item % 144, lane = F.lane, il = lane & 15, kq = lane >> 4;
    float v[8];
#pragma unroll
    for (int j = 0; j < 8; ++j) v[j] = 0.f;
    if (bi < 16) {
        LAS f32x2* Cs = (LAS f32x2*)scr;
        LAS f32x2* Bs = Cs + 16 * 65;
        LAS f32x2* Pw = Bs + 64 * 16;
        { float cr[16], ci[16]; f32x2 bb[16];
#pragma unroll
          for (int q = 0; q < 16; ++q) { cr[q] = F.c_re[(g * 16 + q) * 64 + lane]; ci[q] = F.c_im[(g * 16 + q) * 64 + lane]; bb[q] = F.BBAR[g * 1024 + q * 64 + lane]; }
          const f32x2 lam = F.LAMB[g * 64 + lane];
#pragma unroll
          for (int q = 0; q < 16; ++q) { Cs[q * 65 + lane] = (f32x2){cr[q], ci[q]}; Bs[q * 64 + lane] = bb[q]; }
          Pw[lane] = cpow(lam, bi); Pw[64 + lane] = (bi > 0) ? cpow(lam, bi - 1) : (f32x2){0.f, 0.f}; }
        LDS_WAIT(); asm volatile("" ::: "memory");
        const LAS f32x2* pwr = Pw + (kq >> 1) * 64; const LAS f32x2* brow = Bs + 8 * (kq & 1);
#pragma unroll 4
        for (int p = 0; p < 64; ++p) {
            const f32x2 cw = cmul(Cs[il * 65 + p], pwr[p]);
#pragma unroll
            for (int j = 0; j < 8; ++j) { const f32x2 bv = brow[p * 16 + j]; v[j] += cw.x * bv.x - cw.y * bv.y; }
        }
        LDS_WAIT(); asm volatile("" ::: "memory");
    } else if (bi < 80) {
        const int e = bi - 16, i = e >> 3, kb = e & 7, R = 16 * i + il, p = R & 63, s_ = 2 * kb + (kq >> 1);
        const f32x2 pw = cpow(F.LAMB[g * 64 + p], 15 - s_);
        const f32x2* bb = F.BBAR + (g * 64 + p) * 16 + 8 * (kq & 1);
#pragma unroll
        for (int j = 0; j < 8; ++j) { const f32x2 wv = cmul(pw, bb[j]); v[j] = (R >= 64) ? wv.y : wv.x; }
    } else {
        const int e = bi - 80, t = e >> 2, ks = e & 3;
#pragma unroll
        for (int j = 0; j < 8; ++j) { const int sg = 16 * (2 * ks + (j >> 2)) + 4 * kq + (j & 3), p = sg & 63;
            const f32x2 pw = cpow(F.LAMB[g * 64 + p], t + 1);
            const f32x2 cw = cmul((f32x2){F.c_re[(g * 16 + il) * 64 + p], F.c_im[(g * 16 + il) * 64 + p]}, pw);
            v[j] = (sg >= 64) ? -cw.y : cw.x; }
    }
    v4u o; o.x = pk2(v[0], v[1]); o.y = pk2(v[2], v[3]); o.z = pk2(v[4], v[5]); o.w = pk2(v[6], v[7]);
    *(GAS v4u*)(F.SSMF + (size_t)item * 512 + lane * 8) = o;
}

__device__ __forceinline__ void p0b_phase(Frame& F) {
    const int w = F.vcu;
    { const int idx = w * 384 + F.tid;
      if (F.tid < 384 && idx < 16 * 6144) { const int j = idx % 6144; float s = F.b_ada[j];
#pragma unroll
          for (int ks = 0; ks < 8; ++ks) s += F.MODP[(size_t)ks * 16 * 6144 + idx];
          F.MOD[idx] = s; } }
    LAS float* sh = (LAS float*)(F.lds + RING_OFF);
    const int rb = w;
    { const int b = rb / 16;
#pragma unroll
      for (int e = F.tid; e < 2048; e += NWAVES * 64) { float s_ = F.b_ada[e];
#pragma unroll
          for (int ks = 0; ks < 8; ++ks) s_ += F.MODP[(size_t)(ks * 16 + b) * 6144 + e];
          sh[e] = s_; } }
    __syncthreads();
    if (F.wave >= 6) {
        LAS float* scr = (LAS float*)(F.lds + RING_OFF + 8192 + (F.wave - 6) * WAVE_LDS);
        const int gwi = F.vcu * 2 + (F.wave - 6), NGWI = F.G * 2;
        for (int it = gwi; it < NG * 144; it += NGWI) ssm_frag_item(F, it, scr);
    } else {
        f32x4 gm[4], sv[4];
#pragma unroll
        for (int j = 0; j < 4; ++j) { const int col = 4 * F.lane + 256 * j; gm[j] = (*(const f32x4*)(F.norm1_g + col)) * (*(const LAS f32x4*)(sh + 1024 + col) + 1.0f); sv[j] = *(const LAS f32x4*)(sh + col); }
        for (int r4 = 4 * F.wave; r4 < 128; r4 += 24) {
            f32x4 v[4][4];
#pragma unroll
            for (int q = 0; q < 4; ++q) { const GAS f32x4* xr = (const GAS f32x4*)(F.x + ((size_t)rb * 128 + r4 + q) * DM) + F.lane;
#pragma unroll
                for (int j = 0; j < 4; ++j) v[q][j] = xr[64 * j]; }
#pragma unroll
            for (int q = 0; q < 4; ++q) {
                const size_t m = (size_t)rb * 128 + r4 + q; float ss = 0.f;
#pragma unroll
                for (int j = 0; j < 4; ++j) ss += (v[q][j].x * v[q][j].x + v[q][j].y * v[q][j].y) + (v[q][j].z * v[q][j].z + v[q][j].w * v[q][j].w);
                const float rstd = __builtin_amdgcn_rsqf(wave_sum(ss) * (1.f / DM) + EPS);
                GAS v2u* oh = (GAS v2u*)(F.XN + m * 1024) + F.lane;
#pragma unroll
                for (int j = 0; j < 4; ++j) { const f32x4 h = (v[q][j] * rstd) * gm[j] + sv[j];
                    oh[64 * j] = (v2u){pkh(h.x, h.y), pkh(h.z, h.w)}; }
            }
        }
    }
}

using pg8::Unit; using pg8::cvt_pk_bf16;
struct EpiIn {
    static constexpr int NSTORE = 0; static constexpr bool PERM = true, MID = false; int tmid; unsigned long long* tsp;
    bf16 *U, *Q, *KV, *QI, *KI; float* WI;
    __device__ __forceinline__ void mid(f32x4 (&)[2][2][4][2], const Unit&, int, int, int, int) const {}
    __device__ __forceinline__ void operator()(const f32x4 (&acc)[2][2][4][2], const Unit& u, int wr, int wc, int fr, int fq) const {
        const int row0 = u.pm * 256 + wr * 64 + fr;
        if (u.pn < 7) {
            bf16* base; int ldc, colt; const bool h16 = u.pn >= 5;
            if (u.pn < 2) { base = U; ldc = 512; colt = u.pn * 256; } else if (u.pn < 4) { base = Q; ldc = 512; colt = (u.pn - 2) * 256; } else if (u.pn == 4) { base = KV; ldc = 256; colt = 0; } else { base = QI; ldc = 512; colt = (u.pn - 5) * 256; }
            const int col0 = colt + wc * 32 + 8 * fq;
#pragma unroll
            for (int ai = 0; ai < 2; ++ai)
#pragma unroll
                for (int m = 0; m < 4; ++m) { bf16* rowp = base + (size_t)(row0 + ai * 128 + m * 16) * ldc + col0;
#pragma unroll
                    for (int bj = 0; bj < 2; ++bj) { const f32x4 v0 = acc[ai][bj][m][0], v1 = acc[ai][bj][m][1];
                        v4u wv;
                        if (h16) { wv.x = pkh(v0[0], v0[1]); wv.y = pkh(v0[2], v0[3]); wv.z = pkh(v1[0], v1[1]); wv.w = pkh(v1[2], v1[3]); }
                        else { wv.x = cvt_pk_bf16(v0[0], v0[1]); wv.y = cvt_pk_bf16(v0[2], v0[3]); wv.z = cvt_pk_bf16(v1[0], v1[1]); wv.w = cvt_pk_bf16(v1[2], v1[3]); }
                        *(v4u*)(rowp + bj * 128) = wv; } }
        } else {
            const int col0 = wc * 32 + 8 * fq;
#pragma unroll
            for (int ai = 0; ai < 2; ++ai)
#pragma unroll
                for (int m = 0; m < 4; ++m) { const size_t row = (size_t)(row0 + ai * 128 + m * 16); const f32x4 v0 = acc[ai][0][m][0], v1 = acc[ai][0][m][1];
                    if (col0 < 64) { v4u wv; wv.x = pkh(v0[0], v0[1]); wv.y = pkh(v0[2], v0[3]); wv.z = pkh(v1[0], v1[1]); wv.w = pkh(v1[2], v1[3]); *(v4u*)(KI + row * 64 + col0) = wv; }
                    else if (col0 == 64) { *(f32x4*)(WI + row * 8) = v0; *(f32x4*)(WI + row * 8 + 4) = v1; } }
        }
    }
};
struct EpiGlu {
    static constexpr int NSTORE = 0; static constexpr bool PERM = true, MID = false; int tmid; unsigned long long* tsp;
    const bf16* Z; bf16* MIX; const float* bglu; float* SSQS;
    __device__ __forceinline__ void mid(f32x4 (&)[2][2][4][2], const Unit&, int, int, int, int) const {}
    __device__ __forceinline__ void operator()(const f32x4 (&acc)[2][2][4][2], const Unit& u, int wr, int wc, int fr, int fq) const {
        const int row0 = u.pm * 256 + wr * 64 + fr, col0 = u.pn * 256 + wc * 32 + 8 * fq;
        f32x4 bg[2][2];
#pragma unroll
        for (int bj = 0; bj < 2; ++bj) { bg[bj][0] = *(const f32x4*)(bglu + col0 + bj * 128); bg[bj][1] = *(const f32x4*)(bglu + col0 + bj * 128 + 4); }
#pragma unroll
        for (int ai = 0; ai < 2; ++ai)
#pragma unroll
            for (int m = 0; m < 4; ++m) { const size_t row = (size_t)(row0 + ai * 128 + m * 16); float ss = 0.f;
#pragma unroll
                for (int bj = 0; bj < 2; ++bj) { const int col = col0 + bj * 128;
                    const v4u zz = *(const v4u*)(Z + row * 512 + col);
                    const f32x4 b0 = bg[bj][0], b1 = bg[bj][1];
                    const f32x4 a0 = acc[ai][bj][m][0] + b0, a1 = acc[ai][bj][m][1] + b1;
                    float zf[8] = {bflo(zz.x), bfhi(zz.x), bflo(zz.y), bfhi(zz.y), bflo(zz.z), bfhi(zz.z), bflo(zz.w), bfhi(zz.w)};
                    float av[8] = {a0[0], a0[1], a0[2], a0[3], a1[0], a1[1], a1[2], a1[3]}, y[8];
#pragma unroll
                    for (int e = 0; e < 8; ++e) { y[e] = zf[e] * __builtin_amdgcn_rcpf(1.f + __expf(-av[e])); ss += y[e] * y[e]; }
                    v4u wv; wv.x = cvt_pk_bf16(y[0], y[1]); wv.y = cvt_pk_bf16(y[2], y[3]); wv.z = cvt_pk_bf16(y[4], y[5]); wv.w = cvt_pk_bf16(y[6], y[7]);
                    *(v4u*)(MIX + row * 1024 + col) = wv; }
                ss += __shfl_xor(ss, 16); ss += __shfl_xor(ss, 32);
                if (fq == 0) SSQS[row * 8 + u.pn * 4 + wc] = ss; }
    }
};
struct EpiOut {
    static constexpr int NSTORE = 0; static constexpr bool PERM = true, MID = true; int tmid; unsigned long long* tsp;
    const float* x; bf16* x1; bf16* A2; const float* MOD; const float* g2n; const float* SSQS; float* SSQ2; const float* SSQA;
    __device__ __forceinline__ void mid(f32x4 (&acc)[2][2][4][2], const Unit& u, int wr, int wc, int fr_, int fq_) const {
        int fr = fr_, fq = fq_; asm volatile("" : "+v"(fr), "+v"(fq));
#pragma unroll
        for (int ai = 0; ai < 2; ++ai)
#pragma unroll
            for (int m = 0; m < 4; ++m) { const size_t row = (size_t)(u.pm * 256 + ai * 128 + wr * 64 + m * 16 + fr);
                const f32x4 p = *(const f32x4*)(SSQS + row * 8 + 4 * (fq & 1)); float s = (p.x + p.y) + (p.z + p.w); s += __shfl_xor(s, 16);
                const f32x2 sa = *(const f32x2*)(SSQA + row * 2);
                const float rstd = __builtin_amdgcn_sqrtf((sa.x + sa.y) * (1.f / 512.f) + EPS) * __builtin_amdgcn_rsqf(s * (1.f / 512.f) + EPS);
#pragma unroll
                for (int bj = 0; bj < 2; ++bj)
#pragma unroll
                    for (int n = 0; n < 2; ++n) acc[ai][bj][m][n] *= rstd; }
    }
    __device__ __forceinline__ void operator()(const f32x4 (&acc)[2][2][4][2], const Unit& u, int wr, int wc, int fr_, int fq_) const {
        int fr = fr_, fq = fq_; asm volatile("" : "+v"(fr), "+v"(fq));
        const int b = u.pm >> 3; const float* mod = MOD + (size_t)b * 6144;
        const int row0 = u.pm * 256 + wr * 64 + fr, col0 = u.pn * 256 + wc * 32 + 8 * fq;
        f32x4 g1v[2][2], g2v[2][2];
#pragma unroll
        for (int bj = 0; bj < 2; ++bj)
#pragma unroll
            for (int n = 0; n < 2; ++n) { const int c4 = col0 + bj * 128 + 4 * n; g1v[bj][n] = *(const f32x4*)(mod + 2048 + c4); g2v[bj][n] = (*(const f32x4*)(g2n + c4)) * (*(const f32x4*)(mod + 4096 + c4) + 1.0f); }
        f32x4 xv[2][2][2]; f32x2 sav[2];
#define EPO_LOAD(slot, rg) do { const size_t row_ = (size_t)(row0 + ((rg) >> 2) * 128 + ((rg) & 3) * 16); sav[slot] = *(const f32x2*)(SSQA + row_ * 2); \
        _Pragma("unroll") for (int bj = 0; bj < 2; ++bj) _Pragma("unroll") for (int n = 0; n < 2; ++n) xv[slot][bj][n] = *(const f32x4*)(x + row_ * 1024 + col0 + bj * 128 + 4 * n); } while (0)
        EPO_LOAD(0, 0);
#pragma unroll
        for (int rg = 0; rg < 8; ++rg) { const int ai = rg >> 2, m = rg & 3, sl = rg & 1;
            if (rg + 1 < 8) { if (sl == 0) EPO_LOAD(1, rg + 1); else EPO_LOAD(0, rg + 1); }
            const size_t row = (size_t)(row0 + ai * 128 + m * 16); float ss = 0.f;
            const float ra = __builtin_amdgcn_rsqf((sav[sl].x + sav[sl].y) * (1.f / 512.f) + EPS);
#pragma unroll
            for (int bj = 0; bj < 2; ++bj) { const int col = col0 + bj * 128; float a2[8]; float x8[8];
#pragma unroll
                for (int n = 0; n < 2; ++n) { const int c4 = col + 4 * n;
                    const f32x4 v = xv[sl][bj][n] + g1v[bj][n] * (acc[ai][bj][m][n] * ra);
                    x8[4 * n] = v.x; x8[4 * n + 1] = v.y; x8[4 * n + 2] = v.z; x8[4 * n + 3] = v.w; ss += (v.x * v.x + v.y * v.y) + (v.z * v.z + v.w * v.w);
                    const f32x4 a = v * g2v[bj][n]; a2[4 * n] = a.x; a2[4 * n + 1] = a.y; a2[4 * n + 2] = a.z; a2[4 * n + 3] = a.w; }
                v4u wv; wv.x = cvt_pk_bf16(a2[0], a2[1]); wv.y = cvt_pk_bf16(a2[2], a2[3]); wv.z = cvt_pk_bf16(a2[4], a2[5]); wv.w = cvt_pk_bf16(a2[6], a2[7]);
                *(v4u*)(A2 + row * 1024 + col) = wv;
                v4u xw; xw.x = cvt_pk_bf16(x8[0], x8[1]); xw.y = cvt_pk_bf16(x8[2], x8[3]); xw.z = cvt_pk_bf16(x8[4], x8[5]); xw.w = cvt_pk_bf16(x8[6], x8[7]);
                *(v4u*)(x1 + row * 1024 + col) = xw; }
            ss += __shfl_xor(ss, 16); ss += __shfl_xor(ss, 32);
            if (fq == 0) SSQ2[row * 16 + u.pn * 4 + wc] = ss;
            asm volatile("" ::: "memory"); }
#undef EPO_LOAD
    }
};
struct EpiUp {
    static constexpr int NSTORE = 16; static constexpr bool PERM = true, MID = false; int tmid; unsigned long long* tsp;
    const LAS float* lrs; const LAS float* lbias; bf16* H;
    __device__ __forceinline__ void mid(f32x4 (&)[2][2][4][2], const Unit&, int, int, int, int) const {}
    __device__ __forceinline__ void operator()(const f32x4 (&acc)[2][2][4][2], const Unit& u, int wr, int wc, int fr_, int fq_) const {
        int fr = fr_, fq = fq_; asm volatile("" : "+v"(fr), "+v"(fq));
        const int r0 = wr * 64 + fr, col0 = u.pn * 256 + wc * 32 + 8 * fq;
        const LAS float* rs = lrs + u.idx * 256; const LAS float* bs = lbias + u.idx * 256 + wc * 32 + 8 * fq;
        f32x4 bv[2][2];
#pragma unroll
        for (int bj = 0; bj < 2; ++bj)
#pragma unroll
            for (int n = 0; n < 2; ++n) bv[bj][n] = *(const LAS f32x4*)(bs + bj * 128 + 4 * n);
#pragma unroll
        for (int ai = 0; ai < 2; ++ai)
#pragma unroll
            for (int m = 0; m < 4; ++m) { const int rl = r0 + ai * 128 + m * 16;
                const float rstd = rs[rl];
#pragma unroll
                for (int bj = 0; bj < 2; ++bj) { f32x4 v0 = acc[ai][bj][m][0] * rstd + bv[bj][0], v1 = acc[ai][bj][m][1] * rstd + bv[bj][1];
                    float h[8] = {v0[0], v0[1], v0[2], v0[3], v1[0], v1[1], v1[2], v1[3]};
#pragma unroll
                    for (int e = 0; e < 8; ++e) { const float r = fmaxf(h[e], 0.f); h[e] = r * r; }
                    v4u wv; wv.x = cvt_pk_bf16(h[0], h[1]); wv.y = cvt_pk_bf16(h[2], h[3]); wv.z = cvt_pk_bf16(h[4], h[5]); wv.w = cvt_pk_bf16(h[6], h[7]);
                    const int c_ = col0 + bj * 128;
                    *(v4u*)(H + (size_t)u.pm * (256 * DFF) + (size_t)(c_ >> 6) * (256 * 64) + (size_t)rl * 64 + (c_ & 63)) = wv; } }
    }
};
template <class Sched>
__device__ __forceinline__ void up_tables(const Sched& S, const float* SSQ2, const float* BIAS2, LAS float* lrs, LAS float* lbias) {
    const int t = threadIdx.x;
#pragma unroll 1
    for (int i = 0; i < 8; ++i) { Unit u; if (!S.next(i, u)) break;
        if (t < 256) { const float* p = SSQ2 + ((size_t)u.pm * 256 + t) * 16; const f32x4 a = *(const f32x4*)p, b = *(const f32x4*)(p + 4), c = *(const f32x4*)(p + 8), d = *(const f32x4*)(p + 12);
            const float s = (((a.x + a.y) + (a.z + a.w)) + ((b.x + b.y) + (b.z + b.w))) + (((c.x + c.y) + (c.z + c.w)) + ((d.x + d.y) + (d.z + d.w)));
            lrs[i * 256 + t] = __builtin_amdgcn_rsqf(s * (1.f / 1024.f) + EPS); }
        else lbias[i * 256 + (t - 256)] = BIAS2[(size_t)(u.pm >> 3) * DFF + u.pn * 256 + (t - 256)]; }
    __syncthreads();
}
struct EpiDown {
    static constexpr int NSTORE = 0; static constexpr bool PERM = false, MID = false; int tmid; unsigned long long* tsp;
    float* out; const bf16* X1; const float* MOD; float pscale;
    __device__ __forceinline__ void mid(f32x4 (&)[2][2][4][2], const Unit&, int, int, int, int) const {}
    __device__ __forceinline__ void operator()(const f32x4 (&acc)[2][2][4][2], const Unit& u, int wr, int wc, int fr, int fq) const {
        const int b = u.pm >> 3; const float* g2 = MOD + (size_t)b * 6144 + 5120;
        const int row0 = u.pm * 256 + wr * 64 + fr, col0 = u.pn * 256 + wc * 32 + 4 * fq;
        f32x4 gv[2][2];
#pragma unroll
        for (int bj = 0; bj < 2; ++bj)
#pragma unroll
            for (int n = 0; n < 2; ++n) gv[bj][n] = *(const f32x4*)(g2 + col0 + bj * 128 + n * 16);
#pragma unroll
        for (int ai = 0; ai < 2; ++ai)
#pragma unroll
            for (int m = 0; m < 4; ++m) { float* rowp = out + (size_t)(row0 + ai * 128 + m * 16) * 1024 + col0; const bf16* xrow = X1 + (size_t)(row0 + ai * 128 + m * 16) * 1024 + col0;
#pragma unroll
                for (int bj = 0; bj < 2; ++bj)
#pragma unroll
                    for (int n = 0; n < 2; ++n) { const v2u xb = *(const v2u*)(xrow + bj * 128 + n * 16); const f32x4 x1 = {bflo(xb.x), bfhi(xb.x), bflo(xb.y), bfhi(xb.y)};
#if defined(TS_PROBE) || defined(TS_GEMM)
                        *(f32x4*)(rowp + bj * 128 + n * 16) = (x1 + gv[bj][n] * acc[ai][bj][m][n]) * pscale;
#else
                        *(f32x4*)(rowp + bj * 128 + n * 16) = x1 + gv[bj][n] * acc[ai][bj][m][n];
#endif
                    } }
    }
};

__device__ __forceinline__ float gelu_tanh(float v) {
    const float a2 = (2.0f * 0.7978845608028654f) * (v + 0.044715f * v * v * v);
    return v * __builtin_amdgcn_rcpf(1.0f + __expf(-a2));
}
__device__ __forceinline__ void bias2_wg(Frame& F, int cg) {
    LAS float* sh2 = (LAS float*)(F.lds);
    LAS float* red = (LAS float*)(F.lds + 16 * 1028 * 4);
    __syncthreads();
#pragma unroll 1
    for (int e0 = 0; e0 < 16 * 1024; e0 += 8 * NWAVES * 64) { float t_[8];
#pragma unroll
        for (int q = 0; q < 8; ++q) { const int e = e0 + q * NWAVES * 64 + F.tid; t_[q] = F.MOD[(size_t)(e >> 10) * 6144 + 3072 + (e & 1023)]; }
#pragma unroll
        for (int q = 0; q < 8; ++q) { const int e = e0 + q * NWAVES * 64 + F.tid; sh2[(e >> 10) * 1028 + (e & 1023)] = t_[q]; } }
    __syncthreads();
    const int n = cg * 16 + (F.lane & 15), kk = F.lane >> 4, k0 = F.wave * 128 + kk * 32;
    float acc[16];
#pragma unroll
    for (int bq = 0; bq < 16; ++bq) acc[bq] = 0.f;
    const float* wp0 = F.w_ff1 + (size_t)k0 * DFF + n;
    float w0 = wp0[0], w1 = wp0[DFF], w2 = wp0[2 * DFF], w3 = wp0[3 * DFF];
#pragma unroll 1
    for (int i4 = 0; i4 < 8; ++i4) {
        const float* wp = wp0 + (size_t)(4 * ((i4 + 1) & 7)) * DFF;
        const float x0 = wp[0], x1 = wp[DFF], x2 = wp[2 * DFF], x3 = wp[3 * DFF];
#pragma unroll
        for (int bq = 0; bq < 16; ++bq) { const f32x4 sv = *(const LAS f32x4*)(sh2 + bq * 1028 + k0 + 4 * i4); acc[bq] += sv.x * w0 + sv.y * w1 + sv.z * w2 + sv.w * w3; }
        w0 = x0; w1 = x1; w2 = x2; w3 = x3;
    }
#pragma unroll
    for (int bq = 0; bq < 16; ++bq) { float a = acc[bq]; a += __shfl_xor(a, 16); a += __shfl_xor(a, 32); if (kk == 0) red[(F.wave * 16 + bq) * 16 + (F.lane & 15)] = a; }
    __syncthreads();
    if (F.tid < 256) { const int bq = F.tid >> 4, c = F.tid & 15; float sum = 0.f;
#pragma unroll
        for (int v = 0; v < 8; ++v) sum += red[(v * 16 + bq) * 16 + c];
        F.BIAS2[(size_t)bq * DFF + cg * 16 + c] = sum; }
    __syncthreads();
}
typedef short bf16x8s __attribute__((ext_vector_type(8)));
__device__ __forceinline__ void ssm_unit(Frame& F, int g, int bp) {
    const int lane = F.lane, w = F.wave, n = lane & 15, rq = lane >> 4, tid = F.tid;
    LAS unsigned char* L = F.lds;
    __syncthreads();
    { const char* src = (const char*)(F.SSMF + (size_t)g * 144 * 512) + (size_t)tid * 16;
#pragma unroll
      for (int q = 0; q < 18; ++q) __builtin_amdgcn_global_load_lds((const unsigned*)(src + (size_t)q * 8192), (LAS unsigned*)(L + q * 8192 + w * 1024), 16, 0, 0); }
    LAS f32x2* LL = (LAS f32x2*)(F.lds + LDSCTL_OFF + 1024);
    if (tid < 64) { f32x2 q = F.LAMB[g * 64 + tid]; q = cmul(q, q); q = cmul(q, q); q = cmul(q, q); q = cmul(q, q); LL[tid] = q; q = cmul(q, q); q = cmul(q, q); q = cmul(q, q); q = cmul(q, q); LL[64 + tid] = q; }
    float dsk[4];
#pragma unroll
    for (int r = 0; r < 4; ++r) dsk[r] = F.d_skip[g * 16 + 4 * rq + r];
    asm volatile("s_waitcnt vmcnt(0)" ::: "memory");
    __syncthreads();
#define SSM_A(blk) (*(const LAS bf16x8s*)(L + (blk) * 1024 + lane * 16))
#define SSM_A16(gg, i, r) (LL[((gg) - g) + 16 * (i) + 4 * rq + (r)])
#pragma unroll 1
    for (int bb = 0; bb < 2; ++bb) {
        const int b = 2 * bp + bb;
        int gop = g; asm volatile("" : "+s"(gop));
        LAS float* XCH = (LAS float*)(F.lds + XCH_OFF) + bb * 1024;
        const size_t tok0 = (size_t)b * SEQ + (size_t)(16 * w + n) * 16;
        float Sre[4][4], Sim[4][4];
        { bf16x8s Uf1[8];
#pragma unroll
          for (int kb = 0; kb < 8; ++kb) Uf1[kb] = *(const bf16x8s*)(F.U + (tok0 + 2 * kb + (rq >> 1)) * 512 + gop * 16 + 8 * (rq & 1));
          bf16x8s ef[2][8];
#pragma unroll
          for (int kb = 0; kb < 8; ++kb) ef[0][kb] = SSM_A(16 + kb);
#pragma unroll
          for (int i = 0; i < 8; ++i) { f32x4 d = {0.f, 0.f, 0.f, 0.f};
              if (i + 1 < 8) {
#pragma unroll
                  for (int kb = 0; kb < 8; ++kb) ef[(i + 1) & 1][kb] = SSM_A(16 + (i + 1) * 8 + kb); }
              __builtin_amdgcn_sched_barrier(0);
#pragma unroll
              for (int kb = 0; kb < 8; ++kb) d = __builtin_amdgcn_mfma_f32_16x16x32_bf16(ef[i & 1][kb], Uf1[kb], d, 0, 0, 0);
#pragma unroll
              for (int r = 0; r < 4; ++r) { if (i < 4) Sre[i][r] = d[r]; else Sim[i - 4][r] = d[r]; }
              __builtin_amdgcn_sched_barrier(0); } }
#pragma unroll
        for (int i = 0; i < 4; ++i)
#pragma unroll
            for (int r = 0; r < 4; ++r) { f32x2 ak = SSM_A16(gop, i, r);
#define SSM_SCAN_STEP(K) do { const float ur = __int_as_float(__builtin_amdgcn_update_dpp(0, __float_as_int(Sre[i][r]), 0x110 + (K), 0xf, 0xf, true)), ui = __int_as_float(__builtin_amdgcn_update_dpp(0, __float_as_int(Sim[i][r]), 0x110 + (K), 0xf, 0xf, true)); \
                    Sre[i][r] += ak.x * ur - ak.y * ui; Sim[i][r] += ak.x * ui + ak.y * ur; ak = cmul(ak, ak); } while (0)
                SSM_SCAN_STEP(1); SSM_SCAN_STEP(2); SSM_SCAN_STEP(4); SSM_SCAN_STEP(8);
#undef SSM_SCAN_STEP
            }
        if (n == 15) {
#pragma unroll
            for (int i = 0; i < 4; ++i)
#pragma unroll
                for (int r = 0; r < 4; ++r) { const int p = 16 * i + 4 * rq + r; XCH[w * 128 + p] = Sre[i][r]; XCH[w * 128 + 64 + p] = Sim[i][r]; } }
        __syncthreads();
        int gop2 = gop; asm volatile("" : "+s"(gop2));
        bf16x8s Xfr[4];
        { float Cre[4][4], Cim[4][4]; f32x2 aw[4][4];
#pragma unroll
          for (int i = 0; i < 4; ++i)
#pragma unroll
              for (int r = 0; r < 4; ++r) { Cre[i][r] = 0.f; Cim[i][r] = 0.f; aw[i][r] = LL[64 + (gop2 - g) + 16 * i + 4 * rq + r]; }
#pragma unroll 1
          for (int v = 0; v < w; ++v) {
#pragma unroll
              for (int i = 0; i < 4; ++i)
#pragma unroll
                  for (int r = 0; r < 4; ++r) { const int p = 16 * i + 4 * rq + r; const float tr = XCH[v * 128 + p], ti = XCH[v * 128 + 64 + p];
                      const float nr = aw[i][r].x * Cre[i][r] - aw[i][r].y * Cim[i][r] + tr, ni = aw[i][r].x * Cim[i][r] + aw[i][r].y * Cre[i][r] + ti; Cre[i][r] = nr; Cim[i][r] = ni; } }
          int gop3 = gop2; asm volatile("" : "+s"(gop3));
#pragma unroll
          for (int i = 0; i < 4; ++i)
#pragma unroll
              for (int r = 0; r < 4; ++r) { const f32x2 pn = cpow<4>(SSM_A16(gop3, i, r), n);
                  const float ur = __int_as_float(__builtin_amdgcn_update_dpp(0, __float_as_int(Sre[i][r]), 0x111, 0xf, 0xf, true)), ui = __int_as_float(__builtin_amdgcn_update_dpp(0, __float_as_int(Sim[i][r]), 0x111, 0xf, 0xf, true));
                  Sre[i][r] = ur + pn.x * Cre[i][r] - pn.y * Cim[i][r]; Sim[i][r] = ui + pn.x * Cim[i][r] + pn.y * Cre[i][r]; }
          v4u t_;
          t_.x = cvtpk(Sre[0][0], Sre[0][1]); t_.y = cvtpk(Sre[0][2], Sre[0][3]); t_.z = cvtpk(Sre[1][0], Sre[1][1]); t_.w = cvtpk(Sre[1][2], Sre[1][3]); Xfr[0] = __builtin_bit_cast(bf16x8s, t_);
          t_.x = cvtpk(Sre[2][0], Sre[2][1]); t_.y = cvtpk(Sre[2][2], Sre[2][3]); t_.z = cvtpk(Sre[3][0], Sre[3][1]); t_.w = cvtpk(Sre[3][2], Sre[3][3]); Xfr[1] = __builtin_bit_cast(bf16x8s, t_);
          t_.x = cvtpk(Sim[0][0], Sim[0][1]); t_.y = cvtpk(Sim[0][2], Sim[0][3]); t_.z = cvtpk(Sim[1][0], Sim[1][1]); t_.w = cvtpk(Sim[1][2], Sim[1][3]); Xfr[2] = __builtin_bit_cast(bf16x8s, t_);
          t_.x = cvtpk(Sim[2][0], Sim[2][1]); t_.y = cvtpk(Sim[2][2], Sim[2][3]); t_.z = cvtpk(Sim[3][0], Sim[3][1]); t_.w = cvtpk(Sim[3][2], Sim[3][3]); Xfr[3] = __builtin_bit_cast(bf16x8s, t_); }
        int gop4 = gop2; asm volatile("" : "+s"(gop4) : "v"(Xfr[0]), "v"(Xfr[1]), "v"(Xfr[2]), "v"(Xfr[3]) : "memory");
        bf16x8s Ufr[8];
#pragma unroll
        for (int kb = 0; kb < 8; ++kb) Ufr[kb] = *(const bf16x8s*)(F.U + (tok0 + 2 * kb + (rq >> 1)) * 512 + gop4 * 16 + 8 * (rq & 1));
        v2u uq[16];
#pragma unroll
        for (int t = 0; t < 16; ++t) uq[t] = *(const v2u*)(F.U + (tok0 + t) * 512 + gop4 * 16 + 4 * rq);
#define SSM_AF(T) do { _Pragma("unroll") for (int kb = 0; kb <= (T) / 2; ++kb) af[kb] = SSM_A((T) - 2 * kb); \
            _Pragma("unroll") for (int ks = 0; ks < 4; ++ks) af[(T) / 2 + 1 + ks] = SSM_A(80 + (T) * 4 + ks); } while (0)
#pragma unroll
        for (int t = 0; t < 16; ++t) { f32x4 y = {0.f, 0.f, 0.f, 0.f};
            bf16x8s af[12];
            SSM_AF(t);
            __builtin_amdgcn_sched_barrier(0);
#pragma unroll
            for (int kb = 0; kb <= t / 2; ++kb) y = __builtin_amdgcn_mfma_f32_16x16x32_bf16(af[kb], Ufr[kb], y, 0, 0, 0);
#pragma unroll
            for (int ks = 0; ks < 4; ++ks) y = __builtin_amdgcn_mfma_f32_16x16x32_bf16(af[t / 2 + 1 + ks], Xfr[ks], y, 0, 0, 0);
            const size_t off = (tok0 + t) * 512 + g * 16 + 4 * rq;
            const v2u uu = uq[t];
            const float uf[4] = {bflo(uu.x), bfhi(uu.x), bflo(uu.y), bfhi(uu.y)};
            float z[4];
#pragma unroll
            for (int r = 0; r < 4; ++r) z[r] = gelu_tanh(y[r] + dsk[r] * uf[r]);
            *(v2u*)(F.Z + off) = (v2u){cvtpk(z[0], z[1]), cvtpk(z[2], z[3])};
            asm volatile("" ::: "memory"); }
    }
#undef SSM_AF
#undef SSM_A
#undef SSM_A16
}

__device__ __forceinline__ unsigned fkey(float f) { const unsigned u = __float_as_uint(f); return (u & 0x80000000u) ? ~u : (u | 0x80000000u); }

typedef short bf16x8 __attribute__((ext_vector_type(8)));
typedef float f32x16 __attribute__((ext_vector_type(16)));
__device__ __forceinline__ int crow(int r, int hi) { return (r & 3) + 8 * (r >> 2) + 4 * hi; }

extern "C" __device__ int wl_i32(int src, int lane, int old) __asm("llvm.amdgcn.writelane");
#define DPP_I(x, ctrl) __builtin_amdgcn_update_dpp(0, (x), (ctrl), 0xf, 0xf, false)
__device__ __forceinline__ unsigned wave_umax(unsigned v) {
    v = max(v, (unsigned)DPP_I((int)v, 0xB1)); v = max(v, (unsigned)DPP_I((int)v, 0x4E)); v = max(v, (unsigned)DPP_I((int)v, 0x141)); v = max(v, (unsigned)DPP_I((int)v, 0x140));
    const unsigned a = __builtin_amdgcn_readlane((int)v, 0), b = __builtin_amdgcn_readlane((int)v, 16), c = __builtin_amdgcn_readlane((int)v, 32), d = __builtin_amdgcn_readlane((int)v, 48);
    return max(max(a, b), max(c, d));
}
__device__ __forceinline__ unsigned wave_umin(unsigned v) {
    v = min(v, (unsigned)DPP_I((int)v, 0xB1)); v = min(v, (unsigned)DPP_I((int)v, 0x4E)); v = min(v, (unsigned)DPP_I((int)v, 0x141)); v = min(v, (unsigned)DPP_I((int)v, 0x140));
    const unsigned a = __builtin_amdgcn_readlane((int)v, 0), b = __builtin_amdgcn_readlane((int)v, 16), c = __builtin_amdgcn_readlane((int)v, 32), d = __builtin_amdgcn_readlane((int)v, 48);
    return min(min(a, b), min(c, d));
}
__device__ __forceinline__ float fkey_inv(unsigned k) { return __uint_as_float((k & 0x80000000u) ? (k & 0x7fffffffu) : ~k); }
template <int NJ>
__device__ __forceinline__ void select_query_t(const LAS float* SCq, int t, int nvalid, LAS unsigned long long* BMq, LAS unsigned* H, int lane) {
    constexpr int NF = NJ > 5 ? NJ - 5 : 0;
    float v[NJ];
#pragma unroll
    for (int j = 0; j < NJ; ++j) v[j] = (j < NF) ? SCq[64 * j + lane] : ((64 * j + lane < nvalid) ? SCq[64 * j + lane] : -INFINITY);
    const int n = t + 1;
    if (n <= TOPK) {
        const int d = t - 64 * lane;
        const unsigned long long sm = (d >= 63) ? ~0ull : (d < 0) ? 0ull : ((2ull << d) - 1ull);
        if (lane < NJ) BMq[lane] = sm;
        LDS_WAIT(); asm volatile("" ::: "memory");
        return;
    }
    float hi, lo;
    { float h = -INFINITY, l = INFINITY;
#pragma unroll
      for (int j = 0; j < NJ; ++j) { h = fmaxf(h, v[j]); l = fminf(l, (j < NF || v[j] != -INFINITY) ? v[j] : INFINITY); }
      hi = fkey_inv(wave_umax(fkey(h))); lo = fkey_inv(wave_umin(fkey(l))); }
    const float scale = (hi > lo) ? 254.9999f * __builtin_amdgcn_rcpf(hi - lo) : 0.f;
    *(LAS v4u*)(H + 4 * lane) = (v4u){0u, 0u, 0u, 0u};
    LDS_WAIT(); asm volatile("" ::: "memory");
    unsigned pk[NJ / 4];
#pragma unroll
    for (int j = 0; j < NJ; ++j) { const bool ok = (j < NF) || (v[j] != -INFINITY);
        const int bin = ok ? (int)((v[j] - lo) * scale) : 0;
        if (ok) __hip_atomic_fetch_add(H + bin, 1u, __ATOMIC_RELAXED, __HIP_MEMORY_SCOPE_WORKGROUP);
        if ((j & 3) == 0) pk[j >> 2] = (unsigned)bin; else pk[j >> 2] |= (unsigned)bin << (8 * (j & 3)); }
    LDS_WAIT(); asm volatile("" ::: "memory");
    const v4u c = *(const LAS v4u*)(H + 4 * lane);
    const int lsum = (int)(c.x + c.y + c.z + c.w);
    int x = lsum;
    x += __builtin_amdgcn_update_dpp(0, x, 0x101, 0xf, 0xf, true); x += __builtin_amdgcn_update_dpp(0, x, 0x102, 0xf, 0xf, true);
    x += __builtin_amdgcn_update_dpp(0, x, 0x104, 0xf, 0xf, true); x += __builtin_amdgcn_update_dpp(0, x, 0x108, 0xf, 0xf, true);
    { const int r1 = __builtin_amdgcn_readlane(x, 16), r2 = __builtin_amdgcn_readlane(x, 32), r3 = __builtin_amdgcn_readlane(x, 48); const int row = lane >> 4;
      x += (row == 0) ? (r1 + r2 + r3) : (row == 1) ? (r2 + r3) : (row == 2) ? r3 : 0; }
    int run = x - lsum, B = -1, ca = 0, mB = 0;
    { const int ck[4] = {(int)c.x, (int)c.y, (int)c.z, (int)c.w};
#pragma unroll
      for (int k = 3; k >= 0; --k) { if (B < 0 && run < TOPK && run + ck[k] >= TOPK) { B = 4 * lane + k; ca = run; mB = ck[k]; } run += ck[k]; } }
    { const unsigned long long fm = __ballot(B >= 0); const int src = __ffsll((long long)fm) - 1; B = __builtin_amdgcn_readlane(B, src); ca = __builtin_amdgcn_readlane(ca, src); mB = __builtin_amdgcn_readlane(mB, src); }
    const int need = TOPK - ca;
    float tv; int ts;
    if (mB <= 64) {
        const unsigned long long lt = (1ull << lane) - 1ull; int base = 0;
#pragma unroll
        for (int j = 0; j < NJ; ++j) { const bool inb = ((j < NF) || (v[j] != -INFINITY)) && (int)((pk[j >> 2] >> (8 * (j & 3))) & 255u) == B; const unsigned long long bm = __ballot(inb);
            if (bm != 0ull) { if (inb) { const int pos = base + __popcll(bm & lt); H[2 * pos] = __float_as_uint(v[j]); H[2 * pos + 1] = (unsigned)(64 * j + lane); } base += __popcll(bm); } }
        LDS_WAIT(); asm volatile("" ::: "memory");
        float cv = -INFINITY; int cs = 0x7fffffff;
        if (lane < mB) { const v2u e = *(const LAS v2u*)(H + 2 * lane); cv = __uint_as_float(e.x); cs = (int)e.y; }
        int rank = 0;
        for (int k = 0; k < mB; ++k) { const float ov = __uint_as_float(__builtin_amdgcn_readlane(__float_as_uint(cv), k)); const int os = __builtin_amdgcn_readlane(cs, k); rank += (ov > cv || (ov == cv && os < cs)) ? 1 : 0; }
        const unsigned long long fm = __ballot(lane < mB && rank == need - 1); const int src = __ffsll((long long)fm) - 1;
        tv = __uint_as_float(__builtin_amdgcn_readlane(__float_as_uint(cv), src)); ts = __builtin_amdgcn_readlane(cs, src);
    } else {
        unsigned tau = 0u;
#pragma unroll 1
        for (int bit = 31; bit >= 0; --bit) { const unsigned cand = tau | (1u << bit); int cnt = 0;
#pragma unroll
            for (int j = 0; j < NJ; ++j) { cnt += __popcll(__ballot(fkey(v[j]) >= cand)); asm volatile("" : "+s"(cnt)); }
            if (cnt >= TOPK) tau = cand; }
        int cg = 0;
#pragma unroll
        for (int j = 0; j < NJ; ++j) { cg += __popcll(__ballot(fkey(v[j]) > tau)); asm volatile("" : "+s"(cg)); }
        const int need2 = TOPK - cg; const unsigned long long lt = (1ull << lane) - 1ull;
        tv = fkey_inv(tau); ts = -1; int eqb = 0;
#pragma unroll
        for (int j = 0; j < NJ; ++j) { const bool eq = fkey(v[j]) == tau; const unsigned long long em = __ballot(eq);
            const unsigned long long hit = __ballot(eq && (eqb + __popcll(em & lt) + 1 == need2));
            if (hit != 0ull && ts < 0) ts = 64 * j + (__ffsll((long long)hit) - 1);
            eqb += __popcll(em); asm volatile("" : "+s"(eqb)); }
    }
    int mlo = 0, mhi = 0, cgt = 0;
#pragma unroll
    for (int j = 0; j < NJ; ++j) { const unsigned long long sm = __ballot(v[j] > tv); cgt += __popcll(sm); mlo = wl_i32((int)(unsigned)sm, j, mlo); mhi = wl_i32((int)(unsigned)(sm >> 32), j, mhi); }
    if (cgt == TOPK - 1) {
        if (lane == (ts >> 6)) { const int bit = 1 << (ts & 31); if (ts & 32) mhi |= bit; else mlo |= bit; }
    } else {
#pragma unroll
        for (int j = 0; j < NJ; ++j) { const int s_ = 64 * j + lane; const unsigned long long sm = __ballot(v[j] > tv || (v[j] == tv && s_ <= ts)); mlo = wl_i32((int)(unsigned)sm, j, mlo); mhi = wl_i32((int)(unsigned)(sm >> 32), j, mhi); }
    }
    if (lane < NJ) BMq[lane] = ((unsigned long long)(unsigned)mhi << 32) | (unsigned long long)(unsigned)mlo;
    LDS_WAIT(); asm volatile("" ::: "memory");
}

__device__ __forceinline__ void select_query(const LAS float* SCq, int t, int nvalid, LAS unsigned long long* BMq, LAS unsigned* H, int lane) {
    const int nj = __builtin_amdgcn_readfirstlane((nvalid + 63) >> 6);
    if (nj <= 16) { if (nj <= 8) { if (nj <= 4) select_query_t<4>(SCq, t, nvalid, BMq, H, lane); else select_query_t<8>(SCq, t, nvalid, BMq, H, lane); }
                    else { if (nj <= 12) select_query_t<12>(SCq, t, nvalid, BMq, H, lane); else select_query_t<16>(SCq, t, nvalid, BMq, H, lane); } }
    else { if (nj <= 24) { if (nj <= 20) select_query_t<20>(SCq, t, nvalid, BMq, H, lane); else select_query_t<24>(SCq, t, nvalid, BMq, H, lane); }
           else { if (nj <= 28) select_query_t<28>(SCq, t, nvalid, BMq, H, lane); else select_query_t<32>(SCq, t, nvalid, BMq, H, lane); } }
}

constexpr int KBUF_BYTES = 32768;
typedef _Float16 h16x8 __attribute__((ext_vector_type(8)));
__device__ __forceinline__ void idx_subunit(Frame& F, int b, int t0, int qoff) {
    TS_T0();
    int lane_ = F.lane; asm volatile("" : "+v"(lane_));
    const int lane = lane_, w = F.wave, rt = w & 3, kq = w >> 2, r32 = lane & 31, hh = lane >> 5;
    LAS float* SC = (LAS float*)(F.lds);
    LAS unsigned long long* BM = (LAS unsigned long long*)(F.lds + BM_OFF);
    LAS unsigned* HW = (LAS unsigned*)(F.lds + XCH_OFF) + w * 256;
    const int nk = t0 + 16, nkt = (nk + 31) >> 5, nstep = (nkt + 7) >> 3;
    const int qrow = 2 * ((r32 >> 2) & 1) + (r32 >> 4), qhead = 4 * ((r32 >> 3) & 1) + (r32 & 3);
    const bf16* qp = F.QI2 + (size_t)(b * SEQ + t0 + 4 * rt + qrow) * 512 + qhead * 64 + 8 * hh;
    h16x8 qf[4];
#pragma unroll
    for (int d0 = 0; d0 < 4; ++d0) qf[d0] = *(const h16x8*)(qp + 16 * d0);
    f32x4 wq[4];
#pragma unroll
    for (int tq = 0; tq < 4; ++tq) wq[tq] = *(const f32x4*)(F.WI + (size_t)(b * SEQ + t0 + 4 * rt + 2 * hh + (tq >> 1)) * 8 + 4 * (tq & 1));
    const int S0 = w * 64 + lane, skey = (S0 & 255) >> 3;
    const char* ksrc = (const char*)(F.KI2 + (size_t)b * SEQ * 64) + (w >> 2) * 4096 + skey * 128 + (((S0 & 7) ^ (skey & 7)) * 16);
#define IDX_DMA(step) do { _Pragma("unroll") for (int i_ = 0; i_ < 4; ++i_) { const int tl_ = min(8 * (step) + 2 * i_ + (w >> 2), nkt - 1) - (w >> 2);     \
        __builtin_amdgcn_global_load_lds((const unsigned*)(ksrc + (size_t)tl_ * 4096), (LAS unsigned*)(F.lds + ((step) & 3) * KBUF_BYTES + i_ * 8192 + w * 1024), 16, 0, 0); } } while (0)
    __syncthreads();
    asm volatile("" : "+v"(qf[0]), "+v"(qf[1]), "+v"(qf[2]), "+v"(qf[3]));
    asm volatile("" : "+v"(wq[0]), "+v"(wq[1]), "+v"(wq[2]), "+v"(wq[3]));
    IDX_DMA(0);
    if (1 < nstep) IDX_DMA(1);
    if (2 < nstep) IDX_DMA(2);
    TS_ACC(1);
    float scr[8][4][2];
    { TS_T0();
#pragma unroll
    for (int s_ = 0; s_ < 8; ++s_) {
        if (s_ < nstep) {
            if (s_ + 2 < nstep) asm volatile("s_waitcnt vmcnt(8)" ::: "memory"); else if (s_ + 1 < nstep) asm volatile("s_waitcnt vmcnt(4)" ::: "memory"); else asm volatile("s_waitcnt vmcnt(0)" ::: "memory");
            __builtin_amdgcn_s_barrier();
            asm volatile("" ::: "memory");
            if (s_ + 3 < nstep) IDX_DMA(s_ + 3);
            const LAS unsigned char* kb = F.lds + (s_ & 3) * KBUF_BYTES;
            const int tq0 = t0 + 4 * rt + 2 * hh;
#pragma unroll
            for (int pr = 0; pr < 2; ++pr) {
                const int tiA = 4 * pr + kq, tiB = 4 * pr + 2 + kq;
                const LAS unsigned char* krA = kb + tiA * 4096 + r32 * 128; const LAS unsigned char* krB = kb + tiB * 4096 + r32 * 128;
                const int sw = r32 & 7;
                f32x16 accA, accB;
#pragma unroll
                for (int r = 0; r < 16; ++r) { accA[r] = 0.f; accB[r] = 0.f; }
#pragma unroll
                for (int d0 = 0; d0 < 4; ++d0) {
                    const h16x8 kA = *(const LAS h16x8*)(krA + (((2 * d0 + hh) ^ sw) * 16)), kB = *(const LAS h16x8*)(krB + (((2 * d0 + hh) ^ sw) * 16));
                    accA = __builtin_amdgcn_mfma_f32_32x32x16_f16(qf[d0], kA, accA, 0, 0, 0);
                    accB = __builtin_amdgcn_mfma_f32_32x32x16_f16(qf[d0], kB, accB, 0, 0, 0);
                }
#define IDX_EPI(ACC, TI, I4) do { const int key_ = 32 * (8 * s_ + (TI)) + r32; float a_[2]; \
                    _Pragma("unroll") for (int e = 0; e < 2; ++e) { float p_ = 0.f; \
                        _Pragma("unroll") for (int m = 0; m < 8; ++m) { const float r_ = __int_as_float(max(__float_as_int(ACC[8 * e + m]), 0)); \
                            asm("v_fmac_f32 %0, %1, %2" : "+v"(p_) : "v"(r_), "v"(wq[2 * e + (m >> 2)][m & 3])); }     \
                        a_[e] = p_; } \
                    scr[s_][I4][0] = (key_ <= tq0) ? (a_[0] * IDX_SCALE + 0.0f) : -INFINITY; scr[s_][I4][1] = (key_ <= tq0 + 1) ? (a_[1] * IDX_SCALE + 0.0f) : -INFINITY; } while (0)
                IDX_EPI(accA, tiA, 2 * pr); IDX_EPI(accB, tiB, 2 * pr + 1);
#undef IDX_EPI
            }
        }
    }
#undef IDX_DMA
    TS_ACC(2); }
    { TS_T0();
    if (F.tid == 0) *(LAS unsigned*)(F.lds + MISC_OFF + 96) = 0u;
    __syncthreads();
#pragma unroll
    for (int s_ = 0; s_ < 8; ++s_) {
        if (s_ < nstep) {
#pragma unroll
            for (int i4 = 0; i4 < 4; ++i4) { const int kt = 8 * s_ + 2 * i4 + kq;
                SC[(4 * rt + 2 * hh) * 2048 + 32 * kt + r32] = scr[s_][i4][0]; SC[(4 * rt + 2 * hh + 1) * 2048 + 32 * kt + r32] = scr[s_][i4][1]; } } }
    __syncthreads();
    TS_ACC(3); }
    { TS_T0();
#ifndef DUP_SEL
#define DUP_SEL 1
#endif
#ifndef DUP_FLASH
#define DUP_FLASH 1
#endif
    for (int rep_ = 0; rep_ < DUP_SEL; ++rep_)
#pragma unroll 1
        for (;;) {
            unsigned q_ = 0u; if (lane == 0) q_ = __hip_atomic_fetch_add((LAS unsigned*)(F.lds + MISC_OFF + 96), 1u, __ATOMIC_RELAXED, __HIP_MEMORY_SCOPE_WORKGROUP);
            const int q = __builtin_amdgcn_readfirstlane((int)q_);
            if (q >= 16) break;
            select_query(SC + q * 2048, t0 + q, nkt * 32, BM + (qoff + q) * 32, HW, lane); }
    TS_ACC(4); }
}

typedef short v4i16_t __attribute__((ext_vector_type(4)));
__device__ __forceinline__ v4i16_t vtr(const LAS unsigned char* p) { return __builtin_amdgcn_ds_read_tr16_b64_v4i16((LAS v4i16_t*)p); }
__device__ __forceinline__ void attn_subunit(Frame& F, int b, int kvh, int t0) {
    int lane_ = F.lane; asm volatile("" : "+v"(lane_));
    const int lane = lane_, w = F.wave, r32 = lane & 31, hi = lane >> 5, tid = w * 64 + lane;
    LAS float* wsf = (LAS float*)(F.lds + 32768) + w * 64;
    const LAS unsigned long long* BM = (const LAS unsigned long long*)(F.lds + BM_OFF);
    const int ntile = (t0 + 64) >> 6;
    const int tl = 8 * w + (r32 >> 2), g = r32 & 3;
    constexpr float C2 = 0.125f * 1.4426950408889634f;
    float negS;
    { const float gv = fabsf(F.q_gain[lane] * F.k_gain[lane]); negS = -64.0f * C2 * fkey_inv(wave_umax(fkey(gv))) * 1.0005f; }
    bf16x8 qr[4];
    { const bf16* qp = F.Q + (size_t)(b * SEQ + t0 + tl) * 512 + (4 * kvh + g) * 64 + 8 * hi;
      float qf[32]; float ss = 0.f;
#pragma unroll
      for (int d0 = 0; d0 < 4; ++d0) { const v4u qv = *(const v4u*)(qp + 16 * d0);
          qf[8 * d0 + 0] = bflo(qv.x); qf[8 * d0 + 1] = bfhi(qv.x); qf[8 * d0 + 2] = bflo(qv.y); qf[8 * d0 + 3] = bfhi(qv.y);
          qf[8 * d0 + 4] = bflo(qv.z); qf[8 * d0 + 5] = bfhi(qv.z); qf[8 * d0 + 6] = bflo(qv.w); qf[8 * d0 + 7] = bfhi(qv.w); }
#pragma unroll
      for (int i = 0; i < 32; ++i) ss += qf[i] * qf[i];
      { const auto rr = __builtin_amdgcn_permlane32_swap(__float_as_uint(ss), __float_as_uint(ss), false, false); ss = __uint_as_float(rr[0]) + __uint_as_float(rr[1]); }
      const float rstd = (1.0f / sqrtf(ss * (1.f / 64.f) + EPS)) * C2;
      int dop = 8 * hi; asm volatile("" : "+v"(dop));
#pragma unroll
      for (int d0 = 0; d0 < 4; ++d0) { float v[8];
#pragma unroll
          for (int j = 0; j < 8; ++j) { const int d = 16 * d0 + dop + j; v[j] = qf[8 * d0 + j] * rstd * F.q_gain[d] * F.k_gain[d]; }
          v4u pk; pk.x = cvtpk(v[0], v[1]); pk.y = cvtpk(v[2], v[3]); pk.z = cvtpk(v[4], v[5]); pk.w = cvtpk(v[6], v[7]);
          qr[d0] = __builtin_bit_cast(bf16x8, pk); } }
    const int skey = tid >> 3, sc = tid & 7;
    const bf16* kvp = F.KV + (size_t)(b * SEQ + skey) * 256 + kvh * 64 + 8 * sc;
    const int kwoff = skey * 128 + ((sc ^ (skey & 7)) * 16), vwoff = 8192 + (sc >> 2) * 4096 + skey * 64 + (sc & 3) * 16;
#define ATT_STAGE(bufbase) do { LAS unsigned char* bb_ = F.lds + (bufbase); \
        float kf_[8] = {bflo(kreg.x), bfhi(kreg.x), bflo(kreg.y), bfhi(kreg.y), bflo(kreg.z), bfhi(kreg.z), bflo(kreg.w), bfhi(kreg.w)}; float ss_ = 0.f; \
        _Pragma("unroll") for (int j_ = 0; j_ < 8; ++j_) ss_ += kf_[j_] * kf_[j_]; \
        ss_ += __builtin_bit_cast(float, DPP_I(__builtin_bit_cast(int, ss_), 0xB1)); ss_ += __builtin_bit_cast(float, DPP_I(__builtin_bit_cast(int, ss_), 0x4E)); ss_ += __builtin_bit_cast(float, DPP_I(__builtin_bit_cast(int, ss_), 0x141)); \
        const float rk_ = __builtin_amdgcn_rsqf(ss_ * (1.f / 64.f) + EPS); \
        v4u ko_; ko_.x = cvtpk(kf_[0] * rk_, kf_[1] * rk_); ko_.y = cvtpk(kf_[2] * rk_, kf_[3] * rk_); ko_.z = cvtpk(kf_[4] * rk_, kf_[5] * rk_); ko_.w = cvtpk(kf_[6] * rk_, kf_[7] * rk_); \
        *(LAS v4u*)(bb_ + kwoff) = ko_; *(LAS v4u*)(bb_ + vwoff) = vreg; } while (0)
    float l = 0.f;
    f32x16 o[2];
#pragma unroll
    for (int r = 0; r < 16; ++r) { o[0][r] = 0.f; o[1][r] = 0.f; }
    v4u kreg = *(const v4u*)(kvp), vreg = *(const v4u*)(kvp + 128), kreg2, vreg2;
    __syncthreads();
    ATT_STAGE(0);
    if (ntile > 1) { kreg = *(const v4u*)(kvp + (size_t)64 * 256); vreg = *(const v4u*)(kvp + (size_t)64 * 256 + 128); }
    if (ntile > 2) { kreg2 = *(const v4u*)(kvp + (size_t)128 * 256); vreg2 = *(const v4u*)(kvp + (size_t)128 * 256 + 128); }
    __syncthreads();
    const LAS unsigned char* vp0 = F.lds + 8192 + ((lane >> 4) & 1) * 32 + (lane & 3) * 8 + (4 * hi + ((lane & 15) >> 2)) * 64;
    for (int tile = 0; tile < ntile; ++tile) {
        const int cb_ = (tile & 1) * 16384;
        if (tile + 1 < ntile) { ATT_STAGE(16384 - cb_); kreg = kreg2; vreg = vreg2;
            if (tile + 3 < ntile) { const bf16* np = kvp + (size_t)(tile + 3) * 64 * 256; kreg2 = *(const v4u*)(np); vreg2 = *(const v4u*)(np + 128); } }
        const LAS unsigned char* Kt = F.lds + cb_;
        f32x16 p0, p1;
#pragma unroll
        for (int r = 0; r < 16; ++r) { p0[r] = negS; p1[r] = negS; }
#pragma unroll
        for (int d0 = 0; d0 < 4; ++d0) {
            const bf16x8 a0 = *(const LAS bf16x8*)(Kt + r32 * 128 + (((2 * d0 + hi) ^ (r32 & 7)) * 16));
            const bf16x8 a1 = *(const LAS bf16x8*)(Kt + (32 + r32) * 128 + (((2 * d0 + hi) ^ (r32 & 7)) * 16));
            p0 = __builtin_amdgcn_mfma_f32_32x32x16_bf16(a0, qr[d0], p0, 0, 0, 0);
            p1 = __builtin_amdgcn_mfma_f32_32x32x16_bf16(a1, qr[d0], p1, 0, 0, 0);
        }
        const unsigned long long mw = BM[tl * 32 + tile];
        const int mlo = (int)((unsigned)mw >> (4 * hi)), mhi = (int)((unsigned)(mw >> 32) >> (4 * hi));
        float ps = 0.f;
#define ATT_EXPM(R) do { const float e0_ = __builtin_amdgcn_exp2f(p0[R]), e1_ = __builtin_amdgcn_exp2f(p1[R]); int m0_, m1_; \
            asm("v_bfe_i32 %0, %1, %2, 1" : "=v"(m0_) : "v"(mlo), "n"(8 * ((R) >> 2) + ((R) & 3))); asm("v_bfe_i32 %0, %1, %2, 1" : "=v"(m1_) : "v"(mhi), "n"(8 * ((R) >> 2) + ((R) & 3))); \
            p0[R] = __int_as_float(__float_as_int(e0_) & m0_); p1[R] = __int_as_float(__float_as_int(e1_) & m1_); ps += p0[R] + p1[R]; } while (0)
        ATT_EXPM(0); ATT_EXPM(1); ATT_EXPM(2); ATT_EXPM(3); ATT_EXPM(4); ATT_EXPM(5); ATT_EXPM(6); ATT_EXPM(7);
        ATT_EXPM(8); ATT_EXPM(9); ATT_EXPM(10); ATT_EXPM(11); ATT_EXPM(12); ATT_EXPM(13); ATT_EXPM(14); ATT_EXPM(15);
#undef ATT_EXPM
        l += ps;
        bf16x8 pa[4];
        { v4u t_;
          t_.x = cvtpk(p0[0], p0[1]); t_.y = cvtpk(p0[2], p0[3]); t_.z = cvtpk(p0[4], p0[5]); t_.w = cvtpk(p0[6], p0[7]); pa[0] = __builtin_bit_cast(bf16x8, t_);
          t_.x = cvtpk(p0[8], p0[9]); t_.y = cvtpk(p0[10], p0[11]); t_.z = cvtpk(p0[12], p0[13]); t_.w = cvtpk(p0[14], p0[15]); pa[1] = __builtin_bit_cast(bf16x8, t_);
          t_.x = cvtpk(p1[0], p1[1]); t_.y = cvtpk(p1[2], p1[3]); t_.z = cvtpk(p1[4], p1[5]); t_.w = cvtpk(p1[6], p1[7]); pa[2] = __builtin_bit_cast(bf16x8, t_);
          t_.x = cvtpk(p1[8], p1[9]); t_.y = cvtpk(p1[10], p1[11]); t_.z = cvtpk(p1[12], p1[13]); t_.w = cvtpk(p1[14], p1[15]); pa[3] = __builtin_bit_cast(bf16x8, t_); }
#pragma unroll
        for (int dh = 0; dh < 2; ++dh)
#pragma unroll
            for (int ks = 0; ks < 4; ++ks) { const v4i16_t lo_ = vtr(vp0 + cb_ + dh * 4096 + ks * 1024), hi_ = vtr(vp0 + cb_ + dh * 4096 + ks * 1024 + 512);
                const bf16x8 vb = (bf16x8){lo_[0], lo_[1], lo_[2], lo_[3], hi_[0], hi_[1], hi_[2], hi_[3]};
                o[dh] = __builtin_amdgcn_mfma_f32_32x32x16_bf16(pa[ks], vb, o[dh], 0, 0, 0); }
        __syncthreads();
    }
#undef ATT_STAGE
    { const auto rr = __builtin_amdgcn_permlane32_swap(__float_as_uint(l), __float_as_uint(l), false, false); l = __uint_as_float(rr[0]) + __uint_as_float(rr[1]); }
    if (hi == 0) wsf[r32] = 1.0f / l;
    LDS_WAIT(); asm volatile("" ::: "memory");
    float ssq[4];
#pragma unroll
    for (int q4 = 0; q4 < 4; ++q4) { const f32x4 av = *(const LAS f32x4*)(wsf + 8 * q4 + 4 * hi); float s2 = 0.f;
        const size_t row = (size_t)(b * SEQ + t0 + 8 * w + 2 * q4 + hi);
#pragma unroll
        for (int i = 0; i < 4; ++i) { const float v0 = o[0][4 * q4 + i] * av[i], v1 = o[1][4 * q4 + i] * av[i]; s2 += v0 * v0 + v1 * v1;
            bf16* op = F.MIX + row * 1024 + 512 + (4 * kvh + i) * 64 + r32;
            op[0] = (bf16)f2bf(v0); op[32] = (bf16)f2bf(v1); }
        ssq[q4] = s2; }
#pragma unroll
    for (int q4 = 0; q4 < 4; ++q4) { float s2 = ssq[q4];
        s2 += __shfl_xor(s2, 1); s2 += __shfl_xor(s2, 2); s2 += __shfl_xor(s2, 4); s2 += __shfl_xor(s2, 8); s2 += __shfl_xor(s2, 16);
        if (r32 == 0) F.SSQA[(size_t)(b * SEQ + t0 + 8 * w + 2 * q4 + hi) * 2 + kvh] = s2; }
    LDS_WAIT(); asm volatile("" ::: "memory");
}

__device__ __forceinline__ void attn_unit2(Frame& F, int b, int t0) {
    int lane_ = F.lane; asm volatile("" : "+v"(lane_));
    const int lane = lane_, w = F.wave, r32 = lane & 31, hi = lane >> 5, tid = w * 64 + lane;
    LAS float* wsf = (LAS float*)(F.lds + XCH_OFF) + w * 64;
    LAS unsigned char* qL = F.lds + 65536 + w * 8192 + lane * 16;
    const LAS unsigned long long* BM = (const LAS unsigned long long*)(F.lds + BM_OFF);
    const int ntile = (t0 + 64) >> 6;
    const int tl = 8 * w + (r32 >> 2), g = r32 & 3;
    constexpr float C2 = 0.125f * 1.4426950408889634f;
    float negS;
    { const float gv = fabsf(F.q_gain[lane] * F.k_gain[lane]); negS = -64.0f * C2 * fkey_inv(wave_umax(fkey(gv))) * 1.0005f; }
    __syncthreads();
#define ATT_QPREP(KVH, QR) do { const bf16* qp = F.Q + (size_t)(b * SEQ + t0 + tl) * 512 + (4 * (KVH) + g) * 64 + 8 * hi; \
      float qf[32]; float ss = 0.f; \
      _Pragma("unroll") for (int d0 = 0; d0 < 4; ++d0) { const v4u qv = *(const v4u*)(qp + 16 * d0); \
          qf[8 * d0 + 0] = bflo(qv.x); qf[8 * d0 + 1] = bfhi(qv.x); qf[8 * d0 + 2] = bflo(qv.y); qf[8 * d0 + 3] = bfhi(qv.y); \
          qf[8 * d0 + 4] = bflo(qv.z); qf[8 * d0 + 5] = bfhi(qv.z); qf[8 * d0 + 6] = bflo(qv.w); qf[8 * d0 + 7] = bfhi(qv.w); } \
      _Pragma("unroll") for (int i = 0; i < 32; ++i) ss += qf[i] * qf[i]; \
      { const auto rr = __builtin_amdgcn_permlane32_swap(__float_as_uint(ss), __float_as_uint(ss), false, false); ss = __uint_as_float(rr[0]) + __uint_as_float(rr[1]); } \
      const float rstd = __builtin_amdgcn_rsqf(ss * (1.f / 64.f) + EPS) * C2; \
      int dop = 8 * hi; asm volatile("" : "+v"(dop)); \
      _Pragma("unroll") for (int d0 = 0; d0 < 4; ++d0) { float v[8]; \
          _Pragma("unroll") for (int j = 0; j < 8; ++j) { const int d = 16 * d0 + dop + j; v[j] = qf[8 * d0 + j] * rstd * F.q_gain[d] * F.k_gain[d]; } \
          v4u pk; pk.x = cvtpk(v[0], v[1]); pk.y = cvtpk(v[2], v[3]); pk.z = cvtpk(v[4], v[5]); pk.w = cvtpk(v[6], v[7]); \
          *(LAS v4u*)(qL + (QR) * 4096 + d0 * 1024) = pk; } } while (0)
    ATT_QPREP(0, 0); ATT_QPREP(1, 1);
#undef ATT_QPREP
    const int skey = tid >> 3, sc = tid & 7;
    const bf16* kvp = F.KV + (size_t)(b * SEQ + skey) * 256 + 8 * sc;
    const int kwoff = skey * 128 + ((sc ^ (skey & 7)) * 16), vwoff = 16384 + (sc >> 2) * 4096 + skey * 64 + (sc & 3) * 16;
#define ATT_KSC(KR) ({ float kf_[8] = {bflo(KR.x), bfhi(KR.x), bflo(KR.y), bfhi(KR.y), bflo(KR.z), bfhi(KR.z), bflo(KR.w), bfhi(KR.w)}; float ss_ = 0.f; \
        _Pragma("unroll") for (int j_ = 0; j_ < 8; ++j_) ss_ += kf_[j_] * kf_[j_]; \
        ss_ += __builtin_bit_cast(float, DPP_I(__builtin_bit_cast(int, ss_), 0xB1)); ss_ += __builtin_bit_cast(float, DPP_I(__builtin_bit_cast(int, ss_), 0x4E)); ss_ += __builtin_bit_cast(float, DPP_I(__builtin_bit_cast(int, ss_), 0x141)); \
        const float rk_ = __builtin_amdgcn_rsqf(ss_ * (1.f / 64.f) + EPS); \
        v4u ko_; ko_.x = cvtpk(kf_[0] * rk_, kf_[1] * rk_); ko_.y = cvtpk(kf_[2] * rk_, kf_[3] * rk_); ko_.z = cvtpk(kf_[4] * rk_, kf_[5] * rk_); ko_.w = cvtpk(kf_[6] * rk_, kf_[7] * rk_); ko_; })
#define ATT_STAGE(bufbase) do { LAS unsigned char* bb_ = F.lds + (bufbase); \
        *(LAS v4u*)(bb_ + kwoff) = ATT_KSC(k0r); *(LAS v4u*)(bb_ + 8192 + kwoff) = ATT_KSC(k1r); *(LAS v4u*)(bb_ + vwoff) = v0r; *(LAS v4u*)(bb_ + 8192 + vwoff) = v1r; } while (0)
    LAS float* BIAS = (LAS float*)(F.lds + 65536);
#define ATT_BIAS(T) do { const unsigned long long w_ = BM[(tid >> 3) * 32 + (T)]; const unsigned b8_ = (unsigned)(w_ >> (8 * (tid & 7))) & 0xffu; f32x4 v0_, v1_; \
        _Pragma("unroll") for (int k_ = 0; k_ < 4; ++k_) { v0_[k_] = ((b8_ >> k_) & 1u) ? negS : -1.0e30f; v1_[k_] = ((b8_ >> (4 + k_)) & 1u) ? negS : -1.0e30f; } \
        LAS float* bp_ = BIAS + ((T) & 1) * 4608 + (tid >> 3) * 72 + 8 * (tid & 7); *(LAS f32x4*)bp_ = v0_; *(LAS f32x4*)(bp_ + 4) = v1_; } while (0)
#define ATT_LOAD(tile_) do { const bf16* np_ = kvp + (size_t)(tile_) * 64 * 256; k0r = *(const v4u*)(np_); k1r = *(const v4u*)(np_ + 64); v0r = *(const v4u*)(np_ + 128); v1r = *(const v4u*)(np_ + 192); } while (0)
    float lA = 0.f, lB = 0.f;
    bf16x8 qrA[4], qrB[4];
    LDS_WAIT();
#pragma unroll
    for (int d0 = 0; d0 < 4; ++d0) { qrA[d0] = *(const LAS bf16x8*)(qL + d0 * 1024); qrB[d0] = *(const LAS bf16x8*)(qL + 4096 + d0 * 1024); }
    f32x16 oA[2], oB[2];
#pragma unroll
    for (int r = 0; r < 16; ++r) { oA[0][r] = 0.f; oA[1][r] = 0.f; oB[0][r] = 0.f; oB[1][r] = 0.f; }
    v4u k0r, k1r, v0r, v1r;
    ATT_LOAD(0);
    __syncthreads();
    ATT_STAGE(0); ATT_BIAS(0);
    if (ntile > 1) ATT_LOAD(1);
    __syncthreads();
    const LAS unsigned char* vp0 = F.lds + 16384 + ((lane >> 4) & 1) * 32 + (lane & 3) * 8 + (4 * hi + ((lane & 15) >> 2)) * 64;
    for (int tile = 0; tile < ntile; ++tile) {
        const int cb_ = (tile & 1) * 32768;
        if (tile + 1 < ntile) { ATT_STAGE(32768 - cb_); ATT_BIAS(tile + 1); if (tile + 2 < ntile) ATT_LOAD(tile + 2); }
        const LAS unsigned char* Kt = F.lds + cb_;
        const LAS float* bq_ = BIAS + (tile & 1) * 4608 + tl * 72 + 4 * hi;
#pragma unroll
        for (int hf = 0; hf < 2; ++hf) {
            f32x16 pA, pB, bz;
#pragma unroll
            for (int q4 = 0; q4 < 4; ++q4) { const f32x4 t_ = *(const LAS f32x4*)(bq_ + 32 * hf + 8 * q4); bz[4 * q4] = t_.x; bz[4 * q4 + 1] = t_.y; bz[4 * q4 + 2] = t_.z; bz[4 * q4 + 3] = t_.w; }
#pragma unroll
            for (int d0 = 0; d0 < 4; ++d0) {
                const int ko_ = hf * 4096 + r32 * 128 + (((2 * d0 + hi) ^ (r32 & 7)) * 16);
                const bf16x8 a0 = *(const LAS bf16x8*)(Kt + ko_), c0 = *(const LAS bf16x8*)(Kt + 8192 + ko_);
                if (d0 == 0) { pA = __builtin_amdgcn_mfma_f32_32x32x16_bf16(a0, qrA[d0], bz, 0, 0, 0); pB = __builtin_amdgcn_mfma_f32_32x32x16_bf16(c0, qrB[d0], bz, 0, 0, 0); }
                else { pA = __builtin_amdgcn_mfma_f32_32x32x16_bf16(a0, qrA[d0], pA, 0, 0, 0); pB = __builtin_amdgcn_mfma_f32_32x32x16_bf16(c0, qrB[d0], pB, 0, 0, 0); }
            }
            float psA = 0.f, psB = 0.f;
#define ATT_EXPM(R) do { pA[R] = __builtin_amdgcn_exp2f(pA[R]); pB[R] = __builtin_amdgcn_exp2f(pB[R]); psA += pA[R]; psB += pB[R]; } while (0)
            ATT_EXPM(0); ATT_EXPM(1); ATT_EXPM(2); ATT_EXPM(3); ATT_EXPM(4); ATT_EXPM(5); ATT_EXPM(6); ATT_EXPM(7);
            ATT_EXPM(8); ATT_EXPM(9); ATT_EXPM(10); ATT_EXPM(11); ATT_EXPM(12); ATT_EXPM(13); ATT_EXPM(14); ATT_EXPM(15);
#undef ATT_EXPM
            lA += psA; lB += psB;
            bf16x8 paA[2], paB[2];
            { v4u t_;
              t_.x = cvtpk(pA[0], pA[1]); t_.y = cvtpk(pA[2], pA[3]); t_.z = cvtpk(pA[4], pA[5]); t_.w = cvtpk(pA[6], pA[7]); paA[0] = __builtin_bit_cast(bf16x8, t_);
              t_.x = cvtpk(pA[8], pA[9]); t_.y = cvtpk(pA[10], pA[11]); t_.z = cvtpk(pA[12], pA[13]); t_.w = cvtpk(pA[14], pA[15]); paA[1] = __builtin_bit_cast(bf16x8, t_);
              t_.x = cvtpk(pB[0], pB[1]); t_.y = cvtpk(pB[2], pB[3]); t_.z = cvtpk(pB[4], pB[5]); t_.w = cvtpk(pB[6], pB[7]); paB[0] = __builtin_bit_cast(bf16x8, t_);
              t_.x = cvtpk(pB[8], pB[9]); t_.y = cvtpk(pB[10], pB[11]); t_.z = cvtpk(pB[12], pB[13]); t_.w = cvtpk(pB[14], pB[15]); paB[1] = __builtin_bit_cast(bf16x8, t_); }
#pragma unroll
            for (int dh = 0; dh < 2; ++dh)
#pragma unroll
                for (int k2 = 0; k2 < 2; ++k2) { const int vo_ = cb_ + dh * 4096 + (2 * hf + k2) * 1024;
                    const v4i16_t la_ = vtr(vp0 + vo_), ha_ = vtr(vp0 + vo_ + 512), lb_ = vtr(vp0 + 8192 + vo_), hb_ = vtr(vp0 + 8192 + vo_ + 512);
                    const bf16x8 va = (bf16x8){la_[0], la_[1], la_[2], la_[3], ha_[0], ha_[1], ha_[2], ha_[3]}, vb = (bf16x8){lb_[0], lb_[1], lb_[2], lb_[3], hb_[0], hb_[1], hb_[2], hb_[3]};
                    oA[dh] = __builtin_amdgcn_mfma_f32_32x32x16_bf16(paA[k2], va, oA[dh], 0, 0, 0);
                    oB[dh] = __builtin_amdgcn_mfma_f32_32x32x16_bf16(paB[k2], vb, oB[dh], 0, 0, 0); }
        }
        __syncthreads();
    }
#undef ATT_STAGE
#undef ATT_LOAD
#undef ATT_KSC
#define ATT_FIN(LL, OO, KVH) do { float l_ = LL; { const auto rr = __builtin_amdgcn_permlane32_swap(__float_as_uint(l_), __float_as_uint(l_), false, false); l_ = __uint_as_float(rr[0]) + __uint_as_float(rr[1]); } \
    if (hi == 0) wsf[r32] = __builtin_amdgcn_rcpf(l_); \
    LDS_WAIT(); asm volatile("" ::: "memory"); \
    float ssq[4]; \
    _Pragma("unroll") for (int q4 = 0; q4 < 4; ++q4) { const f32x4 av = *(const LAS f32x4*)(wsf + 8 * q4 + 4 * hi); float s2 = 0.f; \
        const size_t row = (size_t)(b * SEQ + t0 + 8 * w + 2 * q4 + hi); \
        _Pragma("unroll") for (int i = 0; i < 4; ++i) { const float v0 = OO[0][4 * q4 + i] * av[i], v1 = OO[1][4 * q4 + i] * av[i]; s2 += v0 * v0 + v1 * v1; \
            bf16* op = F.MIX + row * 1024 + 512 + (4 * (KVH) + i) * 64 + r32; \
            const unsigned pk_ = cvtpk(v0, v1); op[0] = (bf16)(pk_ & 0xffffu); op[32] = (bf16)(pk_ >> 16); } \
        ssq[q4] = s2; } \
    _Pragma("unroll") for (int q4 = 0; q4 < 4; ++q4) { float s2 = ssq[q4]; \
        s2 += __shfl_xor(s2, 1); s2 += __shfl_xor(s2, 2); s2 += __shfl_xor(s2, 4); s2 += __shfl_xor(s2, 8); s2 += __shfl_xor(s2, 16); \
        if (r32 == 0) F.SSQA[(size_t)(b * SEQ + t0 + 8 * w + 2 * q4 + hi) * 2 + (KVH)] = s2; } \
    LDS_WAIT(); asm volatile("" ::: "memory"); } while (0)
    ATT_FIN(lA, oA, 0); ATT_FIN(lB, oB, 1);
#undef ATT_FIN
}

__device__ __forceinline__ void p3_phase(Frame& F) {
#ifdef TS_PROBE
    const unsigned long long tsp3_ = __builtin_amdgcn_s_memtime(); F.tsacc = 0ull;
#endif
    LAS unsigned char* wl = F.lds + RING_OFF + F.wave * WAVE_LDS;
    const int gw = F.vcu * NWAVES + F.wave, NGW = F.G * NWAVES;
    for (int cg = F.vcu; cg < 256; cg += F.G) { TS_T0(); bias2_wg(F, cg); TS_ACC(7); }
#ifndef DUP_SSM
#define DUP_SSM 1
#endif
#ifndef DUP_ATTN
#define DUP_ATTN 1
#endif
#ifndef NO_SSM
    for (int rep = 0; rep < DUP_SSM; ++rep)
    for (int u = F.vcu; u < NG * 8; u += F.G) { TS_T0(); ssm_unit(F, u & 31, u >> 5); TS_ACC(6); }
#endif
#ifndef NO_ATTN
    for (int rep = 0; rep < DUP_ATTN; ++rep)
    for (int u = F.vcu; u < BATCH * 16; u += F.G) {
        const int b = u >> 4, p = u & 15;
#pragma unroll 1
        for (int side = 0; side < 2; ++side) { const int t0 = 64 * (side ? 31 - p : p);
#pragma unroll 1
#ifndef DUP_IS
#define DUP_IS 1
#endif
            for (int sub = 0; sub < 4 * DUP_IS; ++sub) idx_subunit(F, b, t0 + 16 * (sub & 3), 16 * (sub & 3));
#pragma unroll 1
            for (int rep2_ = 0; rep2_ < DUP_FLASH; ++rep2_) {
#ifndef T_NOFLASH
                { TS_T0(); attn_unit2(F, b, t0); TS_ACC(5); }
#endif
            } }
    }
#endif
    __syncthreads();
#ifdef TS_PROBE
    if (blockIdx.x == 64 && F.tid == 0) { const unsigned long long tot_ = __builtin_amdgcn_s_memtime() - tsp3_; const float fr_ = (float)((double)F.tsacc / (double)tot_); F.MISC[16] = __float_as_uint(0.025f * floorf(fr_ * 40.0f + 0.5f)); }
#endif
}

__device__ __forceinline__ void wg_sync() { __syncthreads(); }
struct Args { const float* in[24]; float* out; unsigned char* ws; int ph_lo, ph_hi, li, pad; };
__global__ void __launch_bounds__(NWAVES * 64, 2) __attribute__((target("no-packed-fp32-ops"))) fwd_kernel(Args args) {
    extern __shared__ __attribute__((aligned(16))) unsigned char lds[];
    Frame F;
    F.lds = (LAS unsigned char*)lds;
    F.MISC = (volatile LAS unsigned*)(F.lds + MISC_OFF);
    F.tid = threadIdx.x; F.lane = F.tid & 63; F.wave = __builtin_amdgcn_readfirstlane(F.tid >> 6);
    F.G = gridDim.x; { const int bx = blockIdx.x; F.vcu = (F.G % 8 == 0) ? (bx % 8) * (F.G / 8) + bx / 8 : bx; }
    unsigned char* ws = args.ws;
    F.ctl = (gu32*)(ws + WS_CTL);
    F.x = args.in[0]; F.c = args.in[1]; F.norm1_g = args.in[2]; F.norm2_g = args.in[3]; F.w_ada = args.in[4]; F.b_ada = args.in[5]; F.w_in = args.in[6];
    F.lam_re = args.in[7]; F.lam_im = args.in[8]; F.log_dt = args.in[9]; F.b_re = args.in[10]; F.b_im = args.in[11]; F.c_re = args.in[12]; F.c_im = args.in[13];
    F.d_skip = args.in[14]; F.w_glu = args.in[15]; F.b_glu = args.in[16]; F.q_gain = args.in[17]; F.k_gain = args.in[18]; F.gn_ssm = args.in[19]; F.gn_attn = args.in[20];
    F.w_out = args.in[21]; F.w_ff1 = args.in[22]; F.w_ff2 = args.in[23]; F.out = args.out;
    F.MODP = (float*)(ws + WS_MODP); F.MOD = (float*)(ws + WS_MOD); F.BIAS2 = (float*)(ws + WS_BIAS2); F.SSQS = (float*)(ws + WS_SSQS); F.SSQ2 = (float*)(ws + WS_SSQ2);
    F.KI2 = (bf16*)(ws + WS_KI); F.WI = (float*)(ws + WS_WI); F.QI2 = (bf16*)(ws + WS_QI); F.SSQA = (float*)(ws + WS_SSQA); F.SSMF = (bf16*)(ws + WS_SSMF); F.X1 = (bf16*)(ws + WS_X1);
    F.LAMB = (f32x2*)(ws + WS_SSMP); F.BBAR = (f32x2*)(ws + WS_SSMP + 16384);
    F.WINP = (bf16*)(ws + WS_WINP); F.WINI = (bf16*)(ws + WS_WINI); F.WGLU = (bf16*)(ws + WS_WGLU); F.WOUT = (bf16*)(ws + WS_WOUT); F.W1 = (bf16*)(ws + WS_W1); F.W2 = (bf16*)(ws + WS_W2);
    F.U = (bf16*)(ws + WS_U); F.Q = (bf16*)(ws + WS_Q); F.A2 = (bf16*)(ws + WS_A2); F.XN = (bf16*)(ws + WS_XN); F.KV = (bf16*)(ws + WS_KV); F.Z = (bf16*)(ws + WS_Z); F.MIX = (bf16*)(ws + WS_MIX); F.H = (bf16*)(ws + WS_H);
    for (int u = F.tid; u < (LDS_BYTES - LDSCTL_OFF) / 4; u += NWAVES * 64) ((LAS unsigned*)(F.lds + LDSCTL_OFF))[u] = 0u;
    wg_sync();
    XcdBarrier bar; bar.bar = (unsigned*)(F.ctl + CW_BAR) + args.li * XCD_BAR_WORDS; bar.x = 0; bar.st = nullptr;
    if (N_LAUNCHES == 1) bar = xcd_barrier_post((unsigned*)(F.ctl + CW_BAR) + args.li * XCD_BAR_WORDS, F.MISC + 8);
#define GRID_BAR() do { if (N_LAUNCHES == 1) xcd_barrier(bar); } while (0)
    const int lo = args.ph_lo, hi = args.ph_hi;
#ifdef TS_GEMM
    unsigned long long tsg_ = 0ull, tsg0_ = 0ull;
#define TSP(k) (((k) == TS_GEMM) ? &tsg_ : nullptr)
#define TSG_BEGIN(k) do { if ((k) == TS_GEMM) tsg0_ = __builtin_amdgcn_s_memtime(); } while (0)
#define TSG_END(k) do { if ((k) == TS_GEMM && blockIdx.x == 64 && F.tid == 0) { const unsigned long long tot_ = __builtin_amdgcn_s_memtime() - tsg0_; const float fr_ = (float)((double)tsg_ / (double)tot_); F.MISC[16] = __float_as_uint(0.06f * floorf(fr_ * (1.0f / 0.06f) + 0.5f)); } } while (0)
#else
#define TSP(k) nullptr
#define TSG_BEGIN(k) do {} while (0)
#define TSG_END(k) do {} while (0)
#endif
#ifndef PHASE_MASK
#define PHASE_MASK 0xFF
#endif
#define IN(k) (((PHASE_MASK >> (k)) & 1) && lo <= (k) && (k) < hi)
#define BOTH(k) (IN(k) && IN((k) + 1))

#ifndef DUP_PH
#define DUP_PH -1
#endif
#define PH_REP(k) for (int rep_ = 0; rep_ < ((DUP_PH == (k)) ? 2 : 1); ++rep_)
    if (IN(0)) { PH_REP(0) p0a_phase(F); if (BOTH(0)) GRID_BAR(); }
    if (IN(1)) { PH_REP(1) p0b_phase(F); if (BOTH(1)) GRID_BAR(); }
    if (IN(2)) { TSG_BEGIN(2); PH_REP(2) {
        { pg8::Gemm g{F.XN, F.WINP, M, 2048, 1024, 1024, 1 << 30, 128, (size_t)256 * 1024 * 2}; pg8::StaticOrder S; S.init(M, 2048, F.G, (int)blockIdx.x);
          EpiIn E{0, TSP(2), F.U, F.Q, F.KV, F.QI2, F.KI2, F.WI};
          pg8::gemm_phase<EpiIn, pg8::StaticOrder, true, true>(F.lds + RING_OFF, g, S, E); }
        }
        TSG_END(2);
        if (BOTH(2)) GRID_BAR();
    }
    if (IN(3)) { p3_phase(F); if (BOTH(3)) GRID_BAR(); }
    if (IN(4)) { PH_REP(4) {
        pg8::Gemm g{F.Z, F.WGLU, M, 512, 512, 512, 1 << 30, 128, (size_t)256 * 512 * 2}; pg8::StaticOrder S; S.init(M, 512, F.G, (int)blockIdx.x);
        EpiGlu E{0, TSP(4), F.Z, F.MIX, F.b_glu, F.SSQS};
        pg8::gemm_phase<EpiGlu, pg8::StaticOrder, true>(F.lds + RING_OFF, g, S, E); }
        if (BOTH(4)) GRID_BAR();
    }
    if (IN(5)) { TSG_BEGIN(5); PH_REP(5) {
        pg8::Gemm g{F.MIX, F.WOUT, M, 1024, 1024, 1024, 1 << 30, 128, (size_t)256 * 1024 * 2}; pg8::StaticOrder S; S.init(M, 1024, F.G, (int)blockIdx.x);
        EpiOut E{8, TSP(5), F.x, F.X1, F.A2, F.MOD, F.norm2_g, F.SSQS, F.SSQ2, F.SSQA};
        pg8::gemm_phase<EpiOut, pg8::StaticOrder, true>(F.lds + RING_OFF, g, S, E); }
        TSG_END(5);
        if (BOTH(5)) GRID_BAR();
    }
    if (IN(6)) { TSG_BEGIN(6); PH_REP(6) {
        pg8::Gemm g{F.A2, F.W1, M, DFF, 1024, 1024, 1 << 30, 128, (size_t)256 * 1024 * 2}; pg8::StaticOrder S; S.init(M, DFF, F.G, (int)blockIdx.x);
        LAS float* lrs_ = (LAS float*)(F.lds + BM_OFF); LAS float* lbias_ = lrs_ + 2048;
        up_tables(S, F.SSQ2, F.BIAS2, lrs_, lbias_);
        EpiUp E{0, TSP(6), lrs_, lbias_, F.H};
        pg8::gemm_phase<EpiUp, pg8::StaticOrder, true>(F.lds + RING_OFF, g, S, E); }
        TSG_END(6);
        if (BOTH(6)) GRID_BAR();
    }
#ifdef PROBE_BARS
    if (N_LAUNCHES == 1 && hi == NPHASE) { for (int i_ = 0; i_ < PROBE_BARS; ++i_) GRID_BAR(); }
#endif
    if (IN(7)) { PH_REP(7) {
        pg8::Gemm g{F.H, F.W2, M, 1024, DFF, 64, 1 << 30, (size_t)256 * 64 * 2, (size_t)256 * DFF * 2}; pg8::StaticOrder S; S.init(M, 1024, F.G, (int)blockIdx.x);
#if defined(TS_PROBE) || defined(TS_GEMM)
        const float psc_ = (blockIdx.x == 64) ? 1.0f + 16.0f * __uint_as_float(F.MISC[16]) : 1.0f;
#else
        const float psc_ = 1.0f;
#endif
        EpiDown E{0, nullptr, F.out, F.X1, F.MOD, psc_};
        pg8::gemm_phase<EpiDown, pg8::StaticOrder, true>(F.lds + RING_OFF, g, S, E); }
    }
#undef IN
#undef BOTH
}

extern "C" void kernel_launch(void* const* d_in, const int* in_sizes, int n_in, void* d_out, int out_size, void* d_ws, size_t ws_size, hipStream_t stream) {
    static int grid = 0;
    if (grid == 0) {
        if (n_in != 24 || in_sizes[0] != M * DM || out_size != M * DM || ws_size < WS_END) { fprintf(stderr, "kernel_launch: unexpected shapes (n_in %d, in0 %d, out %d, ws %zu); nothing launched\n", n_in, n_in > 0 ? in_sizes[0] : -1, out_size, ws_size); grid = -1; return; }
        int dev = 0, cus = 0, per_cu = 0;
        if (hipGetDevice(&dev) != hipSuccess || hipDeviceGetAttribute(&cus, hipDeviceAttributeMultiprocessorCount, dev) != hipSuccess) { fprintf(stderr, "kernel_launch: device query failed\n"); grid = -1; return; }
        if (hipFuncSetAttribute((const void*)fwd_kernel, hipFuncAttributeMaxDynamicSharedMemorySize, LDS_BYTES) != hipSuccess) { fprintf(stderr, "kernel_launch: hipFuncSetAttribute failed\n"); grid = -1; return; }
        if (hipOccupancyMaxActiveBlocksPerMultiprocessor(&per_cu, (const void*)fwd_kernel, NWAVES * 64, LDS_BYTES) != hipSuccess || per_cu < 1)
            fprintf(stderr, "kernel_launch: note: occupancy query reports %d workgroups per CU\n", per_cu);
        (void)hipGetLastError();
        grid = cus;
        if (grid != 256) { fprintf(stderr, "kernel_launch: this kernel is laid out for 256 CUs, found %d; nothing launched\n", grid); grid = -1; return; }
    }
    if (grid < 0) return;
    if (hipMemsetAsync((char*)d_ws + WS_CTL, 0, CTL_ZERO_BYTES, stream) != hipSuccess) { fprintf(stderr, "kernel_launch: memset failed\n"); return; }
    Args a{};
    for (int i = 0; i < 24; ++i) a.in[i] = (const float*)d_in[i];
    a.out = (float*)d_out; a.ws = (unsigned char*)d_ws;
#ifdef PROBE_SPLIT
    { const int lo_[3] = {0, PROBE_SPLIT, PROBE_SPLIT + 1}, hi_[3] = {PROBE_SPLIT + 1, PROBE_SPLIT + 1, NPHASE};
      for (int li = 0; li < 3; ++li) { a.ph_lo = lo_[li]; a.ph_hi = hi_[li]; a.li = li; hipLaunchKernelGGL(fwd_kernel, dim3(grid), dim3(NWAVES * 64), LDS_BYTES, stream, a); } }
#else
    for (int li = 0; li < N_LAUNCHES; ++li) {
        a.ph_lo = (N_LAUNCHES == 1) ? 0 : li; a.ph_hi = (N_LAUNCHES == 1) ? NPHASE : li + 1; a.li = li;
        hipLaunchKernelGGL(fwd_kernel, dim3(grid), dim3(NWAVES * 64), LDS_BYTES, stream, a);
        const hipError_t le = hipPeekAtLastError();
        if (le != hipSuccess) { fprintf(stderr, "kernel_launch: launch %d failed: %s\n", li, hipGetErrorName(le)); break; }
    }
#endif
#ifdef PROBE_PHASE
    a.ph_lo = PROBE_PHASE; a.ph_hi = PROBE_PHASE + 1; a.li = 1;
    hipLaunchKernelGGL(fwd_kernel, dim3(grid), dim3(NWAVES * 64), LDS_BYTES, stream, a);
#endif
}
```

```cpp
#include <hip/hip_runtime.h>
#include <cstdio>
#include <cstdint>

#ifndef MK_N_LAUNCHES
#define MK_N_LAUNCHES 1
#endif

namespace pg8 {
#define PG8_LAS __attribute__((address_space(3)))
typedef unsigned short bf16_t;
typedef short bf16x8 __attribute__((ext_vector_type(8)));
typedef float f32x4 __attribute__((ext_vector_type(4)));
typedef unsigned u32x4 __attribute__((ext_vector_type(4)));
typedef unsigned u32x2 __attribute__((ext_vector_type(2)));
constexpr int BM = 256, BK = 64, HALF = 128, HTB = HALF * BK * 2, STAGE_BYTES = 8 * HTB, NXCD = 8, WGM = 8;

__host__ __device__ __forceinline__ int lds_byte(int r, int c) { const int st = (r >> 4) * 2 + (c >> 5), rr = r & 15, cc = c & 31, ob = rr * 64 + cc * 2; return st * 1024 + (ob ^ (((ob >> 9) & 1) << 5)); }
__host__ __device__ __forceinline__ void stage_rc(int b, int& R, int& C) { const int st = b / 1024, sb = b % 1024, swz = sb ^ (((sb >> 9) & 1) << 5); R = (st >> 1) * 16 + swz / 64; C = (st & 1) * 32 + (swz % 64) / 2; }
__host__ __device__ __forceinline__ int perm32(int rho) { const int n = rho >> 4, i = rho & 15; return 8 * (i >> 2) + 4 * n + (i & 3); }

struct Unit { int pm, pn, idx; };
struct Gemm { const bf16_t* A; const bf16_t* Bt; int M, N, K, lda, wrapA; size_t kstepA, tstepA; };

struct StaticOrder {
    int nM, nN, nwg, G, c;
    __host__ __device__ void init(int M, int N, int G_, int c_) { nM = M / BM; nN = N / BM; nwg = nM * nN; G = G_; c = c_; }
    __host__ __device__ bool next(int i, Unit& u) const {
        const long L = (long)i * G + c; if (L >= nwg) return false;
        int wgid = (int)L; { const int q = nwg / NXCD, r = nwg % NXCD, xcd = wgid % NXCD, off = wgid / NXCD; wgid = (xcd < r ? xcd * (q + 1) : r * (q + 1) + (xcd - r) * q) + off; }
        const int nig = WGM * nN, gid = wgid / nig, fm = gid * WGM, gsz = (nM - fm) < WGM ? (nM - fm) : WGM;
        u.pm = fm + ((wgid % nig) % gsz); u.pn = (wgid % nig) / gsz; u.idx = i; return true;
    }
};

struct ListOrder {
    int nM, nN, nwg, cnt, first, stride;
    __host__ __device__ __forceinline__ void init(int M, int N, int cnt_, int first_, int stride_) { nM = M / BM; nN = N / BM; nwg = nM * nN; cnt = cnt_; first = first_; stride = stride_; }
    __host__ __device__ __forceinline__ bool next(int i, Unit& u) const {
        if (i >= cnt) return false;
        int wgid = first + i * stride;
        { const int q = nwg / NXCD, r = nwg % NXCD, xcd = wgid % NXCD, off = wgid / NXCD; wgid = (xcd < r ? xcd * (q + 1) : r * (q + 1) + (xcd - r) * q) + off; }
        const int nig = WGM * nN, gid = wgid / nig, fm = gid * WGM, gsz = (nM - fm) < WGM ? (nM - fm) : WGM;
        u.pm = fm + ((wgid % nig) % gsz); u.pn = (wgid % nig) / gsz; u.idx = i; return true;
    }
};

__device__ __forceinline__ unsigned cvt_pk_bf16(float lo, float hi) { unsigned r; asm volatile("v_cvt_pk_bf16_f32 %0, %1, %2" : "=v"(r) : "v"(lo), "v"(hi)); return r; }

typedef _Float16 f16x8 __attribute__((ext_vector_type(8)));
typedef int v4i_t __attribute__((ext_vector_type(4)));
typedef int v8i_t __attribute__((ext_vector_type(8)));
template <class Epi, class Sched, bool ALIGN_EPI, bool F16 = false, bool F8 = false>
__device__ __forceinline__ void gemm_phase(PG8_LAS unsigned char* lds, const Gemm g, const Sched& S, const Epi& E) {
    const int tid = threadIdx.x, wid = __builtin_amdgcn_readfirstlane(tid >> 6), lane = tid & 63, wr = wid >> 2, wc = wid & 3, fr = lane & 15, fq = lane >> 4;
    const int K = g.K, nt = K / BK, lda = g.lda, wrapA = g.wrapA;
    unsigned voffA[2], voffB[2];
#pragma unroll
    for (int i = 0; i < 2; ++i) { int R, C; stage_rc(tid * 16 + i * 8192, R, C); const int Rb = Epi::PERM ? ((R & ~31) + perm32(R & 31)) : R;
        voffA[i] = (unsigned)(R * lda + C) * 2u; voffB[i] = (unsigned)(Rb * K + C) * 2u; }
    const size_t kstep = (size_t)(BK * 2), kstepA = g.kstepA;
    const size_t hsA = (size_t)HALF * lda * 2, hsB = (size_t)HALF * K * 2;
    const size_t tsA = g.tstepA, tsB = 2 * hsB;
    const unsigned ldsw = (unsigned)wid * 1024u;
    const int aoff = lds_byte(wr * 64 + fr, F8 ? fq * 16 : fq * 8), boff = lds_byte(wc * 32 + fr, F8 ? fq * 16 : fq * 8);
#define PG8_SA(b, h) (((b) * 2 + (h)) * HTB)
#define PG8_SB(b, h) ((4 + (b) * 2 + (h)) * HTB)
#define PG8_STAGE(bufoff, gbase, voff) do { _Pragma("unroll") for (int _i = 0; _i < 2; ++_i) \
        __builtin_amdgcn_global_load_lds((const unsigned*)((const char*)(gbase) + (voff)[_i]), (PG8_LAS unsigned*)(lds + (bufoff) + ldsw + _i * 8192), 16, 0, 0); } while (0)
#define PG8_LD32(p) __builtin_shufflevector(*(const PG8_LAS v4i_t*)(p), *(const PG8_LAS v4i_t*)((p) + 16), 0, 1, 2, 3, 4, 5, 6, 7)
#define PG8_LDA(dst, b, h) do { if constexpr (F8) { _Pragma("unroll") for (int m = 0; m < 4; ++m) dst##_8[m] = PG8_LD32(lds + PG8_SA(b, h) + aoff + m * 2048); } \
        else { _Pragma("unroll") for (int m = 0; m < 4; ++m) _Pragma("unroll") for (int k = 0; k < 2; ++k) dst[m][k] = *(const PG8_LAS bf16x8*)(lds + PG8_SA(b, h) + aoff + m * 2048 + k * 1024); } } while (0)
#define PG8_LDB(dst, b, h) do { if constexpr (F8) { _Pragma("unroll") for (int n = 0; n < 2; ++n) dst##_8[n] = PG8_LD32(lds + PG8_SB(b, h) + boff + n * 2048); } \
        else { _Pragma("unroll") for (int n = 0; n < 2; ++n) _Pragma("unroll") for (int k = 0; k < 2; ++k) dst[n][k] = *(const PG8_LAS bf16x8*)(lds + PG8_SB(b, h) + boff + n * 2048 + k * 1024); } } while (0)
#define PG8_MMA(ai, bj, At, Bt) do { __builtin_amdgcn_s_setprio(1); \
        if constexpr (F8) { _Pragma("unroll") for (int m = 0; m < 4; ++m) _Pragma("unroll") for (int n = 0; n < 2; ++n) \
            asm volatile("v_mfma_scale_f32_16x16x128_f8f6f4 %0, %1, %2, %0, %3, %3 op_sel_hi:[0,0,0]" : "+v"(acc[ai][bj][m][n]) : "v"(Bt##_8[n]), "v"(At##_8[m]), "v"(one8_)); } \
        else { _Pragma("unroll") for (int m = 0; m < 4; ++m) _Pragma("unroll") for (int n = 0; n < 2; ++n) _Pragma("unroll") for (int k = 0; k < 2; ++k) \
        { if constexpr (F16) acc[ai][bj][m][n] = __builtin_amdgcn_mfma_f32_16x16x32_f16(__builtin_bit_cast(f16x8, Bt[n][k]), __builtin_bit_cast(f16x8, At[m][k]), acc[ai][bj][m][n], 0, 0, 0); \
          else acc[ai][bj][m][n] = __builtin_amdgcn_mfma_f32_16x16x32_bf16(Bt[n][k], At[m][k], acc[ai][bj][m][n], 0, 0, 0); } } __builtin_amdgcn_s_setprio(0); } while (0)
#define PG8_WAIT_V(n) asm volatile("s_waitcnt vmcnt(" #n ")" ::: "memory")
#define PG8_WAIT_L(n) asm volatile("s_waitcnt lgkmcnt(" #n ")" ::: "memory")
#define PG8_WAIT_VR do { if constexpr (Epi::NSTORE == 16) { const int rlx_ = __builtin_amdgcn_readfirstlane((int)(t == 0) & (int)(ui > 0)); \
        asm volatile("s_cmp_lg_u32 %0, 0\n\ts_cbranch_scc1 .Lrlx%=\n\ts_waitcnt vmcnt(8)\n.Lrlx%=:\n\ts_waitcnt vmcnt(24)" :: "s"(rlx_) : "scc", "memory"); } else PG8_WAIT_V(8); } while (0)
#define PG8_BAR __builtin_amdgcn_s_barrier()
#define PG8_SCHED __builtin_amdgcn_sched_barrier(0)
#define PG8_AT(t) ((t) >= wrapA ? (t) - wrapA : (t))
    Unit cur, nxt; int ui = 0;
    if (!S.next(0, cur)) return;
    f32x4 acc[2][2][4][2];
#pragma unroll
    for (int a = 0; a < 2; ++a)
#pragma unroll
        for (int b = 0; b < 2; ++b)
#pragma unroll
            for (int m = 0; m < 4; ++m)
#pragma unroll
                for (int n = 0; n < 2; ++n) acc[a][b][m][n] = (f32x4){0.f, 0.f, 0.f, 0.f};
    int one8_ = 0x7F7F7F7F; asm volatile("" : "+v"(one8_));
    bf16x8 At[4][2], B0[2][2], B1[2][2]; v8i_t At_8[4], B0_8[2], B1_8[2];
    const char* cA = (const char*)g.A + (size_t)cur.pm * tsA; const char* cB = (const char*)g.Bt + (size_t)cur.pn * tsB;
    PG8_STAGE(PG8_SB(0, 0), cB, voffB); PG8_STAGE(PG8_SB(0, 1), cB + hsB, voffB); PG8_STAGE(PG8_SA(0, 0), cA, voffA); PG8_STAGE(PG8_SA(0, 1), cA + hsA, voffA);
    if (wr == 1) PG8_BAR;
    PG8_WAIT_V(2); PG8_BAR;
    PG8_STAGE(PG8_SB(1, 0), cB + kstep, voffB); PG8_STAGE(PG8_SA(1, 0), cA + kstepA, voffA); PG8_STAGE(PG8_SB(1, 1), cB + hsB + kstep, voffB);
    PG8_WAIT_V(6); PG8_BAR;
    for (;;) {
        const bool has_next = S.next(ui + 1, nxt);
        const char* nA = has_next ? (const char*)g.A + (size_t)nxt.pm * tsA : cA; const char* nB = has_next ? (const char*)g.Bt + (size_t)nxt.pn * tsB : cB;
        for (int t = 0; t < nt; t += 2) {
            const bool last = (t == nt - 2);
            const char* a1 = cA + (size_t)PG8_AT(t + 1) * kstepA;
            const char* a2 = last ? nA : cA + (size_t)PG8_AT(t + 2) * kstepA; const char* b2 = last ? nB : cB + (size_t)(t + 2) * kstep;
            const char* a3 = a2 + kstepA; const char* b3 = b2 + kstep;
            if constexpr (Epi::MID) { if (t == E.tmid) E.mid(acc, cur, wr, wc, fr, fq); }
            PG8_LDB(B0, 0, 0); PG8_LDB(B1, 0, 1); PG8_SCHED; PG8_LDA(At, 0, 0); PG8_STAGE(PG8_SA(1, 1), a1 + hsA, voffA);
            PG8_WAIT_VR; PG8_BAR; PG8_WAIT_L(0); PG8_MMA(0, 0, At, B0); PG8_MMA(0, 1, At, B1); PG8_BAR; PG8_SCHED;
            PG8_LDA(At, 0, 1); PG8_STAGE(PG8_SB(0, 0), b2, voffB); PG8_STAGE(PG8_SB(0, 1), b2 + hsB, voffB); PG8_STAGE(PG8_SA(0, 0), a2, voffA);
            PG8_WAIT_VR; PG8_BAR; PG8_WAIT_L(0); PG8_MMA(1, 0, At, B0); PG8_MMA(1, 1, At, B1); PG8_BAR; PG8_SCHED;
            PG8_LDB(B0, 1, 0); PG8_LDB(B1, 1, 1); PG8_SCHED; PG8_LDA(At, 1, 0); PG8_STAGE(PG8_SA(0, 1), a2 + hsA, voffA);
            PG8_WAIT_V(8); PG8_BAR; PG8_WAIT_L(0); PG8_MMA(0, 0, At, B0); PG8_MMA(0, 1, At, B1); PG8_BAR; PG8_SCHED;
            PG8_LDA(At, 1, 1); PG8_STAGE(PG8_SB(1, 0), b3, voffB); PG8_STAGE(PG8_SB(1, 1), b3 + hsB, voffB); PG8_STAGE(PG8_SA(1, 0), a3, voffA);
            PG8_WAIT_V(8); PG8_BAR; PG8_WAIT_L(0); PG8_MMA(1, 0, At, B0); PG8_MMA(1, 1, At, B1); PG8_BAR; PG8_SCHED;
        }
        if constexpr (F8) { asm volatile("s_nop 15\n\ts_nop 7" ::: "memory"); }
        if constexpr (ALIGN_EPI) { if (wr == 0) PG8_BAR; }
#ifdef TS_GEMM
        { const unsigned long long te0_ = __builtin_amdgcn_s_memtime(); E(acc, cur, wr, wc, fr, fq); asm volatile("s_waitcnt vmcnt(0)" ::: "memory"); if (E.tsp) *E.tsp += __builtin_amdgcn_s_memtime() - te0_; }
#else
        E(acc, cur, wr, wc, fr, fq);
#endif
        if (!has_next) break;
#pragma unroll
        for (int a = 0; a < 2; ++a)
#pragma unroll
            for (int b = 0; b < 2; ++b)
#pragma unroll
                for (int m = 0; m < 4; ++m)
#pragma unroll
                    for (int n = 0; n < 2; ++n) acc[a][b][m][n] = (f32x4){0.f, 0.f, 0.f, 0.f};
        cur = nxt; cA = nA; cB = nB; ++ui;
        if constexpr (ALIGN_EPI) { if (wr == 1) PG8_BAR; }
    }
    PG8_WAIT_V(0);
    if constexpr (!ALIGN_EPI) { if (wr == 0) PG8_BAR; }
    PG8_BAR;
#undef PG8_SA
#undef PG8_SB
#undef PG8_STAGE
#undef PG8_LDA
#undef PG8_LDB
#undef PG8_MMA
#undef PG8_LD32
#undef PG8_WAIT_V
#undef PG8_WAIT_L
#undef PG8_WAIT_VR
#undef PG8_BAR
#undef PG8_SCHED
#undef PG8_AT
}
}

constexpr int NWAVES = 8;
constexpr int NPHASE = 8;
constexpr int N_LAUNCHES = MK_N_LAUNCHES;
constexpr int BATCH = 16, SEQ = 2048, DM = 1024, M = BATCH * SEQ;
constexpr int D_SSM = 512, NG = 32, GC = 16, NP = 64, D_ATT = 512, HD = 64, NH = 8, IH = 8, ID = 64, TOPK = 256, DFF = 4096, D_IN = 1864;
constexpr int N_PLAIN = 1280, N_IDX_PAD = 768;
constexpr float EPS = 1e-6f;
constexpr float IDX_SCALE = 0.125f * 0.35355339059327373f;

constexpr size_t MiB = 1u << 20;
constexpr size_t WS_CTL = 0, CTL_ZERO_BYTES = 64 * 1024;
constexpr size_t WS_MODP = 1 * MiB;
constexpr size_t WS_MOD = 4 * MiB;
constexpr size_t WS_BIAS2 = 4 * MiB + 512 * 1024;
constexpr size_t WS_SSQS = 5 * MiB;
constexpr size_t WS_SSQ2 = 6 * MiB;
constexpr size_t WS_SSQA = 35 * MiB + 512 * 1024;
constexpr size_t WS_WINP = 8 * MiB;
constexpr size_t WS_WINI = 11 * MiB;
constexpr size_t WS_WGLU = 16 * MiB;
constexpr size_t WS_WOUT = 17 * MiB;
constexpr size_t WS_W1 = 19 * MiB;
constexpr size_t WS_W2 = 27 * MiB;
constexpr size_t WS_SSMP = 35 * MiB;
constexpr size_t WS_U = 36 * MiB;
constexpr size_t WS_Q = 68 * MiB;
constexpr size_t WS_A2 = 36 * MiB;
constexpr size_t WS_XN = 100 * MiB;
constexpr size_t WS_X1 = 100 * MiB;
constexpr size_t WS_KV = 228 * MiB;
constexpr size_t WS_KI = 244 * MiB;
constexpr size_t WS_WI = 252 * MiB;
constexpr size_t WS_QI = 256 * MiB;
constexpr size_t WS_Z = 320 * MiB;
constexpr size_t WS_MIX = 352 * MiB;
constexpr size_t WS_H = 256 * MiB;
constexpr size_t WS_SSMF = 416 * MiB;
constexpr size_t WS_END = 512 * MiB;
constexpr int CW_BAR = 4096;

constexpr int RING_OFF = 0;
constexpr int WAVE_LDS = 17920;
constexpr int BM_OFF = 131072;
constexpr int XCH_OFF = 147456;
constexpr int LDSCTL_OFF = 155648, MISC_OFF = LDSCTL_OFF + 320;
constexpr int LDS_BYTES = 159744;

#define GAS __attribute__((address_space(1)))
#define LAS __attribute__((address_space(3)))
typedef unsigned short bf16;
typedef unsigned v4u __attribute__((ext_vector_type(4)));
typedef unsigned v2u __attribute__((ext_vector_type(2)));
typedef float f32x4 __attribute__((ext_vector_type(4)));
typedef float f32x2 __attribute__((ext_vector_type(2)));
typedef GAS unsigned gu32;
#define RLX_AGENT __ATOMIC_RELAXED, __HIP_MEMORY_SCOPE_AGENT
#define LDS_WAIT() asm volatile("s_waitcnt lgkmcnt(0)" ::: "memory")
#define VM_WAIT() asm volatile("s_waitcnt vmcnt(0)" ::: "memory")
__device__ __forceinline__ unsigned f2bf(float f) { unsigned u = __builtin_bit_cast(unsigned, f); return (u + 0x7fffu + ((u >> 16) & 1u)) >> 16; }
__device__ __forceinline__ unsigned pk2(float lo, float hi) { return f2bf(lo) | (f2bf(hi) << 16); }
typedef __bf16 bf16x2_t __attribute__((ext_vector_type(2)));
__device__ __forceinline__ unsigned cvtpk(float lo, float hi) { const f32x2 v = {lo, hi}; return __builtin_bit_cast(unsigned, __builtin_convertvector(v, bf16x2_t)); }
__device__ __forceinline__ v2u pack_fp8x8(const float (&v)[8]) { int w0 = 0, w1 = 0;
    w0 = __builtin_amdgcn_cvt_pk_fp8_f32(v[0], v[1], w0, false); w0 = __builtin_amdgcn_cvt_pk_fp8_f32(v[2], v[3], w0, true);
    w1 = __builtin_amdgcn_cvt_pk_fp8_f32(v[4], v[5], w1, false); w1 = __builtin_amdgcn_cvt_pk_fp8_f32(v[6], v[7], w1, true);
    return (v2u){(unsigned)w0, (unsigned)w1}; }
typedef _Float16 f16x2_t __attribute__((ext_vector_type(2)));
__device__ __forceinline__ unsigned pkh(float lo, float hi) { const f16x2_t v = {(_Float16)lo, (_Float16)hi}; return __builtin_bit_cast(unsigned, v); }
__device__ __forceinline__ float bf2f(unsigned h) { return __builtin_bit_cast(float, h << 16); }
__device__ __forceinline__ float bflo(unsigned w) { return __builtin_bit_cast(float, w << 16); }
__device__ __forceinline__ float bfhi(unsigned w) { return __builtin_bit_cast(float, w & 0xffff0000u); }

typedef __amdgpu_buffer_rsrc_t wt_rsrc_t;
__device__ __forceinline__ wt_rsrc_t wt_rsrc(const void* base) { return __builtin_amdgcn_make_buffer_rsrc(const_cast<void*>(base), 0, 0x7fffffff, 0x00020000); }
__device__ __forceinline__ void wt_st16(wt_rsrc_t r, unsigned byteoff, v4u v) { __builtin_amdgcn_raw_buffer_store_b128(v, r, (int)byteoff, 0, 16); }
__device__ __forceinline__ void wt_st8(wt_rsrc_t r, unsigned byteoff, v2u v) { __builtin_amdgcn_raw_buffer_store_b64(v, r, (int)byteoff, 0, 16); }
constexpr size_t WS_K8 = 448 * MiB;
constexpr int CW_KN = 12800;

#define XB_TMO      128
#define XB_XCNT(j)  (256  + 64 * (j))
#define XB_XSUB(j)  (1280 + 64 * (j))
#define XB_XGEN(j)  (2304 + 64 * (j))
#define XB_TOP      3328
#define XB_TOPGEN   3392
#define XCD_BAR_WORDS 3456
#define XB_SPIN_CAP (1u << 18)
__device__ __forceinline__ unsigned xb_ld(unsigned* p)              { return __hip_atomic_load(p, __ATOMIC_RELAXED, __HIP_MEMORY_SCOPE_AGENT); }
__device__ __forceinline__ unsigned xb_add(unsigned* p, unsigned v) { return __hip_atomic_fetch_add(p, v, __ATOMIC_RELAXED, __HIP_MEMORY_SCOPE_AGENT); }
__device__ __forceinline__ unsigned xb_xcc_id() { return (unsigned)__builtin_amdgcn_s_getreg((3 << 11) | 20) & 0xFu; }
#define XB_SPIN(cond, bar) do { unsigned _sp = 0; while (cond) { __builtin_amdgcn_s_sleep(1); \
    if ((++_sp & 255u) == 0u) { if (xb_ld(&(bar)[XB_TMO])) break; if (_sp > XB_SPIN_CAP) { atomicAdd(&(bar)[XB_TMO], 1u); break; } } } } while (0)
struct XcdBarrier { unsigned* bar; unsigned x; volatile LAS unsigned* st; };
__device__ __forceinline__ XcdBarrier xcd_barrier_post(unsigned* bar, volatile LAS unsigned* st) {
    XcdBarrier b; b.bar = bar; b.x = xb_xcc_id(); b.st = st;
    if (threadIdx.x == 0) (void)xb_add(&bar[XB_XCNT(b.x)], 1u);
    return b;
}
__device__ __forceinline__ void xcd_barrier_complete(unsigned* bar, unsigned x, unsigned& nloc, unsigned& nx) {
    const unsigned G = gridDim.x * gridDim.y * gridDim.z;
    unsigned sum, cnt, mine, sp = 0u;
    for (;;) {
        sum = 0u; cnt = 0u; mine = 0u;
#pragma unroll
        for (unsigned j = 0; j < 16; ++j) { const unsigned c = xb_ld(&bar[XB_XCNT(j)]); sum += c; cnt += (c > 0u) ? 1u : 0u; mine = (j == x) ? c : mine; }
        if (sum == G) break;
        __builtin_amdgcn_s_sleep(1);
        if ((++sp & 255u) == 0u) { if (xb_ld(&bar[XB_TMO])) break; if (sp > XB_SPIN_CAP) { atomicAdd(&bar[XB_TMO], 1u); break; } }
    }
    nloc = mine > 0u ? mine : 1u; nx = cnt > 0u ? cnt : 1u;
}
__device__ __forceinline__ void xcd_barrier(const XcdBarrier& b) {
    asm volatile("s_waitcnt vmcnt(0)" ::: "memory");
    __syncthreads();
    if (threadIdx.x == 0) {
        unsigned* bar = b.bar;
        __builtin_amdgcn_s_waitcnt(0);
        unsigned nloc = b.st[0], nx = b.st[1];
        if (nloc == 0u) { xcd_barrier_complete(bar, b.x, nloc, nx); b.st[0] = nloc; b.st[1] = nx; }
        const unsigned old = xb_add(&bar[XB_XSUB(b.x)], 1u);
        const unsigned gen = old / nloc;
        if (old + 1u == (gen + 1u) * nloc) {
            __builtin_amdgcn_fence(__ATOMIC_RELEASE, "agent");
            asm volatile("s_waitcnt vmcnt(0)" ::: "memory");
            const unsigned og = xb_add(&bar[XB_TOP], 1u);
            const unsigned tg = og / nx;
            if (og + 1u == (tg + 1u) * nx) xb_add(&bar[XB_TOPGEN], 1u);
            else XB_SPIN(xb_ld(&bar[XB_TOPGEN]) == tg, bar);
            xb_add(&bar[XB_XGEN(b.x)], 1u);
            __builtin_amdgcn_fence(__ATOMIC_ACQUIRE, "agent");
            asm volatile("s_waitcnt vmcnt(0)" ::: "memory");
        } else {
            XB_SPIN(xb_ld(&bar[XB_XGEN(b.x)]) == gen, bar);
            __builtin_amdgcn_fence(__ATOMIC_ACQUIRE, "agent");
            asm volatile("s_waitcnt vmcnt(0)" ::: "memory");
        }
    }
    __syncthreads();
}

#ifdef TS_PROBE
#define TS_T0() const unsigned long long ts0_ = __builtin_amdgcn_s_memtime()
#define TS_ACC(k) do { if ((k) == TS_PROBE) F.tsacc += __builtin_amdgcn_s_memtime() - ts0_; } while (0)
#else
#define TS_T0() do {} while (0)
#define TS_ACC(k) do {} while (0)
#endif
struct Frame {
    unsigned long long tsacc;
    LAS unsigned char* lds;
    volatile LAS unsigned* MISC;
    gu32* ctl;
    int tid, lane, wave;
    int vcu, G;
    const float *x, *c, *norm1_g, *norm2_g, *w_ada, *b_ada, *w_in, *lam_re, *lam_im, *log_dt, *b_re, *b_im, *c_re, *c_im, *d_skip, *w_glu, *b_glu, *q_gain, *k_gain, *gn_ssm, *gn_attn, *w_out, *w_ff1, *w_ff2;
    float* out;
    float *MODP, *MOD, *BIAS2, *SSQS, *SSQ2, *SSQA, *WI; bf16* X1;
    bf16 *KI2, *QI2, *SSMF;
    f32x2 *LAMB, *BBAR;
    bf16 *WINP, *WINI, *WGLU, *WOUT, *W1, *W2, *U, *Q, *A2, *XN, *KV, *Z, *MIX, *H;
};

__device__ __forceinline__ float wave_sum(float v) {
#pragma unroll
    for (int o = 1; o < 64; o <<= 1) v += __shfl_xor(v, o);
    return v;
}
__device__ __forceinline__ float wave_max(float v) {
#pragma unroll
    for (int o = 1; o < 64; o <<= 1) v = fmaxf(v, __shfl_xor(v, o));
    return v;
}
__device__ __forceinline__ int wave_sum_i(int v) {
#pragma unroll
    for (int o = 1; o < 64; o <<= 1) v += __shfl_xor(v, o);
    return v;
}

__device__ __forceinline__ double exp_d(double x) {
    const double n = __builtin_rint(x * 1.4426950408889634);
    const double r = (x - n * 0.693147180369123816490e+00) - n * 1.90821492927058770002e-10;
    double p = 1.0 / 87178291200.0;
    p = p * r + 1.0 / 6227020800.0; p = p * r + 1.0 / 479001600.0; p = p * r + 1.0 / 39916800.0; p = p * r + 1.0 / 3628800.0; p = p * r + 1.0 / 362880.0;
    p = p * r + 1.0 / 40320.0; p = p * r + 1.0 / 5040.0; p = p * r + 1.0 / 720.0; p = p * r + 1.0 / 120.0; p = p * r + 1.0 / 24.0; p = p * r + 1.0 / 6.0; p = p * r + 0.5; p = p * r + 1.0; p = p * r + 1.0;
    const long long e = (long long)n + 1023;
    return p * __builtin_bit_cast(double, (unsigned long long)e << 52);
}
__device__ __forceinline__ void sincos_d(double x, double& s, double& c) {
    const double n = __builtin_rint(x * 0.63661977236758134308);
    double r = (x - n * 1.57079632673412561417e+00) - n * 6.07710050650619224932e-11;
    r = r - n * 2.02226624879595063154e-21;
    const double r2 = r * r;
    double sp = -1.0 / 1307674368000.0;
    sp = sp * r2 + 1.0 / 6227020800.0; sp = sp * r2 - 1.0 / 39916800.0; sp = sp * r2 + 1.0 / 362880.0; sp = sp * r2 - 1.0 / 5040.0; sp = sp * r2 + 1.0 / 120.0; sp = sp * r2 - 1.0 / 6.0; sp = sp * r2 + 1.0;
    const double sr = sp * r;
    double cp = 1.0 / 20922789888000.0;
    cp = cp * r2 - 1.0 / 87178291200.0; cp = cp * r2 + 1.0 / 479001600.0; cp = cp * r2 - 1.0 / 3628800.0; cp = cp * r2 + 1.0 / 40320.0; cp = cp * r2 - 1.0 / 720.0; cp = cp * r2 + 1.0 / 24.0; cp = cp * r2 - 0.5; cp = cp * r2 + 1.0;
    const long long q = (long long)n & 3;
    s = (q == 0) ? sr : (q == 1) ? cp : (q == 2) ? -sr : -cp;
    c = (q == 0) ? cp : (q == 1) ? -sr : (q == 2) ? -cp : sr;
}

constexpr float W2_SCALE = 128.0f, H_SCALE = 4.0f, H_ROOT = 2.0f, H_RMAX = 21.16f;
template <int MODE>
__device__ __forceinline__ void p0_transpose_item(Frame& F, const float* W, int K, int N, bf16* WT, LAS float* scr, int item, int lane) {
    const int nblk = (N + 31) / 32, kb = item / nblk, nb = item % nblk, k0 = 64 * kb, n0 = 32 * nb;
    const int kr = lane >> 3, nq = 4 * (lane & 7);
    f32x4 ld[8];
#pragma unroll
    for (int i = 0; i < 8; ++i) { const int k = 8 * i + kr; ld[i] = (MODE != 1 || n0 + nq < N) ? *(const f32x4*)(W + (size_t)(k0 + k) * N + n0 + nq) : (f32x4){0.f, 0.f, 0.f, 0.f}; }
#pragma unroll
    for (int i = 0; i < 8; ++i) { const int k = 8 * i + kr; f32x4 v = ld[i];
        if (MODE == 2) { const int kk = k0 + k; v = v * ((kk < D_SSM) ? F.gn_ssm[kk] : F.gn_attn[kk - D_SSM]); }
        scr[k * 33 + nq] = v.x; scr[k * 33 + nq + 1] = v.y; scr[k * 33 + nq + 2] = v.z; scr[k * 33 + nq + 3] = v.w; }
    LDS_WAIT(); asm volatile("" ::: "memory");
    const int c = lane & 7;
#pragma unroll
    for (int j = 0; j < 4; ++j) { const int n = (lane >> 3) + 8 * j; const LAS float* sp = scr + (8 * c) * 33 + n;
        float v[8];
#pragma unroll
        for (int e = 0; e < 8; ++e) v[e] = sp[e * 33];
        if (MODE == 4) {
            float sv8[8];
#pragma unroll
            for (int e = 0; e < 8; ++e) sv8[e] = v[e] * W2_SCALE;
            *(GAS v2u*)((GAS unsigned char*)WT + (size_t)(n0 + n) * K + k0 + 8 * c) = pack_fp8x8(sv8);
        } else {
        v4u o;
        if (MODE == 1) { o.x = pkh(v[0], v[1]); o.y = pkh(v[2], v[3]); o.z = pkh(v[4], v[5]); o.w = pkh(v[6], v[7]); }
        else { o.x = pk2(v[0], v[1]); o.y = pk2(v[2], v[3]); o.z = pk2(v[4], v[5]); o.w = pk2(v[6], v[7]); }
        *(GAS v4u*)(WT + (size_t)(n0 + n) * K + k0 + 8 * c) = o; } }
    LDS_WAIT(); asm volatile("" ::: "memory");
}

__device__ __forceinline__ void p0_mod_item(Frame& F, int item, LAS float* scr) {
    const int cg = item >> 3, ks = item & 7, j = cg * 64 + F.lane, k0 = ks * 128;
#pragma unroll 1
    for (int hq = 0; hq < 4; ++hq) { float cvv[8];
#pragma unroll
      for (int q8 = 0; q8 < 8; ++q8) { const int q = 8 * hq + q8; const float* cb_ = F.c + (q >> 1) * 1024 + k0 + 64 * (q & 1); cvv[q8] = cb_[F.lane]; }
#pragma unroll
      for (int q8 = 0; q8 < 8; ++q8) scr[F.lane + 64 * (8 * hq + q8)] = cvv[q8] * __builtin_amdgcn_rcpf(1.f + __expf(-cvv[q8])); }
    LDS_WAIT(); asm volatile("" ::: "memory");
    float acc[16];
#pragma unroll
    for (int b = 0; b < 16; ++b) acc[b] = 0.f;
#pragma unroll 1
    for (int hf = 0; hf < 4; ++hf) {
        float wv[32];
#pragma unroll
        for (int i = 0; i < 32; ++i) { const float* rowb = F.w_ada + (size_t)(k0 + 32 * hf + i) * 6144; wv[i] = rowb[j]; }
#pragma unroll
        for (int i4 = 0; i4 < 8; ++i4) {
#pragma unroll
            for (int b = 0; b < 16; ++b) { const f32x4 sv = *(const LAS f32x4*)(scr + b * 128 + 32 * hf + 4 * i4); acc[b] += sv.x * wv[4 * i4] + sv.y * wv[4 * i4 + 1] + sv.z * wv[4 * i4 + 2] + sv.w * wv[4 * i4 + 3]; }
            asm volatile("" ::: "memory"); }
    }
#pragma unroll
    for (int b = 0; b < 16; ++b) F.MODP[(size_t)(ks * 16 + b) * 6144 + j] = acc[b];
    LDS_WAIT(); asm volatile("" ::: "memory");
}

__device__ __forceinline__ void p0_ssm_item(Frame& F, int g) {
    const int p = F.lane, gp = g * 64 + p;
    const double lre = (double)F.lam_re[gp], lim = (double)F.lam_im[gp], dt = exp_d((double)F.log_dt[g]);
    double s, c; sincos_d(lim * dt, s, c);
    const double mag = exp_d(lre * dt), lbr = mag * c, lbi = mag * s;
    const double a = lbr - 1.0, b = lbi, den = lre * lre + lim * lim;
    const double cr = (a * lre + b * lim) / den, ci = (b * lre - a * lim) / den;
    F.LAMB[gp] = (f32x2){(float)lbr, (float)lbi};
#pragma unroll
    for (int cc = 0; cc < 16; ++cc) { const double br = (double)F.b_re[gp * 16 + cc], bi = (double)F.b_im[gp * 16 + cc];
        F.BBAR[gp * 16 + cc] = (f32x2){(float)(cr * br - ci * bi), (float)(cr * bi + ci * br)}; }
}

constexpr int I_IN = 16 * 59, I_GLU = 8 * 16, I_OUT = 16 * 32, I_1 = 16 * 128, I_2 = 64 * 32, N_TR_ITEMS = I_IN + I_GLU + I_OUT + I_1 + I_2;
__device__ __forceinline__ void tr_item(Frame& F, int it, LAS float* scr) {
    int r = it;
    if (r < I_IN) { p0_transpose_item<1>(F, F.w_in, 1024, D_IN, F.WINP, scr, r, F.lane); return; } r -= I_IN;
    if (r < I_GLU) { p0_transpose_item<0>(F, F.w_glu, 512, 512, F.WGLU, scr, r, F.lane); return; } r -= I_GLU;
    if (r < I_OUT) { p0_transpose_item<2>(F, F.w_out, 1024, 1024, F.WOUT, scr, r, F.lane); return; } r -= I_OUT;
    if (r < I_1) { p0_transpose_item<0>(F, F.w_ff1, 1024, DFF, F.W1, scr, r, F.lane); return; } r -= I_1;
    p0_transpose_item<4>(F, F.w_ff2, DFF, 1024, F.W2, scr, r, F.lane);
}
__device__ __forceinline__ void p0a_phase(Frame& F) {
    LAS float* scr = (LAS float*)(F.lds + RING_OFF + F.wave * WAVE_LDS);
    const int gw = F.vcu * NWAVES + F.wave, NGW = F.G * NWAVES;
    constexpr int I_MOD = 96 * 8, I_SSM = 32;
    for (int it = gw; it < I_MOD + I_SSM; it += NGW) { if (it < I_MOD) p0_mod_item(F, it, scr); else p0_ssm_item(F, it - I_MOD); }
    if (gw >= I_MOD + I_SSM) { const int NW_ = NGW - (I_MOD + I_SSM);
        for (int it = gw - (I_MOD + I_SSM); it < N_TR_ITEMS; it += NW_) tr_item(F, it, scr);
        { const int gt = (gw - (I_MOD + I_SSM)) * 64 + F.lane, NT = NW_ * 64; GAS v4u* z = (GAS v4u*)(F.WINP + (size_t)1888 * 1024);
          for (int i = gt; i < 160 * 1024 / 8; i += NT) z[i] = (v4u){0u, 0u, 0u, 0u}; } }
}

__device__ __forceinline__ f32x2 cmul(f32x2 a, f32x2 b) { return (f32x2){a.x * b.x - a.y * b.y, a.x * b.y + a.y * b.x}; }
template <int NBITS = 5>
__device__ __forceinline__ f32x2 cpow(f32x2 a, int e) { f32x2 r = {1.f, 0.f}; f32x2 bq = a;
#pragma unroll
    for (int k = 0; k < NBITS; ++k) { if (e & (1 << k)) r = cmul(r, bq); if (k + 1 < NBITS) bq = cmul(bq, bq); }
    return r; }
__device__ __forceinline__ void ssm_frag_item(Frame& F, int item, LAS float* scr) {
    const int g = item / 144, bi = item % 144, lane = F.lane, il = lane & 15, kq = lane >> 4;
    float v[8];
#pragma unroll
    for (int j = 0; j < 8; ++j) v[j] = 0.f;
    if (bi < 16) {
        LAS f32x2* Cs = (LAS f32x2*)scr;
        LAS f32x2* Bs = Cs + 16 * 65;
        LAS f32x2* Pw = Bs + 64 * 16;
        { float cr[16], ci[16]; f32x2 bb[16];
#pragma unroll
          for (int q = 0; q < 16; ++q) { cr[q] = F.c_re[(g * 16 + q) * 64 + lane]; ci[q] = F.c_im[(g * 16 + q) * 64 + lane]; bb[q] = F.BBAR[g * 1024 + q * 64 + lane]; }
          const f32x2 lam = F.LAMB[g * 64 + lane];
#pragma unroll
          for (int q = 0; q < 16; ++q) { Cs[q * 65 + lane] = (f32x2){cr[q], ci[q]}; Bs[q * 64 + lane] = bb[q]; }
          Pw[lane] = cpow(lam, bi); Pw[64 + lane] = (bi > 0) ? cpow(lam, bi - 1) : (f32x2){0.f, 0.f}; }
        LDS_WAIT(); asm volatile("" ::: "memory");
        const LAS f32x2* pwr = Pw + (kq >> 1) * 64; const LAS f32x2* brow = Bs + 8 * (kq & 1);
#pragma unroll 4
        for (int p = 0; p < 64; ++p) {
            const f32x2 cw = cmul(Cs[il * 65 + p], pwr[p]);
#pragma unroll
            for (int j = 0; j < 8; ++j) { const f32x2 bv = brow[p * 16 + j]; v[j] += cw.x * bv.x - cw.y * bv.y; }
        }
        LDS_WAIT(); asm volatile("" ::: "memory");
    } else if (bi < 80) {
        const int e = bi - 16, i = e >> 3, kb = e & 7, R = 16 * i + il, p = R & 63, s_ = 2 * kb + (kq >> 1);
        const f32x2 pw = cpow(F.LAMB[g * 64 + p], 15 - s_);
        const f32x2* bb = F.BBAR + (g * 64 + p) * 16 + 8 * (kq & 1);
#pragma unroll
        for (int j = 0; j < 8; ++j) { const f32x2 wv = cmul(pw, bb[j]); v[j] = (R >= 64) ? wv.y : wv.x; }
    } else {
        const int e = bi - 80, t = e >> 2, ks = e & 3;
#pragma unroll
        for (int j = 0; j < 8; ++j) { const int sg = 16 * (2 * ks + (j >> 2)) + 4 * kq + (j & 3), p = sg & 63;
            const f32x2 pw = cpow(F.LAMB[g * 64 + p], t + 1);
            const f32x2 cw = cmul((f32x2){F.c_re[(g * 16 + il) * 64 + p], F.c_im[(g * 16 + il) * 64 + p]}, pw);
            v[j] = (sg >= 64) ? -cw.y : cw.x; }
    }
    v4u o; o.x = pk2(v[0], v[1]); o.y = pk2(v[2], v[3]); o.z = pk2(v[4], v[5]); o.w = pk2(v[6], v[7]);
    *(GAS v4u*)(F.SSMF + (size_t)item * 512 + lane * 8) = o;
}

__device__ __forceinline__ void p0b_phase(Frame& F) {
    const int w = F.vcu;
    { const int idx = w * 384 + F.tid;
      if (F.tid < 384 && idx < 16 * 6144) { const int j = idx % 6144; float s = F.b_ada[j];
#pragma unroll
          for (int ks = 0; ks < 8; ++ks) s += F.MODP[(size_t)ks * 16 * 6144 + idx];
          F.MOD[idx] = s; } }
    LAS float* sh = (LAS float*)(F.lds + RING_OFF);
    const int rb = w;
    { const int b = rb / 16;
#pragma unroll
      for (int e = F.tid; e < 2048; e += NWAVES * 64) { float s_ = F.b_ada[e];
#pragma unroll
          for (int ks = 0; ks < 8; ++ks) s_ += F.MODP[(size_t)(ks * 16 + b) * 6144 + e];
          sh[e] = s_; } }
    __syncthreads();
    if (F.wave >= 6) {
        LAS float* scr = (LAS float*)(F.lds + RING_OFF + 8192 + (F.wave - 6) * WAVE_LDS);
        const int gwi = F.vcu * 2 + (F.wave - 6), NGWI = F.G * 2;
        for (int it = gwi; it < NG * 144; it += NGWI) ssm_frag_item(F, it, scr);
    } else {
        f32x4 gm[4], sv[4];
#pragma unroll
        for (int j = 0; j < 4; ++j) { const int col = 4 * F.lane + 256 * j; gm[j] = (*(const f32x4*)(F.norm1_g + col)) * (*(const LAS f32x4*)(sh + 1024 + col) + 1.0f); sv[j] = *(const LAS f32x4*)(sh + col); }
        for (int r4 = 4 * F.wave; r4 < 128; r4 += 24) {
            f32x4 v[4][4];
#pragma unroll
            for (int q = 0; q < 4; ++q) { const GAS f32x4* xr = (const GAS f32x4*)(F.x + ((size_t)rb * 128 + r4 + q) * DM) + F.lane;
#pragma unroll
                for (int j = 0; j < 4; ++j) v[q][j] = xr[64 * j]; }
#pragma unroll
            for (int q = 0; q < 4; ++q) {
                const size_t m = (size_t)rb * 128 + r4 + q; float ss = 0.f;
#pragma unroll
                for (int j = 0; j < 4; ++j) ss += (v[q][j].x * v[q][j].x + v[q][j].y * v[q][j].y) + (v[q][j].z * v[q][j].z + v[q][j].w * v[q][j].w);
                const float rstd = __builtin_amdgcn_rsqf(wave_sum(ss) * (1.f / DM) + EPS);
                GAS v2u* oh = (GAS v2u*)(F.XN + m * 1024) + F.lane;
#pragma unroll
                for (int j = 0; j < 4; ++j) { const f32x4 h = (v[q][j] * rstd) * gm[j] + sv[j];
                    oh[64 * j] = (v2u){pkh(h.x, h.y), pkh(h.z, h.w)}; }
            }
        }
    }
}

using pg8::Unit; using pg8::cvt_pk_bf16;
struct EpiIn {
    static constexpr int NSTORE = 0; static constexpr bool PERM = true, MID = false; int tmid; unsigned long long* tsp;
    bf16 *U, *Q, *KV, *QI, *KI; float* WI;
    __device__ __forceinline__ void mid(f32x4 (&)[2][2][4][2], const Unit&, int, int, int, int) const {}
    __device__ __forceinline__ void operator()(const f32x4 (&acc)[2][2][4][2], const Unit& u, int wr, int wc, int fr, int fq) const {
        const int row0 = u.pm * 256 + wr * 64 + fr;
        if (u.pn < 7) {
            bf16* base; int ldc, colt; const bool h16 = u.pn >= 5;
            if (u.pn < 2) { base = U; ldc = 512; colt = u.pn * 256; } else if (u.pn < 4) { base = Q; ldc = 512; colt = (u.pn - 2) * 256; } else if (u.pn == 4) { base = KV; ldc = 256; colt = 0; } else { base = QI; ldc = 512; colt = (u.pn - 5) * 256; }
            const int col0 = colt + wc * 32 + 8 * fq;
#pragma unroll
            for (int ai = 0; ai < 2; ++ai)
#pragma unroll
                for (int m = 0; m < 4; ++m) { bf16* rowp = base + (size_t)(row0 + ai * 128 + m * 16) * ldc + col0;
#pragma unroll
                    for (int bj = 0; bj < 2; ++bj) { const f32x4 v0 = acc[ai][bj][m][0], v1 = acc[ai][bj][m][1];
                        v4u wv;
                        if (h16) { wv.x = pkh(v0[0], v0[1]); wv.y = pkh(v0[2], v0[3]); wv.z = pkh(v1[0], v1[1]); wv.w = pkh(v1[2], v1[3]); }
                        else { wv.x = cvt_pk_bf16(v0[0], v0[1]); wv.y = cvt_pk_bf16(v0[2], v0[3]); wv.z = cvt_pk_bf16(v1[0], v1[1]); wv.w = cvt_pk_bf16(v1[2], v1[3]); }
                        *(v4u*)(rowp + bj * 128) = wv; } }
        } else {
            const int col0 = wc * 32 + 8 * fq;
#pragma unroll
            for (int ai = 0; ai < 2; ++ai)
#pragma unroll
                for (int m = 0; m < 4; ++m) { const size_t row = (size_t)(row0 + ai * 128 + m * 16); const f32x4 v0 = acc[ai][0][m][0], v1 = acc[ai][0][m][1];
                    if (col0 < 64) { v4u wv; wv.x = pkh(v0[0], v0[1]); wv.y = pkh(v0[2], v0[3]); wv.z = pkh(v1[0], v1[1]); wv.w = pkh(v1[2], v1[3]); *(v4u*)(KI + row * 64 + col0) = wv; }
                    else if (col0 == 64) { *(f32x4*)(WI + row * 8) = v0; *(f32x4*)(WI + row * 8 + 4) = v1; } }
        }
    }
};
struct EpiGlu {
    static constexpr int NSTORE = 0; static constexpr bool PERM = true, MID = false; int tmid; unsigned long long* tsp;
    const bf16* Z; bf16* MIX; const float* bglu; float* SSQS;
    __device__ __forceinline__ void mid(f32x4 (&)[2][2][4][2], const Unit&, int, int, int, int) const {}
    __device__ __forceinline__ void operator()(const f32x4 (&acc)[2][2][4][2], const Unit& u, int wr, int wc, int fr, int fq) const {
        const int row0 = u.pm * 256 + wr * 64 + fr, col0 = u.pn * 256 + wc * 32 + 8 * fq;
        f32x4 bg[2][2];
#pragma unroll
        for (int bj = 0; bj < 2; ++bj) { bg[bj][0] = *(const f32x4*)(bglu + col0 + bj * 128); bg[bj][1] = *(const f32x4*)(bglu + col0 + bj * 128 + 4); }
#pragma unroll
        for (int ai = 0; ai < 2; ++ai)
#pragma unroll
            for (int m = 0; m < 4; ++m) { const size_t row = (size_t)(row0 + ai * 128 + m * 16); float ss = 0.f;
#pragma unroll
                for (int bj = 0; bj < 2; ++bj) { const int col = col0 + bj * 128;
                    const v4u zz = *(const v4u*)(Z + row * 512 + col);
                    const f32x4 b0 = bg[bj][0], b1 = bg[bj][1];
                    const f32x4 a0 = acc[ai][bj][m][0] + b0, a1 = acc[ai][bj][m][1] + b1;
                    float zf[8] = {bflo(zz.x), bfhi(zz.x), bflo(zz.y), bfhi(zz.y), bflo(zz.z), bfhi(zz.z), bflo(zz.w), bfhi(zz.w)};
                    float av[8] = {a0[0], a0[1], a0[2], a0[3], a1[0], a1[1], a1[2], a1[3]}, y[8];
#pragma unroll
                    for (int e = 0; e < 8; ++e) { y[e] = zf[e] * __builtin_amdgcn_rcpf(1.f + __expf(-av[e])); ss += y[e] * y[e]; }
                    v4u wv; wv.x = cvt_pk_bf16(y[0], y[1]); wv.y = cvt_pk_bf16(y[2], y[3]); wv.z = cvt_pk_bf16(y[4], y[5]); wv.w = cvt_pk_bf16(y[6], y[7]);
                    *(v4u*)(MIX + row * 1024 + col) = wv; }
                ss += __shfl_xor(ss, 16); ss += __shfl_xor(ss, 32);
                if (fq == 0) SSQS[row * 8 + u.pn * 4 + wc] = ss; }
    }
};
struct EpiOut {
    static constexpr int NSTORE = 0; static constexpr bool PERM = true, MID = true; int tmid; unsigned long long* tsp;
    const float* x; bf16* x1; bf16* A2; const float* MOD; const float* g2n; const float* SSQS; float* SSQ2; const float* SSQA;
    __device__ __forceinline__ void mid(f32x4 (&acc)[2][2][4][2], const Unit& u, int wr, int wc, int fr_, int fq_) const {
        int fr = fr_, fq = fq_; asm volatile("" : "+v"(fr), "+v"(fq));
#pragma unroll
        for (int ai = 0; ai < 2; ++ai)
#pragma unroll
            for (int m = 0; m < 4; ++m) { const size_t row = (size_t)(u.pm * 256 + ai * 128 + wr * 64 + m * 16 + fr);
                const f32x4 p = *(const f32x4*)(SSQS + row * 8 + 4 * (fq & 1)); float s = (p.x + p.y) + (p.z + p.w); s += __shfl_xor(s, 16);
                const f32x2 sa = *(const f32x2*)(SSQA + row * 2);
                const float rstd = __builtin_amdgcn_sqrtf((sa.x + sa.y) * (1.f / 512.f) + EPS) * __builtin_amdgcn_rsqf(s * (1.f / 512.f) + EPS);
#pragma unroll
                for (int bj = 0; bj < 2; ++bj)
#pragma unroll
                    for (int n = 0; n < 2; ++n) acc[ai][bj][m][n] *= rstd; }
    }
    __device__ __forceinline__ void operator()(const f32x4 (&acc)[2][2][4][2], const Unit& u, int wr, int wc, int fr, int fq) const {
        const int b = u.pm >> 3; const float* mod = MOD + (size_t)b * 6144;
        const int row0 = u.pm * 256 + wr * 64 + fr, col0 = u.pn * 256 + wc * 32 + 8 * fq;
        f32x4 g1v[2][2], g2v[2][2];
#pragma unroll
        for (int bj = 0; bj < 2; ++bj)
#pragma unroll
            for (int n = 0; n < 2; ++n) { const int c4 = col0 + bj * 128 + 4 * n; g1v[bj][n] = *(const f32x4*)(mod + 2048 + c4); g2v[bj][n] = (*(const f32x4*)(g2n + c4)) * (*(const f32x4*)(mod + 4096 + c4) + 1.0f); }
        f32x4 xv[2][2][2]; f32x2 sav[2];
#define EPO_LOAD(slot, rg) do { const size_t row_ = (size_t)(row0 + ((rg) >> 2) * 128 + ((rg) & 3) * 16); sav[slot] = *(const f32x2*)(SSQA + row_ * 2); \
        _Pragma("unroll") for (int bj = 0; bj < 2; ++bj) _Pragma("unroll") for (int n = 0; n < 2; ++n) xv[slot][bj][n] = *(const f32x4*)(x + row_ * 1024 + col0 + bj * 128 + 4 * n); } while (0)
        EPO_LOAD(0, 0);
#pragma unroll
        for (int rg = 0; rg < 8; ++rg) { const int ai = rg >> 2, m = rg & 3, sl = rg & 1;
            if (rg + 1 < 8) { if (sl == 0) EPO_LOAD(1, rg + 1); else EPO_LOAD(0, rg + 1); }
            const size_t row = (size_t)(row0 + ai * 128 + m * 16); float ss = 0.f;
            const float ra = __builtin_amdgcn_rsqf((sav[sl].x + sav[sl].y) * (1.f / 512.f) + EPS);
#pragma unroll
            for (int bj = 0; bj < 2; ++bj) { const int col = col0 + bj * 128; float a2[8]; float x8[8];
#pragma unroll
                for (int n = 0; n < 2; ++n) { const int c4 = col + 4 * n;
                    const f32x4 v = xv[sl][bj][n] + g1v[bj][n] * (acc[ai][bj][m][n] * ra);
                    x8[4 * n] = v.x; x8[4 * n + 1] = v.y; x8[4 * n + 2] = v.z; x8[4 * n + 3] = v.w; ss += (v.x * v.x + v.y * v.y) + (v.z * v.z + v.w * v.w);
                    const f32x4 a = v * g2v[bj][n]; a2[4 * n] = a.x; a2[4 * n + 1] = a.y; a2[4 * n + 2] = a.z; a2[4 * n + 3] = a.w; }
                v4u wv; wv.x = cvt_pk_bf16(a2[0], a2[1]); wv.y = cvt_pk_bf16(a2[2], a2[3]); wv.z = cvt_pk_bf16(a2[4], a2[5]); wv.w = cvt_pk_bf16(a2[6], a2[7]);
                *(v4u*)(A2 + row * 1024 + col) = wv;
                v4u xw; xw.x = cvt_pk_bf16(x8[0], x8[1]); xw.y = cvt_pk_bf16(x8[2], x8[3]); xw.z = cvt_pk_bf16(x8[4], x8[5]); xw.w = cvt_pk_bf16(x8[6], x8[7]);
                *(v4u*)(x1 + row * 1024 + col) = xw; }
            ss += __shfl_xor(ss, 16); ss += __shfl_xor(ss, 32);
            if (fq == 0) SSQ2[row * 16 + u.pn * 4 + wc] = ss;
            asm volatile("" ::: "memory"); }
#undef EPO_LOAD
    }
};
struct EpiUp {
    static constexpr int NSTORE = 16; static constexpr bool PERM = true, MID = false; int tmid; unsigned long long* tsp;
    const LAS float* lrs; const LAS float* lbias; bf16* H;
    __device__ __forceinline__ void mid(f32x4 (&)[2][2][4][2], const Unit&, int, int, int, int) const {}
    __device__ __forceinline__ void operator()(const f32x4 (&acc)[2][2][4][2], const Unit& u, int wr, int wc, int fr, int fq) const {
        const int r0 = wr * 64 + fr, col0 = u.pn * 256 + wc * 32 + 8 * fq;
        const LAS float* rs = lrs + u.idx * 256; const LAS float* bs = lbias + u.idx * 256 + wc * 32 + 8 * fq;
        f32x4 bv[2][2];
#pragma unroll
        for (int bj = 0; bj < 2; ++bj)
#pragma unroll
            for (int n = 0; n < 2; ++n) bv[bj][n] = *(const LAS f32x4*)(bs + bj * 128 + 4 * n);
#pragma unroll
        for (int ai = 0; ai < 2; ++ai)
#pragma unroll
            for (int m = 0; m < 4; ++m) { const int rl = r0 + ai * 128 + m * 16;
                const float rstd = rs[rl];
#pragma unroll
                for (int bj = 0; bj < 2; ++bj) { f32x4 v0 = acc[ai][bj][m][0] * rstd + bv[bj][0], v1 = acc[ai][bj][m][1] * rstd + bv[bj][1];
                    float h[8] = {v0[0], v0[1], v0[2], v0[3], v1[0], v1[1], v1[2], v1[3]};
#pragma unroll
                    for (int e = 0; e < 8; ++e) { const float r = fminf(fmaxf(h[e], 0.f), H_RMAX); h[e] = r * r; }
                    const int c_ = col0 + bj * 128;
                    *(v2u*)((unsigned char*)H + (size_t)u.pm * (256 * DFF) + (size_t)(c_ >> 7) * (256 * 128) + (size_t)rl * 128 + (c_ & 127)) = pack_fp8x8(h); } }
    }
};
template <class Sched>
__device__ __forceinline__ void up_tables(const Sched& S, const float* SSQ2, const float* BIAS2, LAS float* lrs, LAS float* lbias) {
    const int t = threadIdx.x;
#pragma unroll 1
    for (int i = 0; i < 8; ++i) { Unit u; if (!S.next(i, u)) break;
        if (t < 256) { const float* p = SSQ2 + ((size_t)u.pm * 256 + t) * 16; const f32x4 a = *(const f32x4*)p, b = *(const f32x4*)(p + 4), c = *(const f32x4*)(p + 8), d = *(const f32x4*)(p + 12);
            const float s = (((a.x + a.y) + (a.z + a.w)) + ((b.x + b.y) + (b.z + b.w))) + (((c.x + c.y) + (c.z + c.w)) + ((d.x + d.y) + (d.z + d.w)));
            lrs[i * 256 + t] = H_ROOT * __builtin_amdgcn_rsqf(s * (1.f / 1024.f) + EPS); }
        else lbias[i * 256 + (t - 256)] = H_ROOT * BIAS2[(size_t)(u.pm >> 3) * DFF + u.pn * 256 + (t - 256)]; }
    __syncthreads();
}
struct EpiDown {
    static constexpr int NSTORE = 0; static constexpr bool PERM = false, MID = false; int tmid; unsigned long long* tsp;
    float* out; const bf16* X1; const float* MOD; float pscale;
    __device__ __forceinline__ void mid(f32x4 (&)[2][2][4][2], const Unit&, int, int, int, int) const {}
    __device__ __forceinline__ void operator()(const f32x4 (&acc)[2][2][4][2], const Unit& u, int wr, int wc, int fr, int fq) const {
        const int b = u.pm >> 3; const float* g2 = MOD + (size_t)b * 6144 + 5120;
        const int row0 = u.pm * 256 + wr * 64 + fr, col0 = u.pn * 256 + wc * 32 + 4 * fq;
        f32x4 gv[2][2];
#pragma unroll
        for (int bj = 0; bj < 2; ++bj)
#pragma unroll
            for (int n = 0; n < 2; ++n) gv[bj][n] = *(const f32x4*)(g2 + col0 + bj * 128 + n * 16) * (1.0f / (W2_SCALE * H_SCALE));
#pragma unroll
        for (int ai = 0; ai < 2; ++ai)
#pragma unroll
            for (int m = 0; m < 4; ++m) { float* rowp = out + (size_t)(row0 + ai * 128 + m * 16) * 1024 + col0; const bf16* xrow = X1 + (size_t)(row0 + ai * 128 + m * 16) * 1024 + col0;
#pragma unroll
                for (int bj = 0; bj < 2; ++bj)
#pragma unroll
                    for (int n = 0; n < 2; ++n) { const v2u xb = *(const v2u*)(xrow + bj * 128 + n * 16); const f32x4 x1 = {bflo(xb.x), bfhi(xb.x), bflo(xb.y), bfhi(xb.y)};
#if defined(TS_PROBE) || defined(TS_GEMM)
                        *(f32x4*)(rowp + bj * 128 + n * 16) = (x1 + gv[bj][n] * acc[ai][bj][m][n]) * pscale;
#else
                        *(f32x4*)(rowp + bj * 128 + n * 16) = x1 + gv[bj][n] * acc[ai][bj][m][n];
#endif
                    } }
    }
};

__device__ __forceinline__ float gelu_tanh(float v) {
    const float a2 = (2.0f * 0.7978845608028654f) * (v + 0.044715f * v * v * v);
    return v * __builtin_amdgcn_rcpf(1.0f + __expf(-a2));
}
__device__ __forceinline__ void bias2_wg(Frame& F, int cg) {
    LAS float* sh2 = (LAS float*)(F.lds);
    LAS float* red = (LAS float*)(F.lds + 16 * 1028 * 4);
    __syncthreads();
#pragma unroll 1
    for (int e0 = 0; e0 < 16 * 1024; e0 += 8 * NWAVES * 64) { float t_[8];
#pragma unroll
        for (int q = 0; q < 8; ++q) { const int e = e0 + q * NWAVES * 64 + F.tid; t_[q] = F.MOD[(size_t)(e >> 10) * 6144 + 3072 + (e & 1023)]; }
#pragma unroll
        for (int q = 0; q < 8; ++q) { const int e = e0 + q * NWAVES * 64 + F.tid; sh2[(e >> 10) * 1028 + (e & 1023)] = t_[q]; } }
    __syncthreads();
    const int n = cg * 16 + (F.lane & 15), kk = F.lane >> 4, k0 = F.wave * 128 + kk * 32;
    float acc[16];
#pragma unroll
    for (int bq = 0; bq < 16; ++bq) acc[bq] = 0.f;
    const float* wp0 = F.w_ff1 + (size_t)k0 * DFF + n;
    float wc_[8], wn_[8];
#pragma unroll
    for (int i = 0; i < 8; ++i) wc_[i] = wp0[(size_t)i * DFF];
#pragma unroll 1
    for (int i8 = 0; i8 < 4; ++i8) {
        const float* wp = wp0 + (size_t)(8 * ((i8 + 1) & 3)) * DFF;
#pragma unroll
        for (int i = 0; i < 8; ++i) wn_[i] = wp[(size_t)i * DFF];
#pragma unroll
        for (int h4 = 0; h4 < 2; ++h4) {
#pragma unroll
            for (int bq = 0; bq < 16; ++bq) { const f32x4 sv = *(const LAS f32x4*)(sh2 + bq * 1028 + k0 + 8 * i8 + 4 * h4); acc[bq] += sv.x * wc_[4 * h4] + sv.y * wc_[4 * h4 + 1] + sv.z * wc_[4 * h4 + 2] + sv.w * wc_[4 * h4 + 3]; }
            asm volatile("" ::: "memory"); }
#pragma unroll
        for (int i = 0; i < 8; ++i) wc_[i] = wn_[i];
    }
#pragma unroll
    for (int bq = 0; bq < 16; ++bq) { float a = acc[bq]; a += __shfl_xor(a, 16); a += __shfl_xor(a, 32); if (kk == 0) red[(F.wave * 16 + bq) * 16 + (F.lane & 15)] = a; }
    __syncthreads();
    if (F.tid < 256) { const int bq = F.tid >> 4, c = F.tid & 15; float sum = 0.f;
#pragma unroll
        for (int v = 0; v < 8; ++v) sum += red[(v * 16 + bq) * 16 + c];
        F.BIAS2[(size_t)bq * DFF + cg * 16 + c] = sum; }
    __syncthreads();
}
typedef short bf16x8s __attribute__((ext_vector_type(8)));
__device__ __forceinline__ void ssm_unit(Frame& F, int g, int bp) {
    const int lane = F.lane, w = F.wave, n = lane & 15, rq = lane >> 4, tid = F.tid;
    LAS unsigned char* L = F.lds;
    __syncthreads();
    { const char* src = (const char*)(F.SSMF + (size_t)g * 144 * 512) + (size_t)tid * 16;
#pragma unroll
      for (int q = 0; q < 18; ++q) __builtin_amdgcn_global_load_lds((const unsigned*)(src + (size_t)q * 8192), (LAS unsigned*)(L + q * 8192 + w * 1024), 16, 0, 0); }
    LAS f32x2* LL = (LAS f32x2*)(F.lds + LDSCTL_OFF + 1024);
    if (tid < 64) { f32x2 q = F.LAMB[g * 64 + tid]; q = cmul(q, q); q = cmul(q, q); q = cmul(q, q); q = cmul(q, q); LL[tid] = q; q = cmul(q, q); q = cmul(q, q); q = cmul(q, q); q = cmul(q, q); LL[64 + tid] = q; }
    float dsk[4];
#pragma unroll
    for (int r = 0; r < 4; ++r) dsk[r] = F.d_skip[g * 16 + 4 * rq + r];
    asm volatile("s_waitcnt vmcnt(0)" ::: "memory");
    __syncthreads();
#define SSM_A(blk) (*(const LAS bf16x8s*)(L + (blk) * 1024 + lane * 16))
#define SSM_A16(gg, i, r) (LL[((gg) - g) + 16 * (i) + 4 * rq + (r)])
#pragma unroll 1
    for (int bb = 0; bb < 2; ++bb) {
        const int b = 2 * bp + bb;
        int gop = g; asm volatile("" : "+s"(gop));
        LAS float* XCH = (LAS float*)(F.lds + XCH_OFF) + bb * 1024;
        const size_t tok0 = (size_t)b * SEQ + (size_t)(16 * w + n) * 16;
        float Sre[4][4], Sim[4][4];
        { bf16x8s Uf1[8];
#pragma unroll
          for (int kb = 0; kb < 8; ++kb) Uf1[kb] = *(const bf16x8s*)(F.U + (tok0 + 2 * kb + (rq >> 1)) * 512 + gop * 16 + 8 * (rq & 1));
          bf16x8s ef[2][8];
#pragma unroll
          for (int kb = 0; kb < 8; ++kb) ef[0][kb] = SSM_A(16 + kb);
#pragma unroll
          for (int i = 0; i < 8; ++i) { f32x4 d = {0.f, 0.f, 0.f, 0.f};
              if (i + 1 < 8) {
#pragma unroll
                  for (int kb = 0; kb < 8; ++kb) ef[(i + 1) & 1][kb] = SSM_A(16 + (i + 1) * 8 + kb); }
              __builtin_amdgcn_sched_barrier(0);
#pragma unroll
              for (int kb = 0; kb < 8; ++kb) d = __builtin_amdgcn_mfma_f32_16x16x32_bf16(ef[i & 1][kb], Uf1[kb], d, 0, 0, 0);
#pragma unroll
              for (int r = 0; r < 4; ++r) { if (i < 4) Sre[i][r] = d[r]; else Sim[i - 4][r] = d[r]; }
              __builtin_amdgcn_sched_barrier(0); } }
#pragma unroll
        for (int i = 0; i < 4; ++i)
#pragma unroll
            for (int r = 0; r < 4; ++r) { f32x2 ak = SSM_A16(gop, i, r);
#define SSM_SCAN_STEP(K) do { const float ur = __int_as_float(__builtin_amdgcn_update_dpp(0, __float_as_int(Sre[i][r]), 0x110 + (K), 0xf, 0xf, true)), ui = __int_as_float(__builtin_amdgcn_update_dpp(0, __float_as_int(Sim[i][r]), 0x110 + (K), 0xf, 0xf, true)); \
                    Sre[i][r] += ak.x * ur - ak.y * ui; Sim[i][r] += ak.x * ui + ak.y * ur; ak = cmul(ak, ak); } while (0)
                SSM_SCAN_STEP(1); SSM_SCAN_STEP(2); SSM_SCAN_STEP(4); SSM_SCAN_STEP(8);
#undef SSM_SCAN_STEP
            }
        if (n == 15) {
#pragma unroll
            for (int i = 0; i < 4; ++i)
#pragma unroll
                for (int r = 0; r < 4; ++r) { const int p = 16 * i + 4 * rq + r; XCH[w * 128 + p] = Sre[i][r]; XCH[w * 128 + 64 + p] = Sim[i][r]; } }
        __syncthreads();
        int gop2 = gop; asm volatile("" : "+s"(gop2));
        bf16x8s Xfr[4];
        { float Cre[4][4], Cim[4][4]; f32x2 aw[4][4];
#pragma unroll
          for (int i = 0; i < 4; ++i)
#pragma unroll
              for (int r = 0; r < 4; ++r) { Cre[i][r] = 0.f; Cim[i][r] = 0.f; aw[i][r] = LL[64 + (gop2 - g) + 16 * i + 4 * rq + r]; }
#pragma unroll 1
          for (int v = 0; v < w; ++v) {
#pragma unroll
              for (int i = 0; i < 4; ++i)
#pragma unroll
                  for (int r = 0; r < 4; ++r) { const int p = 16 * i + 4 * rq + r; const float tr = XCH[v * 128 + p], ti = XCH[v * 128 + 64 + p];
                      const float nr = aw[i][r].x * Cre[i][r] - aw[i][r].y * Cim[i][r] + tr, ni = aw[i][r].x * Cim[i][r] + aw[i][r].y * Cre[i][r] + ti; Cre[i][r] = nr; Cim[i][r] = ni; } }
          int gop3 = gop2; asm volatile("" : "+s"(gop3));
#pragma unroll
          for (int i = 0; i < 4; ++i)
#pragma unroll
              for (int r = 0; r < 4; ++r) { const f32x2 pn = cpow<4>(SSM_A16(gop3, i, r), n);
                  const float ur = __int_as_float(__builtin_amdgcn_update_dpp(0, __float_as_int(Sre[i][r]), 0x111, 0xf, 0xf, true)), ui = __int_as_float(__builtin_amdgcn_update_dpp(0, __float_as_int(Sim[i][r]), 0x111, 0xf, 0xf, true));
                  Sre[i][r] = ur + pn.x * Cre[i][r] - pn.y * Cim[i][r]; Sim[i][r] = ui + pn.x * Cim[i][r] + pn.y * Cre[i][r]; }
          v4u t_;
          t_.x = cvtpk(Sre[0][0], Sre[0][1]); t_.y = cvtpk(Sre[0][2], Sre[0][3]); t_.z = cvtpk(Sre[1][0], Sre[1][1]); t_.w = cvtpk(Sre[1][2], Sre[1][3]); Xfr[0] = __builtin_bit_cast(bf16x8s, t_);
          t_.x = cvtpk(Sre[2][0], Sre[2][1]); t_.y = cvtpk(Sre[2][2], Sre[2][3]); t_.z = cvtpk(Sre[3][0], Sre[3][1]); t_.w = cvtpk(Sre[3][2], Sre[3][3]); Xfr[1] = __builtin_bit_cast(bf16x8s, t_);
          t_.x = cvtpk(Sim[0][0], Sim[0][1]); t_.y = cvtpk(Sim[0][2], Sim[0][3]); t_.z = cvtpk(Sim[1][0], Sim[1][1]); t_.w = cvtpk(Sim[1][2], Sim[1][3]); Xfr[2] = __builtin_bit_cast(bf16x8s, t_);
          t_.x = cvtpk(Sim[2][0], Sim[2][1]); t_.y = cvtpk(Sim[2][2], Sim[2][3]); t_.z = cvtpk(Sim[3][0], Sim[3][1]); t_.w = cvtpk(Sim[3][2], Sim[3][3]); Xfr[3] = __builtin_bit_cast(bf16x8s, t_); }
        int gop4 = gop2; asm volatile("" : "+s"(gop4) : "v"(Xfr[0]), "v"(Xfr[1]), "v"(Xfr[2]), "v"(Xfr[3]) : "memory");
        bf16x8s Ufr[8];
#pragma unroll
        for (int kb = 0; kb < 8; ++kb) Ufr[kb] = *(const bf16x8s*)(F.U + (tok0 + 2 * kb + (rq >> 1)) * 512 + gop4 * 16 + 8 * (rq & 1));
        v2u uq[16];
#pragma unroll
        for (int t = 0; t < 16; ++t) uq[t] = *(const v2u*)(F.U + (tok0 + t) * 512 + gop4 * 16 + 4 * rq);
#define SSM_AF(T) do { _Pragma("unroll") for (int kb = 0; kb <= (T) / 2; ++kb) af[kb] = SSM_A((T) - 2 * kb); \
            _Pragma("unroll") for (int ks = 0; ks < 4; ++ks) af[(T) / 2 + 1 + ks] = SSM_A(80 + (T) * 4 + ks); } while (0)
#pragma unroll
        for (int t = 0; t < 16; ++t) { f32x4 y = {0.f, 0.f, 0.f, 0.f};
            bf16x8s af[12];
            SSM_AF(t);
            __builtin_amdgcn_sched_barrier(0);
#pragma unroll
            for (int kb = 0; kb <= t / 2; ++kb) y = __builtin_amdgcn_mfma_f32_16x16x32_bf16(af[kb], Ufr[kb], y, 0, 0, 0);
#pragma unroll
            for (int ks = 0; ks < 4; ++ks) y = __builtin_amdgcn_mfma_f32_16x16x32_bf16(af[t / 2 + 1 + ks], Xfr[ks], y, 0, 0, 0);
            const size_t off = (tok0 + t) * 512 + g * 16 + 4 * rq;
            const v2u uu = uq[t];
            const float uf[4] = {bflo(uu.x), bfhi(uu.x), bflo(uu.y), bfhi(uu.y)};
            float z[4];
#pragma unroll
            for (int r = 0; r < 4; ++r) z[r] = gelu_tanh(y[r] + dsk[r] * uf[r]);
            *(v2u*)(F.Z + off) = (v2u){cvtpk(z[0], z[1]), cvtpk(z[2], z[3])};
            asm volatile("" ::: "memory"); }
    }
#undef SSM_AF
#undef SSM_A
#undef SSM_A16
}

__device__ __forceinline__ unsigned fkey(float f) { const unsigned u = __float_as_uint(f); return (u & 0x80000000u) ? ~u : (u | 0x80000000u); }

typedef short bf16x8 __attribute__((ext_vector_type(8)));
typedef float f32x16 __attribute__((ext_vector_type(16)));
__device__ __forceinline__ int crow(int r, int hi) { return (r & 3) + 8 * (r >> 2) + 4 * hi; }

extern "C" __device__ int wl_i32(int src, int lane, int old) __asm("llvm.amdgcn.writelane");
#define DPP_I(x, ctrl) __builtin_amdgcn_update_dpp(0, (x), (ctrl), 0xf, 0xf, false)
__device__ __forceinline__ unsigned wave_umax(unsigned v) {
    v = max(v, (unsigned)DPP_I((int)v, 0xB1)); v = max(v, (unsigned)DPP_I((int)v, 0x4E)); v = max(v, (unsigned)DPP_I((int)v, 0x141)); v = max(v, (unsigned)DPP_I((int)v, 0x140));
    const unsigned a = __builtin_amdgcn_readlane((int)v, 0), b = __builtin_amdgcn_readlane((int)v, 16), c = __builtin_amdgcn_readlane((int)v, 32), d = __builtin_amdgcn_readlane((int)v, 48);
    return max(max(a, b), max(c, d));
}
__device__ __forceinline__ unsigned wave_umin(unsigned v) {
    v = min(v, (unsigned)DPP_I((int)v, 0xB1)); v = min(v, (unsigned)DPP_I((int)v, 0x4E)); v = min(v, (unsigned)DPP_I((int)v, 0x141)); v = min(v, (unsigned)DPP_I((int)v, 0x140));
    const unsigned a = __builtin_amdgcn_readlane((int)v, 0), b = __builtin_amdgcn_readlane((int)v, 16), c = __builtin_amdgcn_readlane((int)v, 32), d = __builtin_amdgcn_readlane((int)v, 48);
    return min(min(a, b), min(c, d));
}
#define DPP_F(x, ctrl) __int_as_float(__builtin_amdgcn_update_dpp(0, __float_as_int(x), (ctrl), 0xf, 0xf, false))
__device__ __forceinline__ float wave_fmax(float v) {
    v = fmaxf(v, DPP_F(v, 0xB1)); v = fmaxf(v, DPP_F(v, 0x4E)); v = fmaxf(v, DPP_F(v, 0x141)); v = fmaxf(v, DPP_F(v, 0x140));
    const float a = __int_as_float(__builtin_amdgcn_readlane(__float_as_int(v), 0)), b = __int_as_float(__builtin_amdgcn_readlane(__float_as_int(v), 16)), c = __int_as_float(__builtin_amdgcn_readlane(__float_as_int(v), 32)), d = __int_as_float(__builtin_amdgcn_readlane(__float_as_int(v), 48));
    return fmaxf(fmaxf(a, b), fmaxf(c, d));
}
__device__ __forceinline__ float wave_fmin(float v) {
    v = fminf(v, DPP_F(v, 0xB1)); v = fminf(v, DPP_F(v, 0x4E)); v = fminf(v, DPP_F(v, 0x141)); v = fminf(v, DPP_F(v, 0x140));
    const float a = __int_as_float(__builtin_amdgcn_readlane(__float_as_int(v), 0)), b = __int_as_float(__builtin_amdgcn_readlane(__float_as_int(v), 16)), c = __int_as_float(__builtin_amdgcn_readlane(__float_as_int(v), 32)), d = __int_as_float(__builtin_amdgcn_readlane(__float_as_int(v), 48));
    return fminf(fminf(a, b), fminf(c, d));
}
__device__ __forceinline__ float fkey_inv(unsigned k) { return __uint_as_float((k & 0x80000000u) ? (k & 0x7fffffffu) : ~k); }
template <int NJ>
__device__ __forceinline__ void select_query_t(const LAS float* SCq, int t, int nvalid, LAS unsigned long long* BMq, LAS unsigned* H, int lane) {
    constexpr int NF = NJ > 5 ? NJ - 5 : 0;
    float v[NJ];
#pragma unroll
    for (int j = 0; j < NJ; ++j) v[j] = (j < NF) ? SCq[64 * j + lane] : ((64 * j + lane < nvalid) ? SCq[64 * j + lane] : -INFINITY);
    const int n = t + 1;
    if (n <= TOPK) {
        const int d = t - 64 * lane;
        const unsigned long long sm = (d >= 63) ? ~0ull : (d < 0) ? 0ull : ((2ull << d) - 1ull);
        if (lane < NJ) BMq[lane] = sm;
        LDS_WAIT(); asm volatile("" ::: "memory");
        return;
    }
    float hi, lo;
    { float h = -INFINITY, l = INFINITY;
#pragma unroll
      for (int j = 0; j < NJ; ++j) { h = fmaxf(h, v[j]); l = fminf(l, (j < NF || v[j] != -INFINITY) ? v[j] : INFINITY); }
      hi = wave_fmax(h); lo = wave_fmin(l); }
    const float scale = (hi > lo) ? 254.9999f * __builtin_amdgcn_rcpf(hi - lo) : 0.f;
    *(LAS v4u*)(H + 4 * lane) = (v4u){0u, 0u, 0u, 0u};
    LDS_WAIT(); asm volatile("" ::: "memory");
    unsigned pk[NJ / 4];
#pragma unroll
    for (int j = 0; j < NJ; ++j) { const bool ok = (j < NF) || (v[j] != -INFINITY);
        const int bin = ok ? (int)((v[j] - lo) * scale) : 0;
        if (ok) __hip_atomic_fetch_add(H + bin, 1u, __ATOMIC_RELAXED, __HIP_MEMORY_SCOPE_WORKGROUP);
        if ((j & 3) == 0) pk[j >> 2] = (unsigned)bin; else pk[j >> 2] |= (unsigned)bin << (8 * (j & 3)); }
    LDS_WAIT(); asm volatile("" ::: "memory");
    const v4u c = *(const LAS v4u*)(H + 4 * lane);
    const int lsum = (int)(c.x + c.y + c.z + c.w);
    int x = lsum;
    x += __builtin_amdgcn_update_dpp(0, x, 0x101, 0xf, 0xf, true); x += __builtin_amdgcn_update_dpp(0, x, 0x102, 0xf, 0xf, true);
    x += __builtin_amdgcn_update_dpp(0, x, 0x104, 0xf, 0xf, true); x += __builtin_amdgcn_update_dpp(0, x, 0x108, 0xf, 0xf, true);
    { const int r1 = __builtin_amdgcn_readlane(x, 16), r2 = __builtin_amdgcn_readlane(x, 32), r3 = __builtin_amdgcn_readlane(x, 48); const int row = lane >> 4;
      x += (row == 0) ? (r1 + r2 + r3) : (row == 1) ? (r2 + r3) : (row == 2) ? r3 : 0; }
    int run = x - lsum, B = -1, ca = 0, mB = 0;
    { const int ck[4] = {(int)c.x, (int)c.y, (int)c.z, (int)c.w};
#pragma unroll
      for (int k = 3; k >= 0; --k) { if (B < 0 && run < TOPK && run + ck[k] >= TOPK) { B = 4 * lane + k; ca = run; mB = ck[k]; } run += ck[k]; } }
    { const unsigned long long fm = __ballot(B >= 0); const int src = __ffsll((long long)fm) - 1; B = __builtin_amdgcn_readlane(B, src); ca = __builtin_amdgcn_readlane(ca, src); mB = __builtin_amdgcn_readlane(mB, src); }
    const int need = TOPK - ca;
    float tv; int ts;
    if (mB <= 64) {
        const unsigned long long lt = (1ull << lane) - 1ull; int base = 0;
#pragma unroll
        for (int j = 0; j < NJ; ++j) { const bool inb = ((j < NF) || (v[j] != -INFINITY)) && (int)((pk[j >> 2] >> (8 * (j & 3))) & 255u) == B; const unsigned long long bm = __ballot(inb);
            if (bm != 0ull) { if (inb) { const int pos = base + __popcll(bm & lt); H[2 * pos] = __float_as_uint(v[j]); H[2 * pos + 1] = (unsigned)(64 * j + lane); } base += __popcll(bm); } }
        LDS_WAIT(); asm volatile("" ::: "memory");
        float cv = -INFINITY; int cs = 0x7fffffff;
        if (lane < mB) { const v2u e = *(const LAS v2u*)(H + 2 * lane); cv = __uint_as_float(e.x); cs = (int)e.y; }
        int rank = 0;
        for (int k = 0; k < mB; ++k) { const float ov = __uint_as_float(__builtin_amdgcn_readlane(__float_as_uint(cv), k)); const int os = __builtin_amdgcn_readlane(cs, k); rank += (ov > cv || (ov == cv && os < cs)) ? 1 : 0; }
        const unsigned long long fm = __ballot(lane < mB && rank == need - 1); const int src = __ffsll((long long)fm) - 1;
        tv = __uint_as_float(__builtin_amdgcn_readlane(__float_as_uint(cv), src)); ts = __builtin_amdgcn_readlane(cs, src);
    } else {
        unsigned tau = 0u;
#pragma unroll 1
        for (int bit = 31; bit >= 0; --bit) { const unsigned cand = tau | (1u << bit); int cnt = 0;
#pragma unroll
            for (int j = 0; j < NJ; ++j) { cnt += __popcll(__ballot(fkey(v[j]) >= cand)); asm volatile("" : "+s"(cnt)); }
            if (cnt >= TOPK) tau = cand; }
        int cg = 0;
#pragma unroll
        for (int j = 0; j < NJ; ++j) { cg += __popcll(__ballot(fkey(v[j]) > tau)); asm volatile("" : "+s"(cg)); }
        const int need2 = TOPK - cg; const unsigned long long lt = (1ull << lane) - 1ull;
        tv = fkey_inv(tau); ts = -1; int eqb = 0;
#pragma unroll
        for (int j = 0; j < NJ; ++j) { const bool eq = fkey(v[j]) == tau; const unsigned long long em = __ballot(eq);
            const unsigned long long hit = __ballot(eq && (eqb + __popcll(em & lt) + 1 == need2));
            if (hit != 0ull && ts < 0) ts = 64 * j + (__ffsll((long long)hit) - 1);
            eqb += __popcll(em); asm volatile("" : "+s"(eqb)); }
    }
    int mlo = 0, mhi = 0, cgt = 0;
#pragma unroll
    for (int j = 0; j < NJ; ++j) { const unsigned long long sm = __ballot(v[j] > tv); cgt += __popcll(sm); mlo = wl_i32((int)(unsigned)sm, j, mlo); mhi = wl_i32((int)(unsigned)(sm >> 32), j, mhi); }
    if (cgt == TOPK - 1) {
        if (lane == (ts >> 6)) { const int bit = 1 << (ts & 31); if (ts & 32) mhi |= bit; else mlo |= bit; }
    } else {
#pragma unroll
        for (int j = 0; j < NJ; ++j) { const int s_ = 64 * j + lane; const unsigned long long sm = __ballot(v[j] > tv || (v[j] == tv && s_ <= ts)); mlo = wl_i32((int)(unsigned)sm, j, mlo); mhi = wl_i32((int)(unsigned)(sm >> 32), j, mhi); }
    }
    if (lane < NJ) BMq[lane] = ((unsigned long long)(unsigned)mhi << 32) | (unsigned long long)(unsigned)mlo;
    LDS_WAIT(); asm volatile("" ::: "memory");
}

__device__ __forceinline__ void select_query(const LAS float* SCq, int t, int nvalid, LAS unsigned long long* BMq, LAS unsigned* H, int lane) {
    const int nj = __builtin_amdgcn_readfirstlane((nvalid + 63) >> 6);
    if (nj <= 16) { if (nj <= 8) { if (nj <= 4) select_query_t<4>(SCq, t, nvalid, BMq, H, lane); else select_query_t<8>(SCq, t, nvalid, BMq, H, lane); }
                    else { if (nj <= 12) select_query_t<12>(SCq, t, nvalid, BMq, H, lane); else select_query_t<16>(SCq, t, nvalid, BMq, H, lane); } }
    else { if (nj <= 24) { if (nj <= 20) select_query_t<20>(SCq, t, nvalid, BMq, H, lane); else select_query_t<24>(SCq, t, nvalid, BMq, H, lane); }
           else { if (nj <= 28) select_query_t<28>(SCq, t, nvalid, BMq, H, lane); else select_query_t<32>(SCq, t, nvalid, BMq, H, lane); } }
}

constexpr int KBUF_BYTES = 32768;
typedef _Float16 h16x8 __attribute__((ext_vector_type(8)));
__device__ __forceinline__ void idx_subunit(Frame& F, int b, int t0, int qoff) {
    TS_T0();
    int lane_ = F.lane; asm volatile("" : "+v"(lane_));
    const int lane = lane_, w = F.wave, rt = w & 3, kq = w >> 2, r32 = lane & 31, hh = lane >> 5;
    LAS float* SC = (LAS float*)(F.lds);
    LAS unsigned long long* BM = (LAS unsigned long long*)(F.lds + BM_OFF);
    LAS unsigned* HW = (LAS unsigned*)(F.lds + XCH_OFF) + w * 256;
    const int nk = t0 + 16, nkt = (nk + 31) >> 5, nstep = (nkt + 7) >> 3;
    const int qrow = 2 * ((r32 >> 2) & 1) + (r32 >> 4), qhead = 4 * ((r32 >> 3) & 1) + (r32 & 3);
    const bf16* qp = F.QI2 + (size_t)(b * SEQ + t0 + 4 * rt + qrow) * 512 + qhead * 64 + 8 * hh;
    h16x8 qf[4];
#pragma unroll
    for (int d0 = 0; d0 < 4; ++d0) qf[d0] = *(const h16x8*)(qp + 16 * d0);
    f32x4 wq[4];
#pragma unroll
    for (int tq = 0; tq < 4; ++tq) wq[tq] = *(const f32x4*)(F.WI + (size_t)(b * SEQ + t0 + 4 * rt + 2 * hh + (tq >> 1)) * 8 + 4 * (tq & 1));
    const int S0 = w * 64 + lane, skey = (S0 & 255) >> 3;
    const char* ksrc = (const char*)(F.KI2 + (size_t)b * SEQ * 64) + (w >> 2) * 4096 + skey * 128 + (((S0 & 7) ^ (skey & 7)) * 16);
#define IDX_DMA(step) do { _Pragma("unroll") for (int i_ = 0; i_ < 4; ++i_) { const int tl_ = min(8 * (step) + 2 * i_ + (w >> 2), nkt - 1) - (w >> 2);     \
        __builtin_amdgcn_global_load_lds((const unsigned*)(ksrc + (size_t)tl_ * 4096), (LAS unsigned*)(F.lds + ((step) & 3) * KBUF_BYTES + i_ * 8192 + w * 1024), 16, 0, 0); } } while (0)
    __syncthreads();
    asm volatile("" : "+v"(qf[0]), "+v"(qf[1]), "+v"(qf[2]), "+v"(qf[3]));
    asm volatile("" : "+v"(wq[0]), "+v"(wq[1]), "+v"(wq[2]), "+v"(wq[3]));
    IDX_DMA(0);
    if (1 < nstep) IDX_DMA(1);
    if (2 < nstep) IDX_DMA(2);
    TS_ACC(1);
    float scr[8][4][2];
    { TS_T0();
#pragma unroll
    for (int s_ = 0; s_ < 8; ++s_) {
        if (s_ < nstep) {
            if (s_ + 2 < nstep) asm volatile("s_waitcnt vmcnt(8)" ::: "memory"); else if (s_ + 1 < nstep) asm volatile("s_waitcnt vmcnt(4)" ::: "memory"); else asm volatile("s_waitcnt vmcnt(0)" ::: "memory");
            __builtin_amdgcn_s_barrier();
            asm volatile("" ::: "memory");
            if (s_ + 3 < nstep) IDX_DMA(s_ + 3);
            const LAS unsigned char* kb = F.lds + (s_ & 3) * KBUF_BYTES;
            const int tq0 = t0 + 4 * rt + 2 * hh;
#pragma unroll
            for (int pr = 0; pr < 2; ++pr) {
                const int tiA = 4 * pr + kq, tiB = 4 * pr + 2 + kq;
                const LAS unsigned char* krA = kb + tiA * 4096 + r32 * 128; const LAS unsigned char* krB = kb + tiB * 4096 + r32 * 128;
                const int sw = r32 & 7;
                f32x16 accA, accB;
#pragma unroll
                for (int r = 0; r < 16; ++r) { accA[r] = 0.f; accB[r] = 0.f; }
                __builtin_amdgcn_s_setprio(1);
#pragma unroll
                for (int d0 = 0; d0 < 4; ++d0) {
                    const h16x8 kA = *(const LAS h16x8*)(krA + (((2 * d0 + hh) ^ sw) * 16)), kB = *(const LAS h16x8*)(krB + (((2 * d0 + hh) ^ sw) * 16));
                    accA = __builtin_amdgcn_mfma_f32_32x32x16_f16(qf[d0], kA, accA, 0, 0, 0);
                    accB = __builtin_amdgcn_mfma_f32_32x32x16_f16(qf[d0], kB, accB, 0, 0, 0);
                }
                __builtin_amdgcn_s_setprio(0);
#define IDX_EPI(ACC, TI, I4) do { const int key_ = 32 * (8 * s_ + (TI)) + r32; float a_[2]; \
                    _Pragma("unroll") for (int e = 0; e < 2; ++e) { float p_ = 0.f; \
                        _Pragma("unroll") for (int m = 0; m < 8; ++m) { const float r_ = __int_as_float(max(__float_as_int(ACC[8 * e + m]), 0)); \
                            asm("v_fmac_f32 %0, %1, %2" : "+v"(p_) : "v"(r_), "v"(wq[2 * e + (m >> 2)][m & 3])); }     \
                        a_[e] = p_; } \
                    scr[s_][I4][0] = (key_ <= tq0) ? (a_[0] * IDX_SCALE + 0.0f) : -INFINITY; scr[s_][I4][1] = (key_ <= tq0 + 1) ? (a_[1] * IDX_SCALE + 0.0f) : -INFINITY; } while (0)
                IDX_EPI(accA, tiA, 2 * pr); IDX_EPI(accB, tiB, 2 * pr + 1);
#undef IDX_EPI
            }
        }
    }
#undef IDX_DMA
    TS_ACC(2); }
    { TS_T0();
    if (F.tid == 0) *(LAS unsigned*)(F.lds + MISC_OFF + 96) = 0u;
    __syncthreads();
#pragma unroll
    for (int s_ = 0; s_ < 8; ++s_) {
        if (s_ < nstep) {
#pragma unroll
            for (int i4 = 0; i4 < 4; ++i4) { const int kt = 8 * s_ + 2 * i4 + kq;
                SC[(4 * rt + 2 * hh) * 2048 + 32 * kt + r32] = scr[s_][i4][0]; SC[(4 * rt + 2 * hh + 1) * 2048 + 32 * kt + r32] = scr[s_][i4][1]; } } }
    __syncthreads();
    TS_ACC(3); }
    { TS_T0();
#ifndef DUP_SEL
#define DUP_SEL 1
#endif
#ifndef DUP_FLASH
#define DUP_FLASH 1
#endif
    for (int rep_ = 0; rep_ < DUP_SEL; ++rep_)
#pragma unroll 1
        for (;;) {
            unsigned q_ = 0u; if (lane == 0) q_ = __hip_atomic_fetch_add((LAS unsigned*)(F.lds + MISC_OFF + 96), 1u, __ATOMIC_RELAXED, __HIP_MEMORY_SCOPE_WORKGROUP);
            const int q = __builtin_amdgcn_readfirstlane((int)q_);
            if (q >= 16) break;
            select_query(SC + q * 2048, t0 + q, nkt * 32, BM + (qoff + q) * 32, HW, lane); }
    TS_ACC(4); }
}

typedef short v4i16_t __attribute__((ext_vector_type(4)));
__device__ __forceinline__ v4i16_t vtr(const LAS unsigned char* p) { return __builtin_amdgcn_ds_read_tr16_b64_v4i16((LAS v4i16_t*)p); }
__device__ __forceinline__ void attn_subunit(Frame& F, int b, int kvh, int t0) {
    int lane_ = F.lane; asm volatile("" : "+v"(lane_));
    const int lane = lane_, w = F.wave, r32 = lane & 31, hi = lane >> 5, tid = w * 64 + lane;
    LAS float* wsf = (LAS float*)(F.lds + 32768) + w * 64;
    const LAS unsigned long long* BM = (const LAS unsigned long long*)(F.lds + BM_OFF);
    const int ntile = (t0 + 64) >> 6;
    const int tl = 8 * w + (r32 >> 2), g = r32 & 3;
    constexpr float C2 = 0.125f * 1.4426950408889634f;
    float negS;
    { const float gv = fabsf(F.q_gain[lane] * F.k_gain[lane]); negS = -64.0f * C2 * fkey_inv(wave_umax(fkey(gv))) * 1.0005f; }
    bf16x8 qr[4];
    { const bf16* qp = F.Q + (size_t)(b * SEQ + t0 + tl) * 512 + (4 * kvh + g) * 64 + 8 * hi;
      float qf[32]; float ss = 0.f;
#pragma unroll
      for (int d0 = 0; d0 < 4; ++d0) { const v4u qv = *(const v4u*)(qp + 16 * d0);
          qf[8 * d0 + 0] = bflo(qv.x); qf[8 * d0 + 1] = bfhi(qv.x); qf[8 * d0 + 2] = bflo(qv.y); qf[8 * d0 + 3] = bfhi(qv.y);
          qf[8 * d0 + 4] = bflo(qv.z); qf[8 * d0 + 5] = bfhi(qv.z); qf[8 * d0 + 6] = bflo(qv.w); qf[8 * d0 + 7] = bfhi(qv.w); }
#pragma unroll
      for (int i = 0; i < 32; ++i) ss += qf[i] * qf[i];
      { const auto rr = __builtin_amdgcn_permlane32_swap(__float_as_uint(ss), __float_as_uint(ss), false, false); ss = __uint_as_float(rr[0]) + __uint_as_float(rr[1]); }
      const float rstd = (1.0f / sqrtf(ss * (1.f / 64.f) + EPS)) * C2;
      int dop = 8 * hi; asm volatile("" : "+v"(dop));
#pragma unroll
      for (int d0 = 0; d0 < 4; ++d0) { float v[8];
#pragma unroll
          for (int j = 0; j < 8; ++j) { const int d = 16 * d0 + dop + j; v[j] = qf[8 * d0 + j] * rstd * F.q_gain[d] * F.k_gain[d]; }
          v4u pk; pk.x = cvtpk(v[0], v[1]); pk.y = cvtpk(v[2], v[3]); pk.z = cvtpk(v[4], v[5]); pk.w = cvtpk(v[6], v[7]);
          qr[d0] = __builtin_bit_cast(bf16x8, pk); } }
    const int skey = tid >> 3, sc = tid & 7;
    const bf16* kvp = F.KV + (size_t)(b * SEQ + skey) * 256 + kvh * 64 + 8 * sc;
    const int kwoff = skey * 128 + ((sc ^ (skey & 7)) * 16), vwoff = 8192 + (sc >> 2) * 4096 + skey * 64 + (sc & 3) * 16;
#define ATT_STAGE(bufbase) do { LAS unsigned char* bb_ = F.lds + (bufbase); \
        float kf_[8] = {bflo(kreg.x), bfhi(kreg.x), bflo(kreg.y), bfhi(kreg.y), bflo(kreg.z), bfhi(kreg.z), bflo(kreg.w), bfhi(kreg.w)}; float ss_ = 0.f; \
        _Pragma("unroll") for (int j_ = 0; j_ < 8; ++j_) ss_ += kf_[j_] * kf_[j_]; \
        ss_ += __builtin_bit_cast(float, DPP_I(__builtin_bit_cast(int, ss_), 0xB1)); ss_ += __builtin_bit_cast(float, DPP_I(__builtin_bit_cast(int, ss_), 0x4E)); ss_ += __builtin_bit_cast(float, DPP_I(__builtin_bit_cast(int, ss_), 0x141)); \
        const float rk_ = __builtin_amdgcn_rsqf(ss_ * (1.f / 64.f) + EPS); \
        v4u ko_; ko_.x = cvtpk(kf_[0] * rk_, kf_[1] * rk_); ko_.y = cvtpk(kf_[2] * rk_, kf_[3] * rk_); ko_.z = cvtpk(kf_[4] * rk_, kf_[5] * rk_); ko_.w = cvtpk(kf_[6] * rk_, kf_[7] * rk_); \
        *(LAS v4u*)(bb_ + kwoff) = ko_; *(LAS v4u*)(bb_ + vwoff) = vreg; } while (0)
    float l = 0.f;
    f32x16 o[2];
#pragma unroll
    for (int r = 0; r < 16; ++r) { o[0][r] = 0.f; o[1][r] = 0.f; }
    v4u kreg = *(const v4u*)(kvp), vreg = *(const v4u*)(kvp + 128), kreg2, vreg2;
    __syncthreads();
    ATT_STAGE(0);
    if (ntile > 1) { kreg = *(const v4u*)(kvp + (size_t)64 * 256); vreg = *(const v4u*)(kvp + (size_t)64 * 256 + 128); }
    if (ntile > 2) { kreg2 = *(const v4u*)(kvp + (size_t)128 * 256); vreg2 = *(const v4u*)(kvp + (size_t)128 * 256 + 128); }
    __syncthreads();
    const LAS unsigned char* vp0 = F.lds + 8192 + ((lane >> 4) & 1) * 32 + (lane & 3) * 8 + (4 * hi + ((lane & 15) >> 2)) * 64;
    for (int tile = 0; tile < ntile; ++tile) {
        const int cb_ = (tile & 1) * 16384;
        if (tile + 1 < ntile) { ATT_STAGE(16384 - cb_); kreg = kreg2; vreg = vreg2;
            if (tile + 3 < ntile) { const bf16* np = kvp + (size_t)(tile + 3) * 64 * 256; kreg2 = *(const v4u*)(np); vreg2 = *(const v4u*)(np + 128); } }
        const LAS unsigned char* Kt = F.lds + cb_;
        f32x16 p0, p1;
#pragma unroll
        for (int r = 0; r < 16; ++r) { p0[r] = negS; p1[r] = negS; }
#pragma unroll
        for (int d0 = 0; d0 < 4; ++d0) {
            const bf16x8 a0 = *(const LAS bf16x8*)(Kt + r32 * 128 + (((2 * d0 + hi) ^ (r32 & 7)) * 16));
            const bf16x8 a1 = *(const LAS bf16x8*)(Kt + (32 + r32) * 128 + (((2 * d0 + hi) ^ (r32 & 7)) * 16));
            p0 = __builtin_amdgcn_mfma_f32_32x32x16_bf16(a0, qr[d0], p0, 0, 0, 0);
            p1 = __builtin_amdgcn_mfma_f32_32x32x16_bf16(a1, qr[d0], p1, 0, 0, 0);
        }
        const unsigned long long mw = BM[tl * 32 + tile];
        const int mlo = (int)((unsigned)mw >> (4 * hi)), mhi = (int)((unsigned)(mw >> 32) >> (4 * hi));
        float ps = 0.f;
#define ATT_EXPM(R) do { const float e0_ = __builtin_amdgcn_exp2f(p0[R]), e1_ = __builtin_amdgcn_exp2f(p1[R]); int m0_, m1_; \
            asm("v_bfe_i32 %0, %1, %2, 1" : "=v"(m0_) : "v"(mlo), "n"(8 * ((R) >> 2) + ((R) & 3))); asm("v_bfe_i32 %0, %1, %2, 1" : "=v"(m1_) : "v"(mhi), "n"(8 * ((R) >> 2) + ((R) & 3))); \
            p0[R] = __int_as_float(__float_as_int(e0_) & m0_); p1[R] = __int_as_float(__float_as_int(e1_) & m1_); ps += p0[R] + p1[R]; } while (0)
        ATT_EXPM(0); ATT_EXPM(1); ATT_EXPM(2); ATT_EXPM(3); ATT_EXPM(4); ATT_EXPM(5); ATT_EXPM(6); ATT_EXPM(7);
        ATT_EXPM(8); ATT_EXPM(9); ATT_EXPM(10); ATT_EXPM(11); ATT_EXPM(12); ATT_EXPM(13); ATT_EXPM(14); ATT_EXPM(15);
#undef ATT_EXPM
        l += ps;
        bf16x8 pa[4];
        { v4u t_;
          t_.x = cvtpk(p0[0], p0[1]); t_.y = cvtpk(p0[2], p0[3]); t_.z = cvtpk(p0[4], p0[5]); t_.w = cvtpk(p0[6], p0[7]); pa[0] = __builtin_bit_cast(bf16x8, t_);
          t_.x = cvtpk(p0[8], p0[9]); t_.y = cvtpk(p0[10], p0[11]); t_.z = cvtpk(p0[12], p0[13]); t_.w = cvtpk(p0[14], p0[15]); pa[1] = __builtin_bit_cast(bf16x8, t_);
          t_.x = cvtpk(p1[0], p1[1]); t_.y = cvtpk(p1[2], p1[3]); t_.z = cvtpk(p1[4], p1[5]); t_.w = cvtpk(p1[6], p1[7]); pa[2] = __builtin_bit_cast(bf16x8, t_);
          t_.x = cvtpk(p1[8], p1[9]); t_.y = cvtpk(p1[10], p1[11]); t_.z = cvtpk(p1[12], p1[13]); t_.w = cvtpk(p1[14], p1[15]); pa[3] = __builtin_bit_cast(bf16x8, t_); }
#pragma unroll
        for (int dh = 0; dh < 2; ++dh)
#pragma unroll
            for (int ks = 0; ks < 4; ++ks) { const v4i16_t lo_ = vtr(vp0 + cb_ + dh * 4096 + ks * 1024), hi_ = vtr(vp0 + cb_ + dh * 4096 + ks * 1024 + 512);
                const bf16x8 vb = (bf16x8){lo_[0], lo_[1], lo_[2], lo_[3], hi_[0], hi_[1], hi_[2], hi_[3]};
                o[dh] = __builtin_amdgcn_mfma_f32_32x32x16_bf16(pa[ks], vb, o[dh], 0, 0, 0); }
        __syncthreads();
    }
#undef ATT_STAGE
    { const auto rr = __builtin_amdgcn_permlane32_swap(__float_as_uint(l), __float_as_uint(l), false, false); l = __uint_as_float(rr[0]) + __uint_as_float(rr[1]); }
    if (hi == 0) wsf[r32] = 1.0f / l;
    LDS_WAIT(); asm volatile("" ::: "memory");
    float ssq[4];
#pragma unroll
    for (int q4 = 0; q4 < 4; ++q4) { const f32x4 av = *(const LAS f32x4*)(wsf + 8 * q4 + 4 * hi); float s2 = 0.f;
        const size_t row = (size_t)(b * SEQ + t0 + 8 * w + 2 * q4 + hi);
#pragma unroll
        for (int i = 0; i < 4; ++i) { const float v0 = o[0][4 * q4 + i] * av[i], v1 = o[1][4 * q4 + i] * av[i]; s2 += v0 * v0 + v1 * v1;
            bf16* op = F.MIX + row * 1024 + 512 + (4 * kvh + i) * 64 + r32;
            op[0] = (bf16)f2bf(v0); op[32] = (bf16)f2bf(v1); }
        ssq[q4] = s2; }
#pragma unroll
    for (int q4 = 0; q4 < 4; ++q4) { float s2 = ssq[q4];
        s2 += __shfl_xor(s2, 1); s2 += __shfl_xor(s2, 2); s2 += __shfl_xor(s2, 4); s2 += __shfl_xor(s2, 8); s2 += __shfl_xor(s2, 16);
        if (r32 == 0) F.SSQA[(size_t)(b * SEQ + t0 + 8 * w + 2 * q4 + hi) * 2 + kvh] = s2; }
    LDS_WAIT(); asm volatile("" ::: "memory");
}

__device__ __forceinline__ void attn_unit2(Frame& F, int b, int t0) {
    int lane_ = F.lane; asm volatile("" : "+v"(lane_));
    const int lane = lane_, w = F.wave, r32 = lane & 31, hi = lane >> 5, tid = w * 64 + lane;
    LAS float* wsf = (LAS float*)(F.lds + XCH_OFF) + w * 64;
    LAS unsigned char* qL = F.lds + 65536 + w * 8192 + lane * 16;
    const LAS unsigned long long* BM = (const LAS unsigned long long*)(F.lds + BM_OFF);
    const int ntile = (t0 + 64) >> 6;
    const int tl = 8 * w + (r32 >> 2), g = r32 & 3;
    constexpr float C2 = 0.125f * 1.4426950408889634f;
    float negS;
    { const float gv = fabsf(F.q_gain[lane] * F.k_gain[lane]); negS = -64.0f * C2 * fkey_inv(wave_umax(fkey(gv))) * 1.0005f; }
    __syncthreads();
#define ATT_QPREP(KVH, QR) do { const bf16* qp = F.Q + (size_t)(b * SEQ + t0 + tl) * 512 + (4 * (KVH) + g) * 64 + 8 * hi; \
      float qf[32]; float ss = 0.f; \
      _Pragma("unroll") for (int d0 = 0; d0 < 4; ++d0) { const v4u qv = *(const v4u*)(qp + 16 * d0); \
          qf[8 * d0 + 0] = bflo(qv.x); qf[8 * d0 + 1] = bfhi(qv.x); qf[8 * d0 + 2] = bflo(qv.y); qf[8 * d0 + 3] = bfhi(qv.y); \
          qf[8 * d0 + 4] = bflo(qv.z); qf[8 * d0 + 5] = bfhi(qv.z); qf[8 * d0 + 6] = bflo(qv.w); qf[8 * d0 + 7] = bfhi(qv.w); } \
      _Pragma("unroll") for (int i = 0; i < 32; ++i) ss += qf[i] * qf[i]; \
      { const auto rr = __builtin_amdgcn_permlane32_swap(__float_as_uint(ss), __float_as_uint(ss), false, false); ss = __uint_as_float(rr[0]) + __uint_as_float(rr[1]); } \
      const float rstd = __builtin_amdgcn_rsqf(ss * (1.f / 64.f) + EPS) * C2; \
      int dop = 8 * hi; asm volatile("" : "+v"(dop)); \
      _Pragma("unroll") for (int d0 = 0; d0 < 4; ++d0) { float v[8]; \
          _Pragma("unroll") for (int j = 0; j < 8; ++j) { const int d = 16 * d0 + dop + j; v[j] = qf[8 * d0 + j] * (rstd * 16.0f) * F.q_gain[d] * F.k_gain[d]; }     \
          const v2u p8_ = pack_fp8x8(v); (QR)[2 * d0] = (int)p8_.x; (QR)[2 * d0 + 1] = (int)p8_.y; } } while (0)
    const int skey = tid >> 3, sc = tid & 7;
    const bf16* kvp = F.KV + (size_t)(b * SEQ + skey) * 256 + 8 * sc;
    const int kwoff = skey * 128 + ((sc ^ (skey & 7)) * 16), vwoff = 16384 + (sc >> 2) * 4096 + skey * 64 + (sc & 3) * 16;
    v4u k0r, k1r, v0r, v1r;
    if (N_LAUNCHES != 1) { const bf16* np_ = kvp; k0r = *(const v4u*)(np_); k1r = *(const v4u*)(np_ + 64); v0r = *(const v4u*)(np_ + 128); v1r = *(const v4u*)(np_ + 192); }
    pg8::v8i_t qA8, qB8;
    ATT_QPREP(0, qA8); ATT_QPREP(1, qB8);
#undef ATT_QPREP
#define ATT_KSC(KR) ({ float kf_[8] = {bflo(KR.x), bfhi(KR.x), bflo(KR.y), bfhi(KR.y), bflo(KR.z), bfhi(KR.z), bflo(KR.w), bfhi(KR.w)}; float ss_ = 0.f; \
        _Pragma("unroll") for (int j_ = 0; j_ < 8; ++j_) ss_ += kf_[j_] * kf_[j_]; \
        ss_ += __builtin_bit_cast(float, DPP_I(__builtin_bit_cast(int, ss_), 0xB1)); ss_ += __builtin_bit_cast(float, DPP_I(__builtin_bit_cast(int, ss_), 0x4E)); ss_ += __builtin_bit_cast(float, DPP_I(__builtin_bit_cast(int, ss_), 0x141)); \
        const float rk_ = __builtin_amdgcn_rsqf(ss_ * (1.f / 64.f) + EPS); \
        v4u ko_; ko_.x = cvtpk(kf_[0] * rk_, kf_[1] * rk_); ko_.y = cvtpk(kf_[2] * rk_, kf_[3] * rk_); ko_.z = cvtpk(kf_[4] * rk_, kf_[5] * rk_); ko_.w = cvtpk(kf_[6] * rk_, kf_[7] * rk_); ko_; })
#define ATT_STAGE(bufbase) do { LAS unsigned char* bb_ = F.lds + (bufbase); \
        if (N_LAUNCHES == 1) { *(LAS v4u*)(bb_ + kwoff) = k0r; *(LAS v4u*)(bb_ + 8192 + kwoff) = k1r; }        \
        else { *(LAS v4u*)(bb_ + kwoff) = ATT_KSC(k0r); *(LAS v4u*)(bb_ + 8192 + kwoff) = ATT_KSC(k1r); } \
        *(LAS v4u*)(bb_ + vwoff) = v0r; *(LAS v4u*)(bb_ + 8192 + vwoff) = v1r; } while (0)
    LAS float* BIAS = (LAS float*)(F.lds + 65536);
#define ATT_BIAS(T) do { const unsigned long long w_ = BM[(tid >> 3) * 32 + (T)]; const unsigned b8_ = (unsigned)(w_ >> (8 * (tid & 7))) & 0xffu; f32x4 v0_, v1_; \
        _Pragma("unroll") for (int k_ = 0; k_ < 4; ++k_) { v0_[k_] = ((b8_ >> k_) & 1u) ? negS : -1.0e30f; v1_[k_] = ((b8_ >> (4 + k_)) & 1u) ? negS : -1.0e30f; } \
        LAS float* bp_ = BIAS + ((T) & 1) * 4608 + (tid >> 3) * 72 + 8 * (tid & 7); *(LAS f32x4*)bp_ = v0_; *(LAS f32x4*)(bp_ + 4) = v1_; } while (0)
#define ATT_LOAD(tile_) do { const bf16* np_ = kvp + (size_t)(tile_) * 64 * 256; k0r = *(const v4u*)(np_); k1r = *(const v4u*)(np_ + 64); v0r = *(const v4u*)(np_ + 128); v1r = *(const v4u*)(np_ + 192); } while (0)
    float lA = 0.f, lB = 0.f;
    f32x16 oA[2], oB[2];
#pragma unroll
    for (int r = 0; r < 16; ++r) { oA[0][r] = 0.f; oA[1][r] = 0.f; oB[0][r] = 0.f; oB[1][r] = 0.f; }
    __syncthreads();
    const unsigned char* dk0 = (const unsigned char*)F.KV + (WS_K8 - WS_KV) + ((size_t)(b * SEQ + ((tid & 255) >> 2)) * 2 + (tid >> 8)) * 64 + (((tid & 3) ^ (((tid & 255) >> 4) & 3)) * 16);
    const bf16* dv0 = F.KV + (size_t)(b * SEQ + ((tid >> 2) & 63)) * 256 + 128 + 8 * ((tid >> 8) * 4 + (tid & 3));
#define ATT_DMA(tile_, bufbase) do { const size_t to_ = (size_t)(tile_) * 64 * 256; LAS unsigned char* db_ = F.lds + (bufbase) + w * 1024; \
        __builtin_amdgcn_global_load_lds((const unsigned*)(dk0 + (size_t)(tile_) * 64 * 128), (LAS unsigned*)(db_), 16, 0, 0); \
        __builtin_amdgcn_global_load_lds((const unsigned*)(dv0 + to_), (LAS unsigned*)(db_ + 16384), 16, 0, 0); __builtin_amdgcn_global_load_lds((const unsigned*)(dv0 + 64 + to_), (LAS unsigned*)(db_ + 24576), 16, 0, 0); } while (0)
    if (N_LAUNCHES == 1) { ATT_DMA(0, 0); ATT_BIAS(0); asm volatile("s_waitcnt vmcnt(0)" ::: "memory"); }
    else { ATT_STAGE(0); ATT_BIAS(0); if (ntile > 1) ATT_LOAD(1); }
    __syncthreads();
    const LAS unsigned char* vp0 = F.lds + 16384 + ((lane >> 4) & 1) * 32 + (lane & 3) * 8 + (4 * hi + ((lane & 15) >> 2)) * 64;
    for (int tile = 0; tile < ntile; ++tile) {
        const int cb_ = (tile & 1) * 32768;
        if (N_LAUNCHES == 1) { if (tile + 1 < ntile) { ATT_DMA(tile + 1, 32768 - cb_); ATT_BIAS(tile + 1); } }
        else if (tile + 1 < ntile) { ATT_STAGE(32768 - cb_); ATT_BIAS(tile + 1); if (tile + 2 < ntile) ATT_LOAD(tile + 2); }
        const LAS unsigned char* Kt = F.lds + cb_;
        const LAS float* bq_ = BIAS + (tile & 1) * 4608 + tl * 72 + 4 * hi;
#pragma unroll
        for (int hf = 0; hf < 2; ++hf) {
            f32x16 pA, pB, bz;
#pragma unroll
            for (int q4 = 0; q4 < 4; ++q4) { const f32x4 t_ = *(const LAS f32x4*)(bq_ + 32 * hf + 8 * q4); bz[4 * q4] = t_.x; bz[4 * q4 + 1] = t_.y; bz[4 * q4 + 2] = t_.z; bz[4 * q4 + 3] = t_.w; }
            {
              const int kx_ = (r32 >> 2) & 3; const LAS unsigned char* kr_ = Kt + (hf * 32 + r32) * 64;
              const pg8::v4i_t a0 = *(const LAS pg8::v4i_t*)(kr_ + (((2 * hi) ^ kx_) * 16)), a1 = *(const LAS pg8::v4i_t*)(kr_ + (((2 * hi + 1) ^ kx_) * 16));
              const pg8::v4i_t c0 = *(const LAS pg8::v4i_t*)(kr_ + 4096 + (((2 * hi) ^ kx_) * 16)), c1 = *(const LAS pg8::v4i_t*)(kr_ + 4096 + (((2 * hi + 1) ^ kx_) * 16));
              const pg8::v8i_t ka_ = __builtin_shufflevector(a0, a1, 0, 1, 2, 3, 4, 5, 6, 7), kb_ = __builtin_shufflevector(c0, c1, 0, 1, 2, 3, 4, 5, 6, 7);
              pA = __builtin_amdgcn_mfma_scale_f32_32x32x64_f8f6f4(ka_, qA8, bz, 0, 0, 0, 0x7F7F7F7F, 0, 0x7B7B7B7B);
              pB = __builtin_amdgcn_mfma_scale_f32_32x32x64_f8f6f4(kb_, qB8, bz, 0, 0, 0, 0x7F7F7F7F, 0, 0x7B7B7B7B); }
            v4i16_t vfa[2][2][2], vfb[2][2][2];
            { const unsigned vb_ = (unsigned)(unsigned long long)(vp0 + cb_);
#pragma unroll
              for (int dh = 0; dh < 2; ++dh)
#pragma unroll
                for (int k2 = 0; k2 < 2; ++k2) { const int o_ = dh * 4096 + (2 * hf + k2) * 1024;
                    asm volatile("ds_read_b64_tr_b16 %0, %1 offset:%2" : "=v"(vfa[dh][k2][0]) : "v"(vb_), "i"(o_));
                    asm volatile("ds_read_b64_tr_b16 %0, %1 offset:%2" : "=v"(vfa[dh][k2][1]) : "v"(vb_), "i"(o_ + 512));
                    asm volatile("ds_read_b64_tr_b16 %0, %1 offset:%2" : "=v"(vfb[dh][k2][0]) : "v"(vb_), "i"(o_ + 8192));
                    asm volatile("ds_read_b64_tr_b16 %0, %1 offset:%2" : "=v"(vfb[dh][k2][1]) : "v"(vb_), "i"(o_ + 8192 + 512)); } }
            float psA = 0.f, psB = 0.f;
#define ATT_EXPM(R) do { pA[R] = __builtin_amdgcn_exp2f(pA[R]); pB[R] = __builtin_amdgcn_exp2f(pB[R]); psA += pA[R]; psB += pB[R]; } while (0)
            ATT_EXPM(0); ATT_EXPM(1); ATT_EXPM(2); ATT_EXPM(3); ATT_EXPM(4); ATT_EXPM(5); ATT_EXPM(6); ATT_EXPM(7);
            ATT_EXPM(8); ATT_EXPM(9); ATT_EXPM(10); ATT_EXPM(11); ATT_EXPM(12); ATT_EXPM(13); ATT_EXPM(14); ATT_EXPM(15);
#undef ATT_EXPM
            lA += psA; lB += psB;
            bf16x8 paA[2], paB[2];
            { v4u t_;
              t_.x = cvtpk(pA[0], pA[1]); t_.y = cvtpk(pA[2], pA[3]); t_.z = cvtpk(pA[4], pA[5]); t_.w = cvtpk(pA[6], pA[7]); paA[0] = __builtin_bit_cast(bf16x8, t_);
              t_.x = cvtpk(pA[8], pA[9]); t_.y = cvtpk(pA[10], pA[11]); t_.z = cvtpk(pA[12], pA[13]); t_.w = cvtpk(pA[14], pA[15]); paA[1] = __builtin_bit_cast(bf16x8, t_);
              t_.x = cvtpk(pB[0], pB[1]); t_.y = cvtpk(pB[2], pB[3]); t_.z = cvtpk(pB[4], pB[5]); t_.w = cvtpk(pB[6], pB[7]); paB[0] = __builtin_bit_cast(bf16x8, t_);
              t_.x = cvtpk(pB[8], pB[9]); t_.y = cvtpk(pB[10], pB[11]); t_.z = cvtpk(pB[12], pB[13]); t_.w = cvtpk(pB[14], pB[15]); paB[1] = __builtin_bit_cast(bf16x8, t_); }
            asm volatile("s_waitcnt lgkmcnt(0)" : "+v"(vfa[0][0][0]), "+v"(vfa[0][0][1]), "+v"(vfa[0][1][0]), "+v"(vfa[0][1][1]), "+v"(vfa[1][0][0]), "+v"(vfa[1][0][1]), "+v"(vfa[1][1][0]), "+v"(vfa[1][1][1]),
                                                  "+v"(vfb[0][0][0]), "+v"(vfb[0][0][1]), "+v"(vfb[0][1][0]), "+v"(vfb[0][1][1]), "+v"(vfb[1][0][0]), "+v"(vfb[1][0][1]), "+v"(vfb[1][1][0]), "+v"(vfb[1][1][1]) :: "memory");
#pragma unroll
            for (int dh = 0; dh < 2; ++dh)
#pragma unroll
                for (int k2 = 0; k2 < 2; ++k2) {
                    const v4i16_t la_ = vfa[dh][k2][0], ha_ = vfa[dh][k2][1], lb_ = vfb[dh][k2][0], hb_ = vfb[dh][k2][1];
                    const bf16x8 va = (bf16x8){la_[0], la_[1], la_[2], la_[3], ha_[0], ha_[1], ha_[2], ha_[3]}, vb = (bf16x8){lb_[0], lb_[1], lb_[2], lb_[3], hb_[0], hb_[1], hb_[2], hb_[3]};
                    oA[dh] = __builtin_amdgcn_mfma_f32_32x32x16_bf16(paA[k2], va, oA[dh], 0, 0, 0);
                    oB[dh] = __builtin_amdgcn_mfma_f32_32x32x16_bf16(paB[k2], vb, oB[dh], 0, 0, 0); }
        }
        if (N_LAUNCHES == 1) asm volatile("s_waitcnt vmcnt(0)" ::: "memory");
        __syncthreads();
    }
#undef ATT_DMA
#undef ATT_STAGE
#undef ATT_LOAD
#undef ATT_KSC
#define ATT_FIN(LL, OO, KVH) do { float l_ = LL; { const auto rr = __builtin_amdgcn_permlane32_swap(__float_as_uint(l_), __float_as_uint(l_), false, false); l_ = __uint_as_float(rr[0]) + __uint_as_float(rr[1]); } \
    if (hi == 0) wsf[r32] = __builtin_amdgcn_rcpf(l_); \
    LDS_WAIT(); asm volatile("" ::: "memory"); \
    float ssq[4]; \
    _Pragma("unroll") for (int q4 = 0; q4 < 4; ++q4) { const f32x4 av = *(const LAS f32x4*)(wsf + 8 * q4 + 4 * hi); float s2 = 0.f; \
        const size_t row = (size_t)(b * SEQ + t0 + 8 * w + 2 * q4 + hi); \
        _Pragma("unroll") for (int i = 0; i < 4; ++i) { const float v0 = OO[0][4 * q4 + i] * av[i], v1 = OO[1][4 * q4 + i] * av[i]; s2 += v0 * v0 + v1 * v1; \
            bf16* op = F.MIX + row * 1024 + 512 + (4 * (KVH) + i) * 64 + r32; \
            const unsigned pk_ = cvtpk(v0, v1); op[0] = (bf16)(pk_ & 0xffffu); op[32] = (bf16)(pk_ >> 16); } \
        ssq[q4] = s2; } \
    _Pragma("unroll") for (int q4 = 0; q4 < 4; ++q4) { float s2 = ssq[q4]; \
        s2 += __shfl_xor(s2, 1); s2 += __shfl_xor(s2, 2); s2 += __shfl_xor(s2, 4); s2 += __shfl_xor(s2, 8); s2 += __shfl_xor(s2, 16); \
        if (r32 == 0) F.SSQA[(size_t)(b * SEQ + t0 + 8 * w + 2 * q4 + hi) * 2 + (KVH)] = s2; } \
    LDS_WAIT(); asm volatile("" ::: "memory"); } while (0)
    ATT_FIN(lA, oA, 0); ATT_FIN(lB, oB, 1);
#undef ATT_FIN
}

__device__ __forceinline__ void p3_phase(Frame& F) {
#ifdef TS_PROBE
    const unsigned long long tsp3_ = __builtin_amdgcn_s_memtime(); F.tsacc = 0ull;
#endif
    LAS unsigned char* wl = F.lds + RING_OFF + F.wave * WAVE_LDS;
    const int gw = F.vcu * NWAVES + F.wave, NGW = F.G * NWAVES;
    if (N_LAUNCHES == 1) {
        for (int u = F.vcu; u < BATCH * 16; u += F.G) { const int b_ = u >> 4, p_ = u & 15; const wt_rsrc_t k8r = wt_rsrc((const unsigned char*)F.KV + (WS_K8 - WS_KV));
            const int tid_ = F.tid, kk = tid_ >> 3, sc_ = tid_ & 7;
#pragma unroll
            for (int rnd = 0; rnd < 2; ++rnd) { const size_t row = (size_t)(b_ * SEQ + p_ * 128 + rnd * 64 + kk);
#pragma unroll
                for (int hd = 0; hd < 2; ++hd) { const unsigned eo = (unsigned)(row * 256 + hd * 64 + 8 * sc_);
                    const v4u kv_ = *(const v4u*)(F.KV + eo);
                    float kf_[8] = {bflo(kv_.x), bfhi(kv_.x), bflo(kv_.y), bfhi(kv_.y), bflo(kv_.z), bfhi(kv_.z), bflo(kv_.w), bfhi(kv_.w)}; float ss_ = 0.f;
#pragma unroll
                    for (int j_ = 0; j_ < 8; ++j_) ss_ += kf_[j_] * kf_[j_];
                    ss_ += __builtin_bit_cast(float, DPP_I(__builtin_bit_cast(int, ss_), 0xB1)); ss_ += __builtin_bit_cast(float, DPP_I(__builtin_bit_cast(int, ss_), 0x4E)); ss_ += __builtin_bit_cast(float, DPP_I(__builtin_bit_cast(int, ss_), 0x141));
                    const float rk_ = __builtin_amdgcn_rsqf(ss_ * (1.f / 64.f) + EPS);
                    { float k8_[8];
#pragma unroll
                      for (int j_ = 0; j_ < 8; ++j_) k8_[j_] = kf_[j_] * rk_;
                      wt_st8(k8r, (unsigned)((row * 2 + hd) * 64 + 32 * (sc_ & 1) + 8 * (sc_ >> 1)), pack_fp8x8(k8_)); } } }
            asm volatile("s_waitcnt vmcnt(0)" ::: "memory"); __syncthreads();
            if (F.tid == 0) (void)xb_add((unsigned*)(F.ctl + CW_KN + b_ * 64), 1u); }
    }
    for (int cg = F.vcu; cg < 256; cg += F.G) { TS_T0(); bias2_wg(F, cg); TS_ACC(7); }
#ifndef DUP_SSM
#define DUP_SSM 1
#endif
#ifndef DUP_ATTN
#define DUP_ATTN 1
#endif
#ifndef NO_SSM
    for (int rep = 0; rep < DUP_SSM; ++rep)
    for (int u = F.vcu; u < NG * 8; u += F.G) { TS_T0(); ssm_unit(F, u & 31, u >> 5); TS_ACC(6); }
#endif
#ifndef NO_ATTN
    for (int rep = 0; rep < DUP_ATTN; ++rep)
    for (int u = F.vcu; u < BATCH * 16; u += F.G) {
        const int b = u >> 4, p = u & 15;
#pragma unroll 1
        for (int side = 0; side < 2; ++side) { const int t0 = 64 * (side ? 31 - p : p);
            int kn_wait = (N_LAUNCHES == 1 && side == 0) ? 1 : 0;
#pragma unroll 1
#ifndef DUP_IS
#define DUP_IS 1
#endif
            for (int sub = 0; sub < 4 * DUP_IS; ++sub) idx_subunit(F, b, t0 + 16 * (sub & 3), 16 * (sub & 3));
#pragma unroll 1
            for (int rep2_ = 0; rep2_ < DUP_FLASH; ++rep2_) {
#ifndef T_NOFLASH
                if (kn_wait) { kn_wait = 0;
                    __syncthreads();
                    if (F.tid == 0) { unsigned* tmo_ = (unsigned*)(F.ctl + CW_BAR); unsigned* p_ = (unsigned*)(F.ctl + CW_KN + b * 64);
                        XB_SPIN(xb_ld(p_) < 16u, tmo_);
                        __builtin_amdgcn_fence(__ATOMIC_ACQUIRE, "agent");
                        asm volatile("s_waitcnt vmcnt(0)" ::: "memory"); }
                    __syncthreads(); }
                { TS_T0(); attn_unit2(F, b, t0); TS_ACC(5); }
#endif
            } }
    }
#endif
    __syncthreads();
#ifdef TS_PROBE
    if (blockIdx.x == 64 && F.tid == 0) { const unsigned long long tot_ = __builtin_amdgcn_s_memtime() - tsp3_; const float fr_ = (float)((double)F.tsacc / (double)tot_); F.MISC[16] = __float_as_uint(0.025f * floorf(fr_ * 40.0f + 0.5f)); }
#endif
}

struct Args { const float* in[24]; float* out; unsigned char* ws; int ph_lo, ph_hi, li, pad; };
__global__ void __launch_bounds__(NWAVES * 64, 2) fwd_kernel(Args args) {
    extern __shared__ __attribute__((aligned(16))) unsigned char lds[];
    Frame F;
    F.lds = (LAS unsigned char*)lds;
    F.MISC = (volatile LAS unsigned*)(F.lds + MISC_OFF);
    F.tid = threadIdx.x; F.lane = F.tid & 63; F.wave = __builtin_amdgcn_readfirstlane(F.tid >> 6);
    F.G = gridDim.x; { const int bx = blockIdx.x; F.vcu = (F.G % 8 == 0) ? (bx % 8) * (F.G / 8) + bx / 8 : bx; }
    unsigned char* ws = args.ws;
    F.ctl = (gu32*)(ws + WS_CTL);
    F.x = args.in[0]; F.c = args.in[1]; F.norm1_g = args.in[2]; F.norm2_g = args.in[3]; F.w_ada = args.in[4]; F.b_ada = args.in[5]; F.w_in = args.in[6];
    F.lam_re = args.in[7]; F.lam_im = args.in[8]; F.log_dt = args.in[9]; F.b_re = args.in[10]; F.b_im = args.in[11]; F.c_re = args.in[12]; F.c_im = args.in[13];
    F.d_skip = args.in[14]; F.w_glu = args.in[15]; F.b_glu = args.in[16]; F.q_gain = args.in[17]; F.k_gain = args.in[18]; F.gn_ssm = args.in[19]; F.gn_attn = args.in[20];
    F.w_out = args.in[21]; F.w_ff1 = args.in[22]; F.w_ff2 = args.in[23]; F.out = args.out;
    F.MODP = (float*)(ws + WS_MODP); F.MOD = (float*)(ws + WS_MOD); F.BIAS2 = (float*)(ws + WS_BIAS2); F.SSQS = (float*)(ws + WS_SSQS); F.SSQ2 = (float*)(ws + WS_SSQ2);
    F.KI2 = (bf16*)(ws + WS_KI); F.WI = (float*)(ws + WS_WI); F.QI2 = (bf16*)(ws + WS_QI); F.SSQA = (float*)(ws + WS_SSQA); F.SSMF = (bf16*)(ws + WS_SSMF); F.X1 = (bf16*)(ws + WS_X1);
    F.LAMB = (f32x2*)(ws + WS_SSMP); F.BBAR = (f32x2*)(ws + WS_SSMP + 16384);
    F.WINP = (bf16*)(ws + WS_WINP); F.WINI = (bf16*)(ws + WS_WINI); F.WGLU = (bf16*)(ws + WS_WGLU); F.WOUT = (bf16*)(ws + WS_WOUT); F.W1 = (bf16*)(ws + WS_W1); F.W2 = (bf16*)(ws + WS_W2);
    F.U = (bf16*)(ws + WS_U); F.Q = (bf16*)(ws + WS_Q); F.A2 = (bf16*)(ws + WS_A2); F.XN = (bf16*)(ws + WS_XN); F.KV = (bf16*)(ws + WS_KV); F.Z = (bf16*)(ws + WS_Z); F.MIX = (bf16*)(ws + WS_MIX); F.H = (bf16*)(ws + WS_H);
    for (int u = F.tid; u < (LDS_BYTES - LDSCTL_OFF) / 4; u += NWAVES * 64) ((LAS unsigned*)(F.lds + LDSCTL_OFF))[u] = 0u;
    __syncthreads();
    XcdBarrier bar; bar.bar = (unsigned*)(F.ctl + CW_BAR) + args.li * XCD_BAR_WORDS; bar.x = 0; bar.st = nullptr;
    if (N_LAUNCHES == 1) bar = xcd_barrier_post((unsigned*)(F.ctl + CW_BAR) + args.li * XCD_BAR_WORDS, F.MISC + 8);
#define GRID_BAR() do { if (N_LAUNCHES == 1) xcd_barrier(bar); } while (0)
    const int lo = args.ph_lo, hi = args.ph_hi;
#ifdef TS_GEMM
    unsigned long long tsg_ = 0ull, tsg0_ = 0ull;
#define TSP(k) (((k) == TS_GEMM) ? &tsg_ : nullptr)
#define TSG_BEGIN(k) do { if ((k) == TS_GEMM) tsg0_ = __builtin_amdgcn_s_memtime(); } while (0)
#define TSG_END(k) do { if ((k) == TS_GEMM && blockIdx.x == 64 && F.tid == 0) { const unsigned long long tot_ = __builtin_amdgcn_s_memtime() - tsg0_; const float fr_ = (float)((double)tsg_ / (double)tot_); F.MISC[16] = __float_as_uint(0.06f * floorf(fr_ * (1.0f / 0.06f) + 0.5f)); } } while (0)
#else
#define TSP(k) nullptr
#define TSG_BEGIN(k) do {} while (0)
#define TSG_END(k) do {} while (0)
#endif
#ifndef PHASE_MASK
#define PHASE_MASK 0xFF
#endif
#define IN(k) (((PHASE_MASK >> (k)) & 1) && lo <= (k) && (k) < hi)
#define BOTH(k) (IN(k) && IN((k) + 1))

#ifndef DUP_PH
#define DUP_PH -1
#endif
#define PH_REP(k) for (int rep_ = 0; rep_ < ((DUP_PH == (k)) ? 2 : 1); ++rep_)
    if (IN(0)) { PH_REP(0) p0a_phase(F); if (BOTH(0)) GRID_BAR(); }
    if (IN(1)) { PH_REP(1) p0b_phase(F); if (BOTH(1)) GRID_BAR(); }
    if (IN(2)) { TSG_BEGIN(2); PH_REP(2) {
        { pg8::Gemm g{F.XN, F.WINP, M, 2048, 1024, 1024, 1 << 30, 128, (size_t)256 * 1024 * 2}; pg8::StaticOrder S; S.init(M, 2048, F.G, (int)blockIdx.x);
          EpiIn E{0, TSP(2), F.U, F.Q, F.KV, F.QI2, F.KI2, F.WI};
          pg8::gemm_phase<EpiIn, pg8::StaticOrder, true, true>(F.lds + RING_OFF, g, S, E); }
        }
        TSG_END(2);
        if (BOTH(2)) GRID_BAR();
    }
    if (IN(3)) { p3_phase(F); if (BOTH(3)) GRID_BAR(); }
    if (IN(4)) { PH_REP(4) {
        pg8::Gemm g{F.Z, F.WGLU, M, 512, 512, 512, 1 << 30, 128, (size_t)256 * 512 * 2}; pg8::StaticOrder S; S.init(M, 512, F.G, (int)blockIdx.x);
        EpiGlu E{0, TSP(4), F.Z, F.MIX, F.b_glu, F.SSQS};
        pg8::gemm_phase<EpiGlu, pg8::StaticOrder, true>(F.lds + RING_OFF, g, S, E); }
        if (BOTH(4)) GRID_BAR();
    }
    if (IN(5)) { TSG_BEGIN(5); PH_REP(5) {
        pg8::Gemm g{F.MIX, F.WOUT, M, 1024, 1024, 1024, 1 << 30, 128, (size_t)256 * 1024 * 2}; pg8::StaticOrder S; S.init(M, 1024, F.G, (int)blockIdx.x);
        EpiOut E{8, TSP(5), F.x, F.X1, F.A2, F.MOD, F.norm2_g, F.SSQS, F.SSQ2, F.SSQA};
        pg8::gemm_phase<EpiOut, pg8::StaticOrder, true>(F.lds + RING_OFF, g, S, E); }
        TSG_END(5);
        if (BOTH(5)) GRID_BAR();
    }
    if (IN(6)) { TSG_BEGIN(6); PH_REP(6) {
        pg8::Gemm g{F.A2, F.W1, M, DFF, 1024, 1024, 1 << 30, 128, (size_t)256 * 1024 * 2}; pg8::StaticOrder S; S.init(M, DFF, F.G, (int)blockIdx.x);
        LAS float* lrs_ = (LAS float*)(F.lds + BM_OFF); LAS float* lbias_ = lrs_ + 2048;
        up_tables(S, F.SSQ2, F.BIAS2, lrs_, lbias_);
        EpiUp E{0, TSP(6), lrs_, lbias_, F.H};
        pg8::gemm_phase<EpiUp, pg8::StaticOrder, true>(F.lds + RING_OFF, g, S, E); }
        TSG_END(6);
        if (BOTH(6)) GRID_BAR();
    }
#ifdef PROBE_BARS
    if (N_LAUNCHES == 1 && hi == NPHASE) { for (int i_ = 0; i_ < PROBE_BARS; ++i_) GRID_BAR(); }
#endif
    if (IN(7)) { PH_REP(7) {
        pg8::Gemm g{F.H, F.W2, M, 1024, DFF / 2, 64, 1 << 30, (size_t)256 * 64 * 2, (size_t)256 * DFF}; pg8::StaticOrder S; S.init(M, 1024, F.G, (int)blockIdx.x);
#if defined(TS_PROBE) || defined(TS_GEMM)
        const float psc_ = (blockIdx.x == 64) ? 1.0f + 16.0f * __uint_as_float(F.MISC[16]) : 1.0f;
#else
        const float psc_ = 1.0f;
#endif
        EpiDown E{0, nullptr, F.out, F.X1, F.MOD, psc_};
        pg8::gemm_phase<EpiDown, pg8::StaticOrder, true, false, true>(F.lds + RING_OFF, g, S, E); }
    }
#undef IN
#undef BOTH
}

extern "C" void kernel_launch(void* const* d_in, const int* in_sizes, int n_in, void* d_out, int out_size, void* d_ws, size_t ws_size, hipStream_t stream) {
    static int grid = 0;
    if (grid == 0) {
        if (n_in != 24 || in_sizes[0] != M * DM || out_size != M * DM || ws_size < WS_END) { fprintf(stderr, "kernel_launch: unexpected shapes (n_in %d, in0 %d, out %d, ws %zu); nothing launched\n", n_in, n_in > 0 ? in_sizes[0] : -1, out_size, ws_size); grid = -1; return; }
        int dev = 0, cus = 0, per_cu = 0;
        if (hipGetDevice(&dev) != hipSuccess || hipDeviceGetAttribute(&cus, hipDeviceAttributeMultiprocessorCount, dev) != hipSuccess) { fprintf(stderr, "kernel_launch: device query failed\n"); grid = -1; return; }
        if (hipFuncSetAttribute((const void*)fwd_kernel, hipFuncAttributeMaxDynamicSharedMemorySize, LDS_BYTES) != hipSuccess) { fprintf(stderr, "kernel_launch: hipFuncSetAttribute failed\n"); grid = -1; return; }
        if (hipOccupancyMaxActiveBlocksPerMultiprocessor(&per_cu, (const void*)fwd_kernel, NWAVES * 64, LDS_BYTES) != hipSuccess || per_cu < 1)
            fprintf(stderr, "kernel_launch: note: occupancy query reports %d workgroups per CU\n", per_cu);
        (void)hipGetLastError();
        grid = cus;
        if (grid != 256) { fprintf(stderr, "kernel_launch: this kernel is laid out for 256 CUs, found %d; nothing launched\n", grid); grid = -1; return; }
    }
    if (grid < 0) return;
    if (hipMemsetAsync((char*)d_ws + WS_CTL, 0, CTL_ZERO_BYTES, stream) != hipSuccess) { fprintf(stderr, "kernel_launch: memset failed\n"); return; }
    Args a{};
    for (int i = 0; i < 24; ++i) a.in[i] = (const float*)d_in[i];
    a.out = (float*)d_out; a.ws = (unsigned char*)d_ws;
#ifdef PROBE_SPLIT
    { const int lo_[3] = {0, PROBE_SPLIT, PROBE_SPLIT + 1}, hi_[3] = {PROBE_SPLIT + 1, PROBE_SPLIT + 1, NPHASE};
      for (int li = 0; li < 3; ++li) { a.ph_lo = lo_[li]; a.ph_hi = hi_[li]; a.li = li; hipLaunchKernelGGL(fwd_kernel, dim3(grid), dim3(NWAVES * 64), LDS_BYTES, stream, a); } }
#else
    for (int li = 0; li < N_LAUNCHES; ++li) {
        a.ph_lo = (N_LAUNCHES == 1) ? 0 : li; a.ph_hi = (N_LAUNCHES == 1) ? NPHASE : li + 1; a.li = li;
        hipLaunchKernelGGL(fwd_kernel, dim3(grid), dim3(NWAVES * 64), LDS_BYTES, stream, a);
        const hipError_t le = hipPeekAtLastError();
        if (le != hipSuccess) { fprintf(stderr, "kernel_launch: launch %d failed: %s\n", li, hipGetErrorName(le)); break; }
    }
#endif
#ifdef PROBE_PHASE
    a.ph_lo = PROBE_PHASE; a.ph_hi = PROBE_PHASE + 1; a.li = 1;
    hipLaunchKernelGGL(fwd_kernel, dim3(grid), dim3(NWAVES * 64), LDS_BYTES, stream, a);
#endif
}
```
